# Optimizing an MI355X kernel written in HIP

```python
import jax, jax.numpy as jnp
from jax import lax
import numpy as np


D_MODEL = 2048
BATCH = 2
SEQ = 8192
DEPTH = 4

A_WIDTH = D_MODEL // 2
A_HEADS = 8
A_HEAD_DIM = A_WIDTH // A_HEADS
CONV_WIDTH = 4
LRU_C = 8.0
B_HEADS = 4
B_KEY_WIDTH = D_MODEL // 4
B_VAL_WIDTH = D_MODEL // 2
B_DK = B_KEY_WIDTH // B_HEADS
B_DV = B_VAL_WIDTH // B_HEADS
B_RANK = 16
GATE_NORMALIZER = 16.0
C_HEADS = 8
C_EXPAND = 128
C_KEY_WIDTH = C_HEADS * C_EXPAND
C_VAL_WIDTH = D_MODEL // 2
C_DV = C_VAL_WIDTH // C_HEADS
N_BRANCH = 3
CHUNK = 64
D_FF = 5632
EPS = 1e-6
EXP_CLIP = 80.0

IN_SPLITS = (A_WIDTH, A_WIDTH,
             B_KEY_WIDTH, B_KEY_WIDTH, B_VAL_WIDTH, B_VAL_WIDTH,
             B_RANK,
             C_KEY_WIDTH, C_KEY_WIDTH, C_VAL_WIDTH, C_VAL_WIDTH,
             N_BRANCH * D_MODEL)
IN_WIDTH = sum(IN_SPLITS)

kernel_name = 'hybrid_rglru_gla_hgrn2_macaron'


def rms_norm(x, g):
    xf = x.astype(jnp.float32)
    y = xf * lax.rsqrt(jnp.mean(xf * xf, axis=-1, keepdims=True) + EPS)
    return (y * g.astype(jnp.float32)).astype(x.dtype)


def head_rms_norm(o, g):
    return o * lax.rsqrt(jnp.mean(o * o, axis=-1, keepdims=True) + EPS) * g.astype(jnp.float32)


def swiglu(h, w_gate, w_up, w_down):
    return (jax.nn.silu(h @ w_gate) * (h @ w_up)) @ w_down


def causal_depthwise_conv(x, w, b):
    s = x.shape[1]
    xp = jnp.pad(x, ((0, 0), (CONV_WIDTH - 1, 0), (0, 0)))
    out = b
    for k in range(CONV_WIDTH):
        out = out + xp[:, k:k + s] * w[k]
    return out


def rg_lru(x, w_a, b_a, w_x, b_x, lam):
    bsz, s, w = x.shape
    f32 = jnp.float32
    xf = x.astype(f32)
    xh = xf.reshape(bsz, s, A_HEADS, A_HEAD_DIM)
    r = jax.nn.sigmoid(jnp.einsum('bshi,hij->bshj', xh, w_a.astype(f32)).reshape(bsz, s, w) + b_a.astype(f32))
    i = jax.nn.sigmoid(jnp.einsum('bshi,hij->bshj', xh, w_x.astype(f32)).reshape(bsz, s, w) + b_x.astype(f32))
    log_a = -LRU_C * r * jax.nn.softplus(-lam.astype(f32))
    a = jnp.exp(log_a)
    u = jnp.sqrt(-jnp.expm1(2.0 * log_a)) * (i * xf)

    def combine(left, right):
        a1, b1 = left
        a2, b2 = right
        return a1 * a2, a2 * b1 + b2

    _, h = lax.associative_scan(combine, (a, u), axis=1)
    return h.astype(x.dtype)


def chunked_gated_linear_attention(q, k, v, log_f):
    bsz, s, h, dk = q.shape
    dv = v.shape[-1]
    n = s // CHUNK

    def to_chunks(t):
        return t.reshape(bsz, n, CHUNK, h, t.shape[-1]).transpose(1, 0, 3, 2, 4)

    causal = jnp.tril(jnp.ones((CHUNK, CHUNK), dtype=bool))[:, :, None]

    def step(state, inp):
        qc, kc, vc, gc = inp
        b = jnp.cumsum(gc, axis=2)
        diff = b[:, :, :, None, :] - b[:, :, None, :, :]
        decay = jnp.where(causal, jnp.exp(jnp.where(causal, diff, 0.0)), 0.0)
        scores = jnp.einsum('bhid,bhjd,bhijd->bhij', qc, kc, decay)
        o = (jnp.einsum('bhij,bhjv->bhiv', scores, vc)
             + jnp.einsum('bhid,bhdv->bhiv', qc * jnp.exp(b), state))
        b_last = b[:, :, -1:, :]
        state = (state * jnp.exp(b_last[:, :, 0, :, None])
                 + jnp.einsum('bhjd,bhjv->bhdv', kc * jnp.exp(b_last - b), vc))
        return state, o

    s0 = jnp.zeros((bsz, h, dk, dv), jnp.float32)
    _, o = lax.scan(step, s0, (to_chunks(q), to_chunks(k), to_chunks(v), to_chunks(log_f)))
    return o.transpose(1, 0, 3, 2, 4).reshape(bsz, s, h, dv)


def token_mixing(h, lb, w_in, conv_w, conv_b, lru_w_a, lru_b_a, lru_w_x, lru_b_x, lru_lambda,
                 gla_w2, gla_b2, gla_norm_g, hgrn_norm_g, w_br_a, w_br_b, w_br_c, w_out):
    bsz, s, _ = h.shape
    f32 = jnp.float32
    offsets = np.cumsum(IN_SPLITS)[:-1].tolist()
    (a_x, a_gate, b_q, b_k, b_v, b_g, b_lr,
     c_q, c_f, c_i, c_g, merge) = jnp.split(h @ w_in, offsets, axis=-1)

    a_conv = causal_depthwise_conv(a_x, conv_w, conv_b)
    y_a = jax.nn.gelu(a_gate) * rg_lru(a_conv, lru_w_a, lru_b_a, lru_w_x, lru_b_x, lru_lambda)

    q_b = b_q.astype(f32).reshape(bsz, s, B_HEADS, B_DK) * (B_DK ** -0.5)
    k_b = b_k.astype(f32).reshape(bsz, s, B_HEADS, B_DK)
    v_b = b_v.astype(f32).reshape(bsz, s, B_HEADS, B_DV)
    log_alpha = jax.nn.log_sigmoid((b_lr @ gla_w2 + gla_b2).astype(f32)) / GATE_NORMALIZER
    o_b = chunked_gated_linear_attention(q_b, k_b, v_b, log_alpha.reshape(bsz, s, B_HEADS, B_DK))
    y_b = (head_rms_norm(o_b, gla_norm_g).reshape(bsz, s, B_VAL_WIDTH)
           * jax.nn.silu(b_g.astype(f32))).astype(h.dtype)

    q_c = jax.nn.silu(c_q.astype(f32)).reshape(bsz, s, C_HEADS, C_EXPAND)
    f_logit = c_f.astype(f32)
    log_f = jax.nn.log_sigmoid(f_logit) + jnp.log1p(lb * jnp.exp(jnp.minimum(-f_logit, EXP_CLIP)))
    k_c = (1.0 - lb) * jax.nn.sigmoid(-f_logit)
    o_c = chunked_gated_linear_attention(
        q_c, k_c.reshape(bsz, s, C_HEADS, C_EXPAND),
        c_i.astype(f32).reshape(bsz, s, C_HEADS, C_DV), log_f.reshape(bsz, s, C_HEADS, C_EXPAND))
    y_c = (head_rms_norm(o_c, hgrn_norm_g).reshape(bsz, s, C_VAL_WIDTH)
           * jax.nn.sigmoid(c_g.astype(f32))).astype(h.dtype)

    g_a, g_b, g_c = jnp.split(jax.nn.sigmoid(merge), N_BRANCH, axis=-1)
    merged = g_a * (y_a @ w_br_a) + g_b * (y_b @ w_br_b) + g_c * (y_c @ w_br_c)
    return merged @ w_out


def setup_inputs(seed: int = 0) -> dict:
    key = jax.random.key(seed)
    ks = jax.random.split(key, 32)
    f32 = jnp.float32

    def w(k, shape, fan_in):
        return jax.random.normal(k, shape, f32) * (fan_in ** -0.5)

    def gain(k, shape):
        return 1.0 + 0.02 * jax.random.normal(k, shape, f32)

    def bias(k, shape):
        return 0.02 * jax.random.normal(k, shape, f32)

    L = DEPTH
    u = jax.random.uniform(ks[14], (L, A_WIDTH), f32, 0.9, 0.999)
    a0 = u ** (1.0 / LRU_C)
    lru_lambda = jnp.log(a0) - jnp.log1p(-a0)
    return {
        'x': jax.random.normal(ks[0], (BATCH, SEQ, D_MODEL), f32),
        'ffn1_pre_g': gain(ks[1], (L, D_MODEL)),
        'ffn1_w_gate': w(ks[2], (L, D_MODEL, D_FF), D_MODEL),
        'ffn1_w_up': w(ks[3], (L, D_MODEL, D_FF), D_MODEL),
        'ffn1_w_down': w(ks[4], (L, D_FF, D_MODEL), D_FF),
        'ffn1_post_g': gain(ks[5], (L, D_MODEL)),
        'mix_pre_g': gain(ks[6], (L, D_MODEL)),
        'w_in': w(ks[7], (L, D_MODEL, IN_WIDTH), D_MODEL),
        'conv_w': w(ks[8], (L, CONV_WIDTH, A_WIDTH), CONV_WIDTH),
        'conv_b': bias(ks[9], (L, A_WIDTH)),
        'lru_w_a': w(ks[10], (L, A_HEADS, A_HEAD_DIM, A_HEAD_DIM), A_HEAD_DIM),
        'lru_b_a': bias(ks[11], (L, A_WIDTH)),
        'lru_w_x': w(ks[12], (L, A_HEADS, A_HEAD_DIM, A_HEAD_DIM), A_HEAD_DIM),
        'lru_b_x': bias(ks[13], (L, A_WIDTH)),
        'lru_lambda': lru_lambda,
        'gla_w2': w(ks[15], (L, B_RANK, B_KEY_WIDTH), B_RANK),
        'gla_b2': bias(ks[16], (L, B_KEY_WIDTH)),
        'gla_norm_g': gain(ks[17], (L, B_DV)),
        'hgrn_lb_logits': jax.random.normal(ks[18], (L, C_KEY_WIDTH), f32),
        'hgrn_norm_g': gain(ks[19], (L, C_DV)),
        'w_br_a': w(ks[20], (L, A_WIDTH, D_MODEL), A_WIDTH),
        'w_br_b': w(ks[21], (L, B_VAL_WIDTH, D_MODEL), B_VAL_WIDTH),
        'w_br_c': w(ks[22], (L, C_VAL_WIDTH, D_MODEL), C_VAL_WIDTH),
        'w_out': w(ks[23], (L, D_MODEL, D_MODEL), D_MODEL),
        'mix_post_g': gain(ks[24], (L, D_MODEL)),
        'ffn2_pre_g': gain(ks[25], (L, D_MODEL)),
        'ffn2_w_gate': w(ks[26], (L, D_MODEL, D_FF), D_MODEL),
        'ffn2_w_up': w(ks[27], (L, D_MODEL, D_FF), D_MODEL),
        'ffn2_w_down': w(ks[28], (L, D_FF, D_MODEL), D_FF),
        'ffn2_post_g': gain(ks[29], (L, D_MODEL)),
    }


def reference(x, ffn1_pre_g, ffn1_w_gate, ffn1_w_up, ffn1_w_down, ffn1_post_g,
              mix_pre_g, w_in, conv_w, conv_b, lru_w_a, lru_b_a, lru_w_x, lru_b_x, lru_lambda,
              gla_w2, gla_b2, gla_norm_g, hgrn_lb_logits, hgrn_norm_g,
              w_br_a, w_br_b, w_br_c, w_out, mix_post_g,
              ffn2_pre_g, ffn2_w_gate, ffn2_w_up, ffn2_w_down, ffn2_post_g):
    lb_p = jax.nn.softmax(hgrn_lb_logits.astype(jnp.float32), axis=0)
    lb_all = jnp.cumsum(lb_p, axis=0) - lb_p[0:1]
    for l in range(DEPTH):
        x = x + 0.5 * rms_norm(swiglu(rms_norm(x, ffn1_pre_g[l]), ffn1_w_gate[l], ffn1_w_up[l],
                                      ffn1_w_down[l]), ffn1_post_g[l])
        mixed = token_mixing(rms_norm(x, mix_pre_g[l]), lb_all[l], w_in[l], conv_w[l], conv_b[l],
                             lru_w_a[l], lru_b_a[l], lru_w_x[l], lru_b_x[l], lru_lambda[l],
                             gla_w2[l], gla_b2[l], gla_norm_g[l], hgrn_norm_g[l],
                             w_br_a[l], w_br_b[l], w_br_c[l], w_out[l])
        x = x + rms_norm(mixed, mix_post_g[l])
        x = x + 0.5 * rms_norm(swiglu(rms_norm(x, ffn2_pre_g[l]), ffn2_w_gate[l], ffn2_w_up[l],
                                      ffn2_w_down[l]), ffn2_post_g[l])
    return x
```

```cpp
#include <hip/hip_runtime.h>
#include <cstdio>
#include <cstdint>
#ifndef FP8_S0
#define FP8_S0 6
#endif
#ifndef FP8_F2_S0
#define FP8_F2_S0 7
#endif
#ifndef LRUA_G
#define LRUA_G 5
#endif
#ifndef LRUC_G
#define LRUC_G 6
#endif
#ifndef REP_M2
#define REP_M2 1
#endif
#ifndef REP_M4
#define REP_M4 1
#endif
#ifndef REP_M5
#define REP_M5 1
#endif
#ifndef REP_M6
#define REP_M6 1
#endif
#ifndef REP_F1
#define REP_F1 1
#endif
#ifndef REP_F2
#define REP_F2 1
#endif
#ifndef REP_M1
#define REP_M1 1
#endif
#ifndef REP_M3
#define REP_M3 1
#endif
#ifndef REP_M7
#define REP_M7 1
#endif
#ifndef REP_M8
#define REP_M8 1
#endif
#ifndef REP_P0
#define REP_P0 1
#endif
#ifndef REP_LAG
#define REP_LAG 1
#endif
#ifndef REP_LAH
#define REP_LAH 1
#endif
#ifndef GEMM_SP2
#define GEMM_SP2 true
#endif
#ifndef GEMM_ALIGN
#define GEMM_ALIGN true
#endif
#ifndef PROBE_SECOND
#define PROBE_SECOND 0
#endif
#ifndef REP_RP
#define REP_RP 1
#endif
namespace pg8 {
#define PG8_LAS __attribute__((address_space(3)))
typedef unsigned short bf16_t;
typedef short bf16x8 __attribute__((ext_vector_type(8)));
typedef float f32x4 __attribute__((ext_vector_type(4)));
typedef unsigned u32x4 __attribute__((ext_vector_type(4)));
constexpr int BM = 256, BK = 64, HALF = 128, HTB = HALF * BK * 2  , STAGE_BYTES = 8 * HTB, NXCD = 8, WGM = 8;

__host__ __device__ __forceinline__ int lds_byte(int r, int c) { const int st = (r >> 4) * 2 + (c >> 5), rr = r & 15, cc = c & 31, ob = rr * 64 + cc * 2; return st * 1024 + (ob ^ (((ob >> 9) & 1) << 5)); }
__host__ __device__ __forceinline__ void stage_rc(int b, int& R, int& C) { const int st = b / 1024, sb = b % 1024, swz = sb ^ (((sb >> 9) & 1) << 5); R = (st >> 1) * 16 + swz / 64; C = (st & 1) * 32 + (swz % 64) / 2; }
__host__ __device__ __forceinline__ int perm32(int rho) { const int n = rho >> 4, i = rho & 15; return 8 * (i >> 2) + 4 * n + (i & 3); }

struct Unit { int pm, pn, seg; };
struct Gemm { const bf16_t* A; const bf16_t* Bt; int M, N, K, lda; };

struct StaticOrder {
    int nM, nN, nwg, G, c;
    __host__ __device__ void init(int M, int N, int G_, int c_) { nM = M / BM; nN = N / BM; nwg = nM * nN; G = G_; c = c_; }
    __host__ __device__ __forceinline__ bool next(int i, Unit& u) const {
        const long L = (long)i * G + c; if (L >= nwg) return false;
        int wgid = (int)L; { const int q = nwg / NXCD, r = nwg % NXCD, xcd = wgid % NXCD, off = wgid / NXCD; wgid = (xcd < r ? xcd * (q + 1) : r * (q + 1) + (xcd - r) * q) + off; }
        const int nig = WGM * nN, gid = wgid / nig, fm = gid * WGM, gsz = (nM - fm) < WGM ? (nM - fm) : WGM;
        u.pm = fm + ((wgid % nig) % gsz); u.pn = (wgid % nig) / gsz; u.seg = 0; return true;
    }
    __device__ __forceinline__ const char* pa(const Gemm& g, const Unit& u, size_t tstep) const { return (const char*)g.A + (size_t)u.pm * tstep; }
    __device__ __forceinline__ const char* pb(const Gemm& g, const Unit& u, size_t tstep) const { return (const char*)g.Bt + (size_t)u.pn * tstep; }
    __device__ __forceinline__ void a_ready(const Unit&) const {}
    __device__ __forceinline__ void done(const Unit&) const {}
};

typedef float f32x2c __attribute__((ext_vector_type(2))); typedef __bf16 bf16x2c __attribute__((ext_vector_type(2)));
__device__ __forceinline__ unsigned cvt_pk_bf16(float lo, float hi) { f32x2c v = {lo, hi}; bf16x2c b = __builtin_convertvector(v, bf16x2c); return __builtin_bit_cast(unsigned, b); }
typedef float f32x2 __attribute__((ext_vector_type(2)));
__device__ __forceinline__ float bf_lo(unsigned w) { return __uint_as_float(w << 16); }
__device__ __forceinline__ float bf_hi(unsigned w) { return __uint_as_float(w & 0xffff0000u); }
__device__ __forceinline__ float sigmoidf_fast(float x) { return __builtin_amdgcn_rcpf(1.0f + __builtin_amdgcn_exp2f(-1.44269504089f * x)); }
typedef unsigned u32x2 __attribute__((ext_vector_type(2)));

struct EpiF32 {
    static constexpr bool PERM = false, AFTER_DRAIN = false, SEGMENTED = false;
    float* C; int ldc;
    __device__ __forceinline__ void operator()(const f32x4 (&acc)[2][2][4][2], const Unit& u, int wr, int wc, int fr, int fq) const {
        const int row0 = u.pm * BM + wr * 64 + fr, col0 = u.pn * BM + wc * 32 + 4 * fq;
#pragma unroll
        for (int ai = 0; ai < 2; ++ai)
#pragma unroll
            for (int m = 0; m < 4; ++m) { float* rowp = C + (size_t)(row0 + ai * HALF + m * 16) * ldc + col0;
#pragma unroll
                for (int bj = 0; bj < 2; ++bj)
#pragma unroll
                    for (int n = 0; n < 2; ++n) *(f32x4*)(rowp + bj * HALF + n * 16) = acc[ai][bj][m][n]; }
    }
};
struct EpiRawBf16 {
    static constexpr bool PERM = true, AFTER_DRAIN = false, SEGMENTED = false;
    bf16_t* O; int ldc;
    __device__ __forceinline__ void operator()(const f32x4 (&acc)[2][2][4][2], const Unit& u, int wr, int wc, int fr, int fq) const {
        const int row0 = u.pm * BM + wr * 64 + fr, col0 = u.pn * BM + wc * 32 + 8 * fq;
#pragma unroll
        for (int ai = 0; ai < 2; ++ai)
#pragma unroll
            for (int m = 0; m < 4; ++m) { bf16_t* rowp = O + (size_t)(row0 + ai * HALF + m * 16) * ldc + col0;
#pragma unroll
                for (int bj = 0; bj < 2; ++bj) { const f32x4 v0 = acc[ai][bj][m][0], v1 = acc[ai][bj][m][1];
                    u32x4 w; w.x = cvt_pk_bf16(v0[0], v0[1]); w.y = cvt_pk_bf16(v0[2], v0[3]); w.z = cvt_pk_bf16(v1[0], v1[1]); w.w = cvt_pk_bf16(v1[2], v1[3]);
                    *(u32x4*)(rowp + bj * HALF) = w; } }
    }
};
struct EpiWin {
    static constexpr bool PERM = true, AFTER_DRAIN = false, SEGMENTED = false;
    bf16_t* O; int ldc; const float* lb;
    __device__ __forceinline__ void operator()(const f32x4 (&acc)[2][2][4][2], const Unit& u, int wr, int wc, int fr, int fq) const {
        const int row0 = u.pm * BM + wr * 64 + fr, colt = wc * 32 + 8 * fq;
        const int kind = (u.pn == 8 || u.pn == 9) ? 1 : ((u.pn >= 20 && u.pn < 24) ? 2 : ((u.pn >= 24 && u.pn < 28) ? 3 : 0));
        float lbv[2][8];
#pragma unroll
        for (int bj = 0; bj < 2; ++bj)
#pragma unroll
            for (int k = 0; k < 8; ++k) lbv[bj][k] = kind == 3 ? lb[(u.pn - 24) * BM + bj * HALF + colt + k] : 0.f;
#pragma unroll
        for (int ai = 0; ai < 2; ++ai)
#pragma unroll
            for (int m = 0; m < 4; ++m) { const size_t row = (size_t)(row0 + ai * HALF + m * 16);
#pragma unroll
                for (int bj = 0; bj < 2; ++bj) { const f32x4 v0 = acc[ai][bj][m][0], v1 = acc[ai][bj][m][1];
                    f32x4 x0 = v0, x1 = v1;
                    if (kind == 1) { x0 = x0 * 0.08838834764831845f; x1 = x1 * 0.08838834764831845f; }
                    else if (kind == 2) {
#pragma unroll
                        for (int j = 0; j < 4; ++j) { x0[j] = x0[j] * sigmoidf_fast(x0[j]); x1[j] = x1[j] * sigmoidf_fast(x1[j]); } }
                    else if (kind == 3) {
#pragma unroll
                        for (int j = 0; j < 4; ++j) { const float la = lbv[bj][j], lc = lbv[bj][4 + j];
                            x0[j] = 0.69314718056f * __builtin_amdgcn_logf(la + (1.0f - la) * sigmoidf_fast(x0[j])); x1[j] = 0.69314718056f * __builtin_amdgcn_logf(lc + (1.0f - lc) * sigmoidf_fast(x1[j])); } }
                    u32x4 w; w.x = cvt_pk_bf16(x0[0], x0[1]); w.y = cvt_pk_bf16(x0[2], x0[3]); w.z = cvt_pk_bf16(x1[0], x1[1]); w.w = cvt_pk_bf16(x1[2], x1[3]);
                    *(u32x4*)(O + row * ldc + u.pn * BM + colt + bj * HALF) = w; } }
    }
};
struct EpiWinGate {
    static constexpr bool PERM = true, AFTER_DRAIN = false, SEGMENTED = false;
    unsigned char* Q; float sc;
    __device__ __forceinline__ void operator()(const f32x4 (&acc)[2][2][4][2], const Unit& u, int wr, int wc, int fr, int fq) const {
        const int row0 = u.pm * BM + wr * 64 + fr, colt = wc * 32 + 8 * fq;
#pragma unroll
        for (int ai = 0; ai < 2; ++ai)
#pragma unroll
            for (int m = 0; m < 4; ++m) { const size_t row = (size_t)(row0 + ai * HALF + m * 16);
#pragma unroll
                for (int bj = 0; bj < 2; ++bj) { const f32x4 v0 = acc[ai][bj][m][0] * sc, v1 = acc[ai][bj][m][1] * sc; unsigned q[8];
#pragma unroll
                    for (int j = 0; j < 4; ++j) { const float s0 = 255.0f * __builtin_amdgcn_rcpf(1.0f + __builtin_amdgcn_exp2f(-1.44269504089f * __builtin_amdgcn_fmed3f(v0[j], -30.f, 30.f))) + 0.5f,
                                                              s1 = 255.0f * __builtin_amdgcn_rcpf(1.0f + __builtin_amdgcn_exp2f(-1.44269504089f * __builtin_amdgcn_fmed3f(v1[j], -30.f, 30.f))) + 0.5f;
                        q[j] = (unsigned)__builtin_amdgcn_fmed3f(s0, 1.0f, 255.0f); q[4 + j] = (unsigned)__builtin_amdgcn_fmed3f(s1, 1.0f, 255.0f); }
                    u32x2 w; w.x = q[0] | (q[1] << 8) | (q[2] << 16) | (q[3] << 24); w.y = q[4] | (q[5] << 8) | (q[6] << 16) | (q[7] << 24);
                    *(u32x2*)(Q + row * 6144 + u.pn * BM + colt + bj * HALF) = w; } }
    }
};
struct EpiGate8 {
    static constexpr bool PERM = true, AFTER_DRAIN = false, SEGMENTED = false;
    unsigned char* Q; const float* ba; const float* bx;
    __device__ __forceinline__ void operator()(const f32x4 (&acc)[2][2][4][2], const Unit& u, int wr, int wc, int fr, int fq) const {
        const int row0 = u.pm * BM + wr * 64 + fr, colt = wc * 32 + 8 * fq, ch = u.pn * HALF + colt;
        float b[2][8];
#pragma unroll
        for (int k = 0; k < 8; ++k) { b[0][k] = ba[ch + k]; b[1][k] = bx[ch + k]; }
#pragma unroll
        for (int ai = 0; ai < 2; ++ai)
#pragma unroll
            for (int m = 0; m < 4; ++m) { unsigned char* rowp = Q + (size_t)(row0 + ai * HALF + m * 16) * 2048 + u.pn * BM + colt;
#pragma unroll
                for (int bj = 0; bj < 2; ++bj) { const f32x4 v0 = acc[ai][bj][m][0], v1 = acc[ai][bj][m][1]; unsigned q[8];
#pragma unroll
                    for (int j = 0; j < 4; ++j) { q[j] = (unsigned)(255.0f * sigmoidf_fast(v0[j] + b[bj][j]) + 0.5f); q[4 + j] = (unsigned)(255.0f * sigmoidf_fast(v1[j] + b[bj][4 + j]) + 0.5f); }
                    u32x2 w; w.x = q[0] | (q[1] << 8) | (q[2] << 16) | (q[3] << 24); w.y = q[4] | (q[5] << 8) | (q[6] << 16) | (q[7] << 24);
                    *(u32x2*)(rowp + bj * HALF) = w; } }
    }
};
struct EpiSwiGLU {
    static constexpr bool PERM = true, AFTER_DRAIN = false, SEGMENTED = false;
    bf16_t* O; int ldc;
    __device__ __forceinline__ void operator()(const f32x4 (&acc)[2][2][4][2], const Unit& u, int wr, int wc, int fr, int fq) const {
        const int row0 = u.pm * BM + wr * 64 + fr, col0 = u.pn * HALF + wc * 32 + 8 * fq;
#pragma unroll
        for (int ai = 0; ai < 2; ++ai)
#pragma unroll
            for (int m = 0; m < 4; ++m) { bf16_t* rowp = O + (size_t)(row0 + ai * HALF + m * 16) * ldc + col0;
                float r[8];
#pragma unroll
                for (int n = 0; n < 2; ++n)
#pragma unroll
                    for (int j = 0; j < 4; ++j) { const float g = acc[ai][0][m][n][j], up = acc[ai][1][m][n][j]; r[n * 4 + j] = g * sigmoidf_fast(g) * up; }
                u32x4 w; w.x = cvt_pk_bf16(r[0], r[1]); w.y = cvt_pk_bf16(r[2], r[3]); w.z = cvt_pk_bf16(r[4], r[5]); w.w = cvt_pk_bf16(r[6], r[7]);
                *(u32x4*)rowp = w; }
    }
};
__device__ __forceinline__ unsigned cvt_pk4_fp8(float a, float b, float c, float d) { int w = 0; w = __builtin_amdgcn_cvt_pk_fp8_f32(a, b, w, false); w = __builtin_amdgcn_cvt_pk_fp8_f32(c, d, w, true); return (unsigned)w; }
struct EpiSwiGLU8 {
    static constexpr bool PERM = true, AFTER_DRAIN = false, SEGMENTED = false;
    bf16_t* O; int ldc; float sc; unsigned char* O8; float s8; PG8_LAS unsigned* mx;
    __device__ __forceinline__ void operator()(const f32x4 (&acc)[2][2][4][2], const Unit& u, int wr, int wc, int fr, int fq) const {
        const int row0 = u.pm * BM + wr * 64 + fr, col0 = u.pn * HALF + wc * 32 + 8 * fq;
        float lm = 0.f;
#pragma unroll
        for (int ai = 0; ai < 2; ++ai)
#pragma unroll
            for (int m = 0; m < 4; ++m) { const size_t ro = (size_t)(row0 + ai * HALF + m * 16) * ldc + col0;
                float r[8];
#pragma unroll
                for (int n = 0; n < 2; ++n)
#pragma unroll
                    for (int j = 0; j < 4; ++j) { const float g = acc[ai][0][m][n][j] * sc, up = acc[ai][1][m][n][j] * sc; r[n * 4 + j] = g * sigmoidf_fast(g) * up; }
                if (O8) {
#pragma unroll
                    for (int k = 0; k < 8; ++k) r[k] = __builtin_amdgcn_fmed3f(r[k] * s8, -448.0f, 448.0f);
                    u32x2 w; w.x = cvt_pk4_fp8(r[0], r[1], r[2], r[3]); w.y = cvt_pk4_fp8(r[4], r[5], r[6], r[7]); *(u32x2*)(O8 + ro) = w; }
                else {
#pragma unroll
                    for (int k = 0; k < 8; ++k) lm = fmaxf(lm, fabsf(r[k]));
                    u32x4 w; w.x = cvt_pk_bf16(r[0], r[1]); w.y = cvt_pk_bf16(r[2], r[3]); w.z = cvt_pk_bf16(r[4], r[5]); w.w = cvt_pk_bf16(r[6], r[7]);
                    *(u32x4*)(O + ro) = w; } }
        if (!O8 && mx) {
#pragma unroll
            for (int o = 1; o < 64; o <<= 1) lm = fmaxf(lm, __shfl_xor(lm, o));
            if ((fr | fq) == 0) __hip_atomic_fetch_max(mx, __float_as_uint(lm), __ATOMIC_RELAXED, __HIP_MEMORY_SCOPE_WORKGROUP);
            asm volatile("s_waitcnt lgkmcnt(0)" ::: "memory"); }
    }
};
struct EpiRaw8 {
    static constexpr bool PERM = true, AFTER_DRAIN = false, SEGMENTED = false;
    bf16_t* O; int ldc; float sc;
    __device__ __forceinline__ void operator()(const f32x4 (&acc)[2][2][4][2], const Unit& u, int wr, int wc, int fr, int fq) const {
        const int row0 = u.pm * BM + wr * 64 + fr, col0 = u.pn * BM + wc * 32 + 8 * fq;
#pragma unroll
        for (int ai = 0; ai < 2; ++ai)
#pragma unroll
            for (int m = 0; m < 4; ++m) { bf16_t* rowp = O + (size_t)(row0 + ai * HALF + m * 16) * ldc + col0;
#pragma unroll
                for (int bj = 0; bj < 2; ++bj) { const f32x4 v0 = acc[ai][bj][m][0] * sc, v1 = acc[ai][bj][m][1] * sc;
                    u32x4 w; w.x = cvt_pk_bf16(v0[0], v0[1]); w.y = cvt_pk_bf16(v0[2], v0[3]); w.z = cvt_pk_bf16(v1[0], v1[1]); w.w = cvt_pk_bf16(v1[2], v1[3]);
                    *(u32x4*)(rowp + bj * HALF) = w; } }
    }
};
struct GateOrder : StaticOrder {
    __device__ __forceinline__ const char* pa(const Gemm& g, const Unit& u, size_t tstep) const { return (const char*)g.A + (size_t)(u.pn >> 1) * 512 + (size_t)u.pm * tstep; }
};
struct BranchOrder : StaticOrder {
    size_t astride, bstride;
    __device__ __forceinline__ bool next(int i, Unit& u) const { const int ti = i / 3, sg = i - 3 * ti; if (!StaticOrder::next(ti, u)) return false; u.seg = sg; return true; }
    __device__ __forceinline__ const char* pa(const Gemm& g, const Unit& u, size_t tstep) const { return (const char*)g.A + (size_t)u.seg * astride + (size_t)u.pm * tstep; }
    __device__ __forceinline__ const char* pb(const Gemm& g, const Unit& u, size_t tstep) const { return (const char*)g.Bt + (size_t)u.seg * bstride + (size_t)u.pn * tstep; }
};
__device__ __forceinline__ float ub0(unsigned w) { return (float)(w & 0xFFu); }
__device__ __forceinline__ float ub1(unsigned w) { return (float)((w >> 8) & 0xFFu); }
__device__ __forceinline__ float ub2(unsigned w) { return (float)((w >> 16) & 0xFFu); }
__device__ __forceinline__ float ub3(unsigned w) { return (float)(w >> 24); }
struct EpiBranchFused {
    static constexpr bool PERM = true, AFTER_DRAIN = false, SEGMENTED = true;
    const unsigned char* Q; bf16_t* MO; int ld;
    __device__ __forceinline__ void operator()(f32x4 (&acc)[2][2][4][2], const Unit& u, int wr, int wc, int fr, int fq) const {
        const int row0 = u.pm * BM + wr * 64 + fr, col0 = u.pn * BM + wc * 32 + 8 * fq; const int sg = u.seg; const bool fin = sg == 2;
        const unsigned char* qn = Q + (size_t)row0 * 6144 + sg * 2048 + col0; const unsigned char* qd = fin ? qn : qn + 2048;
        u32x2 gn[2][4][2], gd[2][4][2];
#define BR_LOAD(ai_) do { _Pragma("unroll") for (int m = 0; m < 4; ++m) _Pragma("unroll") for (int bj = 0; bj < 2; ++bj) { const size_t go = (size_t)((ai_) * HALF + m * 16) * 6144 + bj * HALF; \
            gn[ai_][m][bj] = *(const u32x2*)(qn + go); gd[ai_][m][bj] = *(const u32x2*)(qd + go); } } while (0)
        BR_LOAD(0); BR_LOAD(1);
#pragma unroll
        for (int ai = 0; ai < 2; ++ai) {
#pragma unroll
            for (int m = 0; m < 4; ++m)
#pragma unroll
                for (int bj = 0; bj < 2; ++bj) { const u32x2 a = gn[ai][m][bj], d = gd[ai][m][bj];
                    const float an[8] = {ub0(a.x), ub1(a.x), ub2(a.x), ub3(a.x), ub0(a.y), ub1(a.y), ub2(a.y), ub3(a.y)};
                    const float dn[8] = {ub0(d.x), ub1(d.x), ub2(d.x), ub3(d.x), ub0(d.y), ub1(d.y), ub2(d.y), ub3(d.y)};
                    float f[8];
#pragma unroll
                    for (int k = 0; k < 8; ++k) { const float rd = __builtin_amdgcn_rcpf(dn[k]); f[k] = an[k] * (fin ? (1.0f / 255.0f) : rd); }
                    f32x4 v0 = acc[ai][bj][m][0], v1 = acc[ai][bj][m][1];
                    v0[0] *= f[0]; v0[1] *= f[1]; v0[2] *= f[2]; v0[3] *= f[3]; v1[0] *= f[4]; v1[1] *= f[5]; v1[2] *= f[6]; v1[3] *= f[7];
                    acc[ai][bj][m][0] = v0; acc[ai][bj][m][1] = v1;
                    if (fin) { u32x4 w; w.x = cvt_pk_bf16(v0[0], v0[1]); w.y = cvt_pk_bf16(v0[2], v0[3]); w.z = cvt_pk_bf16(v1[0], v1[1]); w.w = cvt_pk_bf16(v1[2], v1[3]);
                        *(u32x4*)(MO + (size_t)(row0 + ai * HALF + m * 16) * ld + col0 + bj * HALF) = w; } }
        }
#undef BR_LOAD
    }
};

typedef int i32x4 __attribute__((ext_vector_type(4))); typedef int i32x8 __attribute__((ext_vector_type(8)));
__device__ __forceinline__ i32x8 cat8(const bf16x8 a, const bf16x8 b) { const i32x4 x = __builtin_bit_cast(i32x4, a), y = __builtin_bit_cast(i32x4, b); return __builtin_shufflevector(x, y, 0, 1, 2, 3, 4, 5, 6, 7); }
__device__ __forceinline__ void mfma_fp8_acc(f32x4& acc, const i32x8 b, const i32x8 a) { asm volatile("v_mfma_f32_16x16x128_f8f6f4 %0, %1, %2, %0" : "+v"(acc) : "v"(b), "v"(a)); }
template <class Epi, class Sched, bool ALIGN_EPI = false, bool SP2 = false, int LDA = 0  , bool FP8 = false>
__device__ __forceinline__ void gemm_phase(PG8_LAS unsigned char* lds, const Gemm g, const Sched& S, const Epi& E) {
    int tid_l = threadIdx.x; asm volatile("" : "+v"(tid_l)); const int tid = tid_l, wid = __builtin_amdgcn_readfirstlane(tid >> 6), lane = tid & 63, wr = wid >> 2, wc = wid & 3, fr = lane & 15, fq = lane >> 4;
    const int K = g.K, nt = K / BK;
    unsigned voffA[2], voffB[2];
#pragma unroll
    for (int i = 0; i < 2; ++i) { int R, C; stage_rc(tid * 16 + i * 8192, R, C); const int Rb = Epi::PERM ? ((R & ~31) + perm32(R & 31)) : R;
        voffA[i] = (unsigned)(R * (LDA ? LDA : K) + C) * 2u; voffB[i] = (unsigned)(Rb * K + C) * 2u; }
    const size_t kstep = (size_t)(BK * 2);
    const size_t hstepB = (size_t)HALF * K * 2, hstepA = LDA ? (size_t)HALF * LDA * 2 : hstepB;
    const size_t tstepA = 2 * hstepA, tstepB = 2 * hstepB;
    const unsigned ldsw = (unsigned)wid * 1024u;
    const int aoff = lds_byte(wr * 64 + fr, fq * 8), boff = lds_byte(wc * 32 + fr, fq * 8);
#define PG8_SA(b, h) (((b) * 2 + (h)) * HTB)
#define PG8_SB(b, h) ((4 + (b) * 2 + (h)) * HTB)
#define PG8_STAGE(bufoff, gbase, voff) do { _Pragma("unroll") for (int _i = 0; _i < 2; ++_i) \
        __builtin_amdgcn_global_load_lds((const unsigned*)((const char*)(gbase) + (voff)[_i]), (PG8_LAS unsigned*)(lds + (bufoff) + ldsw + _i * 8192), 16, 0, 0); } while (0)
#define PG8_LDA(dst, b, h) do { _Pragma("unroll") for (int m = 0; m < 4; ++m) _Pragma("unroll") for (int k = 0; k < 2; ++k) dst[m][k] = *(const PG8_LAS bf16x8*)(lds + PG8_SA(b, h) + aoff + m * 2048 + k * 1024); } while (0)
#define PG8_LDB(dst, b, h) do { _Pragma("unroll") for (int n = 0; n < 2; ++n) _Pragma("unroll") for (int k = 0; k < 2; ++k) dst[n][k] = *(const PG8_LAS bf16x8*)(lds + PG8_SB(b, h) + boff + n * 2048 + k * 1024); } while (0)
#define PG8_MMA(ai, bj, At, Bt) do { __builtin_amdgcn_s_setprio(1); _Pragma("unroll") for (int m = 0; m < 4; ++m) _Pragma("unroll") for (int n = 0; n < 2; ++n) { \
        if constexpr (FP8) mfma_fp8_acc(acc[ai][bj][m][n], cat8(Bt[n][0], Bt[n][1]), cat8(At[m][0], At[m][1])); \
        else { _Pragma("unroll") for (int k = 0; k < 2; ++k) acc[ai][bj][m][n] = __builtin_amdgcn_mfma_f32_16x16x32_bf16(Bt[n][k], At[m][k], acc[ai][bj][m][n], 0, 0, 0); } } __builtin_amdgcn_s_setprio(0); } while (0)
#define PG8_WAIT_V(n) asm volatile("s_waitcnt vmcnt(" #n ")" ::: "memory")
#define PG8_WAIT_L(n) asm volatile("s_waitcnt lgkmcnt(" #n ")" ::: "memory")
#define PG8_BAR __builtin_amdgcn_s_barrier()
#define PG8_SCHED __builtin_amdgcn_sched_barrier(0)
    Unit cur, nxt; int ui = 0;
    if (!S.next(0, cur)) return;
    f32x4 acc[2][2][4][2];
#pragma unroll
    for (int a = 0; a < 2; ++a)
#pragma unroll
        for (int b = 0; b < 2; ++b)
#pragma unroll
            for (int m = 0; m < 4; ++m)
#pragma unroll
                for (int n = 0; n < 2; ++n) acc[a][b][m][n] = (f32x4){0.f, 0.f, 0.f, 0.f};
    bf16x8 At[4][2], B0[2][2], B1[2][2];
    const char* cA = S.pa(g, cur, tstepA); const char* cB = S.pb(g, cur, tstepB);
    S.a_ready(cur);
    if constexpr (SP2) {
        PG8_STAGE(PG8_SB(0, 0), cB, voffB); PG8_STAGE(PG8_SB(0, 1), cB + hstepB, voffB); PG8_STAGE(PG8_SA(0, 0), cA, voffA); PG8_STAGE(PG8_SA(0, 1), cA + hstepA, voffA);
        if (wr == 1) PG8_BAR;
        PG8_WAIT_V(2); PG8_BAR;
        PG8_STAGE(PG8_SB(1, 0), cB + kstep, voffB); PG8_STAGE(PG8_SA(1, 0), cA + kstep, voffA); PG8_STAGE(PG8_SB(1, 1), cB + hstepB + kstep, voffB);
        PG8_WAIT_V(6); PG8_BAR;
    } else {
        PG8_STAGE(PG8_SB(0, 0), cB, voffB); PG8_STAGE(PG8_SA(0, 0), cA, voffA); PG8_STAGE(PG8_SB(0, 1), cB + hstepB, voffB); PG8_STAGE(PG8_SA(0, 1), cA + hstepA, voffA);
        if (wr == 1) PG8_BAR;
        PG8_WAIT_V(4); PG8_BAR;
        PG8_STAGE(PG8_SB(1, 0), cB + kstep, voffB); PG8_STAGE(PG8_SA(1, 0), cA + kstep, voffA); PG8_STAGE(PG8_SB(1, 1), cB + hstepB + kstep, voffB);
        PG8_WAIT_V(6); PG8_BAR;
    }
    for (;;) {
        const bool has_next = S.next(ui + 1, nxt);
        const char* nA = has_next ? S.pa(g, nxt, tstepA) : cA; const char* nB = has_next ? S.pb(g, nxt, tstepB) : cB;
        for (int t = 0; t < nt; t += 2) {
            const bool last = (t == nt - 2);
            const char* a1 = cA + (size_t)(t + 1) * kstep;
            const char* a2 = last ? nA : cA + (size_t)(t + 2) * kstep; const char* b2 = last ? nB : cB + (size_t)(t + 2) * kstep;
            const char* a3 = a2 + kstep; const char* b3 = b2 + kstep;
            if (last && has_next) S.a_ready(nxt);
            if constexpr (SP2) {
            PG8_LDB(B0, 0, 0); PG8_LDB(B1, 0, 1); PG8_SCHED; PG8_LDA(At, 0, 0); PG8_STAGE(PG8_SA(1, 1), a1 + hstepA, voffA);
            PG8_WAIT_V(8); PG8_WAIT_L(0); PG8_BAR; PG8_MMA(0, 0, At, B0); PG8_MMA(0, 1, At, B1); PG8_BAR; PG8_SCHED;
            PG8_LDA(At, 0, 1); PG8_STAGE(PG8_SB(0, 0), b2, voffB); PG8_STAGE(PG8_SB(0, 1), b2 + hstepB, voffB); PG8_STAGE(PG8_SA(0, 0), a2, voffA);
            PG8_WAIT_V(8); PG8_WAIT_L(0); PG8_BAR; PG8_MMA(1, 0, At, B0); PG8_MMA(1, 1, At, B1); PG8_BAR; PG8_SCHED;
            PG8_LDB(B0, 1, 0); PG8_LDB(B1, 1, 1); PG8_SCHED; PG8_LDA(At, 1, 0); PG8_STAGE(PG8_SA(0, 1), a2 + hstepA, voffA);
            PG8_WAIT_V(8); PG8_WAIT_L(0); PG8_BAR; PG8_MMA(0, 0, At, B0); PG8_MMA(0, 1, At, B1); PG8_BAR; PG8_SCHED;
            PG8_LDA(At, 1, 1); PG8_STAGE(PG8_SB(1, 0), b3, voffB); PG8_STAGE(PG8_SB(1, 1), b3 + hstepB, voffB); PG8_STAGE(PG8_SA(1, 0), a3, voffA);
            PG8_WAIT_V(8); PG8_WAIT_L(0); PG8_BAR; PG8_MMA(1, 0, At, B0); PG8_MMA(1, 1, At, B1); PG8_BAR; PG8_SCHED;
            } else {
            PG8_LDB(B0, 0, 0); PG8_SCHED; PG8_LDA(At, 0, 0); PG8_STAGE(PG8_SA(1, 1), a1 + hstepA, voffA);
            PG8_WAIT_L(8); PG8_BAR; PG8_WAIT_L(0); PG8_MMA(0, 0, At, B0); PG8_BAR; PG8_SCHED;
            PG8_LDB(B1, 0, 1); PG8_STAGE(PG8_SB(0, 0), b2, voffB);
            PG8_BAR; PG8_WAIT_L(0); PG8_MMA(0, 1, At, B1); PG8_BAR;
            PG8_LDA(At, 0, 1); PG8_STAGE(PG8_SA(0, 0), a2, voffA);
            PG8_BAR; PG8_WAIT_L(0); PG8_MMA(1, 0, At, B0); PG8_BAR; PG8_SCHED;
            PG8_STAGE(PG8_SB(0, 1), b2 + hstepB, voffB);
            PG8_WAIT_V(6); PG8_BAR; PG8_MMA(1, 1, At, B1); PG8_BAR;
            PG8_LDB(B0, 1, 0); PG8_SCHED; PG8_LDA(At, 1, 0); PG8_STAGE(PG8_SA(0, 1), a2 + hstepA, voffA);
            PG8_WAIT_L(8); PG8_BAR; PG8_WAIT_L(0); PG8_MMA(0, 0, At, B0); PG8_BAR; PG8_SCHED;
            PG8_LDB(B1, 1, 1); PG8_STAGE(PG8_SB(1, 0), b3, voffB);
            PG8_BAR; PG8_WAIT_L(0); PG8_MMA(0, 1, At, B1); PG8_BAR;
            PG8_LDA(At, 1, 1); PG8_STAGE(PG8_SA(1, 0), a3, voffA);
            PG8_BAR; PG8_WAIT_L(0); PG8_MMA(1, 0, At, B0); PG8_BAR; PG8_SCHED;
            PG8_STAGE(PG8_SB(1, 1), b3 + hstepB, voffB);
            PG8_WAIT_V(6); PG8_BAR; PG8_MMA(1, 1, At, B1); PG8_BAR;
            }
        }
        if constexpr (ALIGN_EPI) { if (wr == 0) PG8_BAR; }
        if constexpr (FP8) asm volatile("s_nop 15\n\ts_nop 15" ::: "memory");
        if constexpr (!Epi::AFTER_DRAIN) { E(acc, cur, wr, wc, fr, fq); S.done(cur); }
        if (!has_next) break;
        if (!Epi::SEGMENTED || cur.seg == 2)
#pragma unroll
        for (int a = 0; a < 2; ++a)
#pragma unroll
            for (int b = 0; b < 2; ++b)
#pragma unroll
                for (int m = 0; m < 4; ++m)
#pragma unroll
                    for (int n = 0; n < 2; ++n) acc[a][b][m][n] = (f32x4){0.f, 0.f, 0.f, 0.f};
        cur = nxt; cA = nA; cB = nB; ++ui;
        if constexpr (ALIGN_EPI) { if (wr == 1) PG8_BAR; }
    }
    PG8_WAIT_V(0);
    if constexpr (!ALIGN_EPI) { if (wr == 0) PG8_BAR; }
    PG8_BAR;
    if constexpr (Epi::AFTER_DRAIN) { E.fused(acc, cur, wr, wc, fr, fq, lds, wid, lane); S.done(cur); }
#undef PG8_SA
#undef PG8_SB
#undef PG8_STAGE
#undef PG8_LDA
#undef PG8_LDB
#undef PG8_MMA
#undef PG8_WAIT_V
#undef PG8_WAIT_L
#undef PG8_BAR
#undef PG8_SCHED
}
}

constexpr int NWAVES = 8;
constexpr int M = 16384, D = 2048, FF = 5632, SEQ = 8192, NL = 4;
constexpr int IN_W = 15376, NIN = 15360, PW = 9216;
constexpr int P_AX = 0, P_AG = 1024, P_BQ = 2048, P_BK = 2560, P_BV = 3072, P_BG = 4096, P_CQ = 5120, P_CF = 6144, P_CI = 7168, P_CG = 8192, P_MG = 9216;
#ifndef H_PITCH
#define H_PITCH 2048
#endif
constexpr int HP = H_PITCH;
constexpr float EPS = 1e-6f;
constexpr size_t MiB = 1u << 20;
constexpr size_t WS_CTL = 0, CTL_ZERO_BYTES = 1 * MiB;
constexpr size_t WS_LB = 1 * MiB;
constexpr size_t WS_CA = 2 * MiB, WS_CH = 3 * MiB, WS_HIN = 4 * MiB, WS_LDT = 5 * MiB;
constexpr size_t WS_W = 8 * MiB, WL_STRIDE = 217 * MiB;
constexpr size_t WL_GU1 = 0, WL_D1 = 44 * MiB, WL_IN = 66 * MiB, WL_GT = 127 * MiB, WL_BR = 131 * MiB, WL_OUT = 143 * MiB, WL_GU2 = 151 * MiB, WL_D2 = 195 * MiB;
constexpr size_t WS_MGQ = (1068 + 288) * MiB;
constexpr size_t WS_XH = 940 * MiB, WS_XL = 1004 * MiB;
constexpr size_t WS_H = 876 * MiB, WS_Y = (1068 + 256) * MiB  , WS_P = 1068 * MiB, WS_YA = 1556 * MiB, WS_YB = 1588 * MiB, WS_YC = 1620 * MiB, WS_XC = 1652 * MiB, WS_GT = 1684 * MiB, WS_MG = 1748 * MiB, WS_SLOC = 1812 * MiB, WS_GG = 1844 * MiB, WS_SIN = 1876 * MiB, WS_END = 1908 * MiB;
static_assert(WS_W + 4 * WL_STRIDE <= WS_H && WS_P + (size_t)M * PW * 2 <= WS_YA, "ws map");
constexpr int CW_TMO = 0, CW_CODE = 1, CW_WMAX = 64  , CW_SMAX = CW_WMAX + 8  , CW_BAR = 4096;
constexpr size_t WS_H8 = 1036 * MiB;
constexpr int RING_OFF = 0, RING_BYTES = 131072;
constexpr int LDSCTL_OFF = 149504, MISC_OFF = LDSCTL_OFF + 320;
constexpr int LDS_BYTES = 155648;

#define GAS __attribute__((address_space(1)))
#define LAS __attribute__((address_space(3)))
typedef unsigned short bf16;
typedef unsigned v4u __attribute__((ext_vector_type(4)));
typedef unsigned v2u __attribute__((ext_vector_type(2)));
typedef float f32x4 __attribute__((ext_vector_type(4)));
typedef float f32x2 __attribute__((ext_vector_type(2)));
typedef GAS unsigned gu32;
static_assert(FP8_F2_S0 >= 2 * NL - 1 && FP8_F2_S0 - 1 >= FP8_S0, "fp8 down GEMM: only the last FFN, and the half-step before it must be an fp8 gate|up step");
#define RLX_AGENT __ATOMIC_RELAXED, __HIP_MEMORY_SCOPE_AGENT
#define LDS_WAIT() asm volatile("s_waitcnt lgkmcnt(0)" ::: "memory")
#define VM_WAIT() asm volatile("s_waitcnt vmcnt(0)" ::: "memory")
typedef float f32x2_t __attribute__((ext_vector_type(2))); typedef __bf16 bf16x2_t __attribute__((ext_vector_type(2)));
__device__ __forceinline__ unsigned pk2(float lo, float hi) { f32x2_t v = {lo, hi}; bf16x2_t b = __builtin_convertvector(v, bf16x2_t); return __builtin_bit_cast(unsigned, b); }
__device__ __forceinline__ unsigned f2bf(float f) { return pk2(f, 0.f) & 0xffffu; }
__device__ __forceinline__ float bf2f(unsigned short b) { return __uint_as_float(((unsigned)b) << 16); }
__device__ __forceinline__ float blo(unsigned w) { return __uint_as_float(w << 16); }
__device__ __forceinline__ float bhi(unsigned w) { return __uint_as_float(w & 0xffff0000u); }
__device__ __forceinline__ float fexp(float x) { return __builtin_amdgcn_exp2f(1.44269504089f * x); }
__device__ __forceinline__ float flog(float x) { return 0.69314718056f * __builtin_amdgcn_logf(x); }
__device__ __forceinline__ float frcp(float x) { return __builtin_amdgcn_rcpf(x); }
__device__ __forceinline__ float sigm(float x) { return frcp(1.0f + __builtin_amdgcn_exp2f(-1.44269504089f * x)); }
__device__ __forceinline__ float log_sigm(float x) { return fminf(x, 0.f) - flog(1.0f + fexp(-fabsf(x))); }
__device__ __forceinline__ float gelu_tanh(float x) { const float u = 0.7978845608028654f * (x + 0.044715f * x * x * x); const float t = 1.0f - 2.0f * frcp(fexp(2.0f * u) + 1.0f); return 0.5f * x * (1.0f + t); }
__device__ __forceinline__ float neg_expm1(float x, float ex) { const float ser = -x * (1.0f + x * (0.5f + x * (0.16666667f + x * (0.041666668f + x * 0.0083333338f)))); return x > -0.1f ? ser : 1.0f - ex; }

#define XB_TMO      128
#define XB_XCNT(j)  (256  + 64 * (j))
#define XB_XSUB(j)  (1280 + 64 * (j))
#define XB_XGEN(j)  (2304 + 64 * (j))
#define XB_TOP      3328
#define XB_TOPGEN   3392
#define XCD_BAR_WORDS 3456
#define XB_SPIN_CAP (1u << 18)

__device__ __forceinline__ unsigned xb_ld(unsigned* p)              { return __hip_atomic_load(p, __ATOMIC_RELAXED, __HIP_MEMORY_SCOPE_AGENT); }
__device__ __forceinline__ unsigned xb_add(unsigned* p, unsigned v) { return __hip_atomic_fetch_add(p, v, __ATOMIC_RELAXED, __HIP_MEMORY_SCOPE_AGENT); }
__device__ __forceinline__ unsigned xb_xcc_id() { return (unsigned)__builtin_amdgcn_s_getreg((3 << 11) | 20) & 0xFu; }
#define XB_SPIN(cond, bar) do { unsigned _sp = 0; while (cond) { __builtin_amdgcn_s_sleep(1); \
    if ((++_sp & 255u) == 0u) { if (xb_ld(&(bar)[XB_TMO])) break; if (_sp > XB_SPIN_CAP) { atomicAdd(&(bar)[XB_TMO], 1u); break; } } } } while (0)

struct XcdBarrier {
    unsigned* bar; unsigned x;
    volatile LAS unsigned* st;
};

__device__ __forceinline__ XcdBarrier xcd_barrier_post(unsigned* bar, volatile LAS unsigned* st) {
    XcdBarrier b; b.bar = bar; b.x = xb_xcc_id(); b.st = st;
    if (threadIdx.x == 0) (void)xb_add(&bar[XB_XCNT(b.x)], 1u);
    return b;
}
__device__ __forceinline__ void xcd_barrier_complete(unsigned* bar, unsigned x, unsigned& nloc, unsigned& nx) {
    const unsigned G = gridDim.x * gridDim.y * gridDim.z;
    unsigned sum, cnt, mine, sp = 0u;
    for (;;) {
        sum = 0u; cnt = 0u; mine = 0u;
#pragma unroll
        for (unsigned j = 0; j < 16; ++j) { const unsigned c = xb_ld(&bar[XB_XCNT(j)]); sum += c; cnt += (c > 0u) ? 1u : 0u; mine = (j == x) ? c : mine; }
        if (sum == G) break;
        __builtin_amdgcn_s_sleep(1);
        if ((++sp & 255u) == 0u) { if (xb_ld(&bar[XB_TMO])) break; if (sp > XB_SPIN_CAP) { atomicAdd(&bar[XB_TMO], 1u); break; } }
    }
    nloc = mine > 0u ? mine : 1u; nx = cnt > 0u ? cnt : 1u;
}

__device__ __forceinline__ void xcd_barrier(const XcdBarrier& b) {
    asm volatile("s_waitcnt vmcnt(0)" ::: "memory");
    __syncthreads();
    if (threadIdx.x == 0) {
        unsigned* bar = b.bar;
        __builtin_amdgcn_s_waitcnt(0);
        unsigned nloc = b.st[0], nx = b.st[1];
        if (nloc == 0u) { xcd_barrier_complete(bar, b.x, nloc, nx); b.st[0] = nloc; b.st[1] = nx; }
        const unsigned old = xb_add(&bar[XB_XSUB(b.x)], 1u);
        const unsigned gen = old / nloc;
        if (old + 1u == (gen + 1u) * nloc) {
            __builtin_amdgcn_fence(__ATOMIC_RELEASE, "agent");
            asm volatile("s_waitcnt vmcnt(0)" ::: "memory");
            const unsigned og = xb_add(&bar[XB_TOP], 1u);
            const unsigned tg = og / nx;
            if (og + 1u == (tg + 1u) * nx) xb_add(&bar[XB_TOPGEN], 1u);
            else XB_SPIN(xb_ld(&bar[XB_TOPGEN]) == tg, bar);
            __builtin_amdgcn_fence(__ATOMIC_ACQUIRE, "agent");
            xb_add(&bar[XB_XGEN(b.x)], 1u);
            asm volatile("s_waitcnt vmcnt(0)" ::: "memory");
        } else {
            XB_SPIN(xb_ld(&bar[XB_XGEN(b.x)]) == gen, bar);
            __builtin_amdgcn_fence(__ATOMIC_ACQUIRE, "agent");
            asm volatile("s_waitcnt vmcnt(0)" ::: "memory");
        }
    }
    __syncthreads();
}

struct Args { const float* in[30]; float* out; unsigned char* ws; int ph_lo, ph_hi; };
struct Frame {
    LAS unsigned char* lds;
    volatile LAS unsigned* MISC;
    gu32* ctl;
    int tid, lane, wave, vcu, G, bx;
};
__device__ __forceinline__ float wave_sum(float v) {
#pragma unroll
    for (int o = 1; o < 64; o <<= 1) v += __shfl_xor(v, o);
    return v;
}
__device__ __forceinline__ unsigned pk4_fp8(float a, float b, float c, float d) { int w = 0; w = __builtin_amdgcn_cvt_pk_fp8_f32(a, b, w, false); w = __builtin_amdgcn_cvt_pk_fp8_f32(c, d, w, true); return (unsigned)w; }
__device__ __forceinline__ float pow2_floor(float t) { return __uint_as_float(__float_as_uint(t) & 0x7F800000u); }
__device__ __forceinline__ float fp8_scale(float amax) { return pow2_floor(fminf(440.0f / fmaxf(amax, 1e-30f), 1.0e12f)); }
#ifndef FP8_HEAD
#define FP8_HEAD 8.0f
#endif
__device__ __forceinline__ bool wscale_ok(const unsigned char* ws, int slot) { const gu32* c = (const gu32*)(ws + WS_CTL);
    return __uint_as_float(c[CW_WMAX + slot]) * fp8_scale(FP8_HEAD * __uint_as_float(c[CW_SMAX + slot])) <= 448.0f; }
__device__ __forceinline__ float wscale(const unsigned char* ws, int slot) { const gu32* c = (const gu32*)(ws + WS_CTL);
    const float amax = __uint_as_float(c[CW_WMAX + slot]), s0 = fp8_scale(FP8_HEAD * __uint_as_float(c[CW_SMAX + slot])); return amax * s0 <= 448.0f ? s0 : fp8_scale(amax); }
__device__ __forceinline__ float h8_scale(const float* g, int ln) {
    float gm = 0.f;
#pragma unroll
    for (int j = 0; j < 4; ++j) { const f32x4 a = ((const GAS f32x4*)g)[2 * (64 * j + ln)], b = ((const GAS f32x4*)g)[2 * (64 * j + ln) + 1];
        gm = fmaxf(gm, fmaxf(fmaxf(fmaxf(fabsf(a.x), fabsf(a.y)), fmaxf(fabsf(a.z), fabsf(a.w))), fmaxf(fmaxf(fabsf(b.x), fabsf(b.y)), fmaxf(fabsf(b.z), fabsf(b.w))))); }
#pragma unroll
    for (int o = 1; o < 64; o <<= 1) gm = fmaxf(gm, __shfl_xor(gm, o));
    return fp8_scale(45.2548339959f * gm);
}
template <int MAP> __device__ __forceinline__ int dest_row(int n) {
    if (MAP == 1) return 256 * (n >> 7) + (n & 127);
    if (MAP == 2) return 256 * (n >> 7) + 128 + (n & 127);
    if (MAP == 3) return n < 5120 ? n : (n < 5136 ? 15360 + (n - 5120) : n - 16);
    if (MAP == 4) return n - 9232;
    return n;
}
template <int MAP> __device__ __forceinline__ void p0_item(const float* W, int K, int N, bf16* WT, LAS float* scr, int item, int lane) {
    const int nblk = (N + 31) / 32, kb = item / nblk, nb = item % nblk, k0 = 64 * kb, n0 = 32 * nb;
    const int nn = n0 + (lane & 31); const bool okr = nn < N;
#pragma unroll
    for (int i = 0; i < 32; ++i) { const int kk = 2 * i + (lane >> 5); scr[kk * 33 + (lane & 31)] = okr ? W[(size_t)(k0 + kk) * N + nn] : 0.f; }
    LDS_WAIT(); asm volatile("" ::: "memory");
    const int c = lane & 7;
#pragma unroll
    for (int j = 0; j < 4; ++j) { const int n = (lane >> 3) + 8 * j; const LAS float* s = scr + (8 * c) * 33 + n;
        v4u o; o.x = pk2(s[0 * 33], s[1 * 33]); o.y = pk2(s[2 * 33], s[3 * 33]); o.z = pk2(s[4 * 33], s[5 * 33]); o.w = pk2(s[6 * 33], s[7 * 33]);
        if (n0 + n < N && !(MAP == 3 && n0 + n >= 9232)) __builtin_nontemporal_store(o, (GAS v4u*)(WT + (size_t)dest_row<MAP>(n0 + n) * K + k0 + 8 * c)); }
    LDS_WAIT(); asm volatile("" ::: "memory");
}
__device__ __forceinline__ float p0_absmax_item(const float* W, int K, int N, int item, int lane, int nmin) {
    (void)K; const int nblk = (N + 31) / 32, kb = item / nblk, nb = item % nblk, k0 = 64 * kb, n0 = 32 * nb;
    const int nn = n0 + (lane & 31); const bool okr = nn < N && nn >= nmin;
    float m = 0.f;
#pragma unroll
    for (int i = 0; i < 32; ++i) { const int kk = 2 * i + (lane >> 5); m = fmaxf(m, fabsf(okr ? W[(size_t)(k0 + kk) * N + nn] : 0.f)); }
    return m;
}
template <int MAP> __device__ __forceinline__ float p0_item8(const float* W, int K, int N, unsigned char* W8, LAS float* scr, int item, int lane, float sW) {
    const int nblk = (N + 31) / 32, kb = item / nblk, nb = item % nblk, k0 = 64 * kb, n0 = 32 * nb;
    const int nn = n0 + (lane & 31); const bool okr = nn < N;
    float mx = 0.f; const bool cnt = !(MAP == 4 && nn < 9232);
#pragma unroll
    for (int i = 0; i < 32; ++i) { const int kk = 2 * i + (lane >> 5); const float v = okr ? W[(size_t)(k0 + kk) * N + nn] : 0.f; scr[kk * 33 + (lane & 31)] = v; mx = fmaxf(mx, cnt ? fabsf(v) : 0.f); }
    LDS_WAIT(); asm volatile("" ::: "memory");
    const int c = lane & 7;
#pragma unroll
    for (int j = 0; j < 4; ++j) { const int n = (lane >> 3) + 8 * j; const LAS float* s = scr + (8 * c) * 33 + n;
        v2u o; o.x = pk4_fp8(s[0 * 33] * sW, s[1 * 33] * sW, s[2 * 33] * sW, s[3 * 33] * sW); o.y = pk4_fp8(s[4 * 33] * sW, s[5 * 33] * sW, s[6 * 33] * sW, s[7 * 33] * sW);
        if (n0 + n < N && !(MAP == 4 && n0 + n < 9232)) __builtin_nontemporal_store(o, (GAS v2u*)(W8 + (size_t)dest_row<MAP>(n0 + n) * K + k0 + 8 * c)); }
    LDS_WAIT(); asm volatile("" ::: "memory");
    return mx;
}
constexpr int NBLK_IN = (IN_W + 31) / 32, MG_N0 = IN_W - 6144  , MG_NB0 = MG_N0 / 32, I_MG = (D / 64) * (NBLK_IN - MG_NB0);
constexpr size_t WL_IN8 = 40 * MiB;
constexpr int I_GATE = (D / 64) * (FF / 32), I_DOWN = (FF / 64) * (D / 32), I_IN = (D / 64) * ((IN_W + 31) / 32), I_BR = (1024 / 64) * (D / 32), I_OUT = (D / 64) * (D / 32);
constexpr int I_LAYER = 2 * (2 * I_GATE + I_DOWN) + I_IN + 3 * I_BR + I_OUT;

__device__ __forceinline__ void x_pack8(const f32x4 va, const f32x4 vb, v4u& hi, v2u& lo) {
    unsigned r[8];
#pragma unroll
    for (int k = 0; k < 4; ++k) { const float fa = va[k], fb = vb[k]; const unsigned ua = __float_as_uint(fa), ub = __float_as_uint(fb);
        r[k] = (ua + 0x7Fu + ((ua >> 8) & 1u)) >> 8; r[4 + k] = (ub + 0x7Fu + ((ub >> 8) & 1u)) >> 8; }
    hi.x = (r[0] >> 8) | ((r[1] >> 8) << 16); hi.y = (r[2] >> 8) | ((r[3] >> 8) << 16); hi.z = (r[4] >> 8) | ((r[5] >> 8) << 16); hi.w = (r[6] >> 8) | ((r[7] >> 8) << 16);
    lo.x = (r[0] & 0xFFu) | ((r[1] & 0xFFu) << 8) | ((r[2] & 0xFFu) << 16) | (r[3] << 24); lo.y = (r[4] & 0xFFu) | ((r[5] & 0xFFu) << 8) | ((r[6] & 0xFFu) << 16) | (r[7] << 24);
}
__device__ __forceinline__ f32x4 x_unpack4(const unsigned h0, const unsigned h1, const unsigned lo) {
    f32x4 v; v.x = __uint_as_float((h0 << 16) | ((lo & 0xFFu) << 8)); v.y = __uint_as_float((h0 & 0xFFFF0000u) | (lo & 0xFF00u));
    v.z = __uint_as_float((h1 << 16) | ((lo >> 8) & 0xFF00u)); v.w = __uint_as_float((h1 & 0xFFFF0000u) | ((lo >> 16) & 0xFF00u)); return v;
}
__device__ __forceinline__ f32x4 bf4(const unsigned a, const unsigned b) { return (f32x4){blo(a), bhi(a), blo(b), bhi(b)}; }
__device__ __forceinline__ void rowpass(const Frame& F, const float* xin32, const unsigned short* xih, const unsigned char* xil, const bf16* Y, float* xo32, unsigned short* xoh, unsigned char* xol,
                                        const float* gpost, float scale, const float* gpre, bf16* H, unsigned char* H8 = nullptr) {
    const int gw = F.vcu * NWAVES + F.wave, NGW = F.G * NWAVES, ln = F.lane;
    const float s8 = H8 ? h8_scale(gpre, ln) : 0.f;
    f32x4 gq[8];
#pragma unroll
    for (int j = 0; j < 4; ++j) { gq[2 * j] = Y ? ((const GAS f32x4*)gpost)[2 * (64 * j + ln)] : (f32x4){0.f, 0.f, 0.f, 0.f}; gq[2 * j + 1] = Y ? ((const GAS f32x4*)gpost)[2 * (64 * j + ln) + 1] : (f32x4){0.f, 0.f, 0.f, 0.f}; }
    for (int m = gw; m < M; m += 2 * NGW) {
        const int m1 = m + NGW;
        f32x4 x0[8], x1[8];
        if (xin32) { const GAS f32x4* xr0 = (const GAS f32x4*)(xin32 + (size_t)m * D) + 2 * ln; const GAS f32x4* xr1 = (const GAS f32x4*)(xin32 + (size_t)m1 * D) + 2 * ln;
#pragma unroll
            for (int j = 0; j < 4; ++j) { x0[2 * j] = xr0[128 * j]; x0[2 * j + 1] = xr0[128 * j + 1]; x1[2 * j] = xr1[128 * j]; x1[2 * j + 1] = xr1[128 * j + 1]; } }
        else { const GAS v4u* h0 = (const GAS v4u*)(xih + (size_t)m * D) + ln; const GAS v4u* h1 = (const GAS v4u*)(xih + (size_t)m1 * D) + ln;
            const GAS v2u* l0 = (const GAS v2u*)(xil + (size_t)m * D) + ln; const GAS v2u* l1 = (const GAS v2u*)(xil + (size_t)m1 * D) + ln;
            v4u a0[4], a1[4]; v2u b0[4], b1[4];
#pragma unroll
            for (int j = 0; j < 4; ++j) { a0[j] = __builtin_nontemporal_load(h0 + 64 * j); a1[j] = __builtin_nontemporal_load(h1 + 64 * j); b0[j] = __builtin_nontemporal_load(l0 + 64 * j); b1[j] = __builtin_nontemporal_load(l1 + 64 * j); }
#pragma unroll
            for (int j = 0; j < 4; ++j) { x0[2 * j] = x_unpack4(a0[j].x, a0[j].y, b0[j].x); x0[2 * j + 1] = x_unpack4(a0[j].z, a0[j].w, b0[j].y); x1[2 * j] = x_unpack4(a1[j].x, a1[j].y, b1[j].x); x1[2 * j + 1] = x_unpack4(a1[j].z, a1[j].w, b1[j].y); } }
        if (Y) {
            const GAS v4u* yr0 = (const GAS v4u*)(Y + (size_t)m * D) + ln; const GAS v4u* yr1 = (const GAS v4u*)(Y + (size_t)m1 * D) + ln;
            v4u y0[4], y1[4]; float s0 = 0.f, s1 = 0.f;
#pragma unroll
            for (int j = 0; j < 4; ++j) { y0[j] = __builtin_nontemporal_load(yr0 + 64 * j); y1[j] = __builtin_nontemporal_load(yr1 + 64 * j); }
#pragma unroll
            for (int j = 0; j < 4; ++j) { const f32x4 a = bf4(y0[j].x, y0[j].y), b = bf4(y0[j].z, y0[j].w), c = bf4(y1[j].x, y1[j].y), d = bf4(y1[j].z, y1[j].w);
                s0 += ((a.x * a.x + a.y * a.y) + (a.z * a.z + a.w * a.w)) + ((b.x * b.x + b.y * b.y) + (b.z * b.z + b.w * b.w));
                s1 += ((c.x * c.x + c.y * c.y) + (c.z * c.z + c.w * c.w)) + ((d.x * d.x + d.y * d.y) + (d.z * d.z + d.w * d.w)); }
#pragma unroll
            for (int o = 1; o < 64; o <<= 1) { s0 += __shfl_xor(s0, o); s1 += __shfl_xor(s1, o); }
            const float r0 = scale * rsqrtf(s0 * (1.f / D) + EPS), r1 = scale * rsqrtf(s1 * (1.f / D) + EPS);
#pragma unroll
            for (int j = 0; j < 4; ++j) { x0[2 * j] = x0[2 * j] + bf4(y0[j].x, y0[j].y) * gq[2 * j] * r0; x0[2 * j + 1] = x0[2 * j + 1] + bf4(y0[j].z, y0[j].w) * gq[2 * j + 1] * r0;
                x1[2 * j] = x1[2 * j] + bf4(y1[j].x, y1[j].y) * gq[2 * j] * r1; x1[2 * j + 1] = x1[2 * j + 1] + bf4(y1[j].z, y1[j].w) * gq[2 * j + 1] * r1; }
            if (xo32) { GAS f32x4* xo0 = (GAS f32x4*)(xo32 + (size_t)m * D) + 2 * ln; GAS f32x4* xo1 = (GAS f32x4*)(xo32 + (size_t)m1 * D) + 2 * ln;
#pragma unroll
                for (int j = 0; j < 4; ++j) { xo0[128 * j] = x0[2 * j]; xo0[128 * j + 1] = x0[2 * j + 1]; xo1[128 * j] = x1[2 * j]; xo1[128 * j + 1] = x1[2 * j + 1]; } }
            else { GAS v4u* h0 = (GAS v4u*)(xoh + (size_t)m * D) + ln; GAS v4u* h1 = (GAS v4u*)(xoh + (size_t)m1 * D) + ln;
                GAS v2u* l0 = (GAS v2u*)(xol + (size_t)m * D) + ln; GAS v2u* l1 = (GAS v2u*)(xol + (size_t)m1 * D) + ln;
#pragma unroll
                for (int j = 0; j < 4; ++j) { v4u a; v2u b; x_pack8(x0[2 * j], x0[2 * j + 1], a, b); __builtin_nontemporal_store(a, h0 + 64 * j); __builtin_nontemporal_store(b, l0 + 64 * j); x_pack8(x1[2 * j], x1[2 * j + 1], a, b); __builtin_nontemporal_store(a, h1 + 64 * j); __builtin_nontemporal_store(b, l1 + 64 * j); } }
        }
        if (H || H8) {
            float s0 = 0.f, s1 = 0.f;
#pragma unroll
            for (int j = 0; j < 8; ++j) { s0 += (x0[j].x * x0[j].x + x0[j].y * x0[j].y) + (x0[j].z * x0[j].z + x0[j].w * x0[j].w); s1 += (x1[j].x * x1[j].x + x1[j].y * x1[j].y) + (x1[j].z * x1[j].z + x1[j].w * x1[j].w); }
#pragma unroll
            for (int o = 1; o < 64; o <<= 1) { s0 += __shfl_xor(s0, o); s1 += __shfl_xor(s1, o); }
            const float r0 = rsqrtf(s0 * (1.f / D) + EPS), r1 = rsqrtf(s1 * (1.f / D) + EPS);
            GAS v4u* ho0 = (GAS v4u*)(H + (size_t)m * HP) + ln; GAS v4u* ho1 = (GAS v4u*)(H + (size_t)m1 * HP) + ln;
#pragma unroll
            for (int j = 0; j < 4; ++j) { const f32x4 ga = ((const GAS f32x4*)gpre)[2 * (64 * j + ln)], gb = ((const GAS f32x4*)gpre)[2 * (64 * j + ln) + 1];
                const f32x4 a = x0[2 * j] * ga * r0, b = x0[2 * j + 1] * gb * r0, c = x1[2 * j] * ga * r1, d = x1[2 * j + 1] * gb * r1;
                if (H) { ho0[64 * j] = (v4u){pk2(a.x, a.y), pk2(a.z, a.w), pk2(b.x, b.y), pk2(b.z, b.w)}; ho1[64 * j] = (v4u){pk2(c.x, c.y), pk2(c.z, c.w), pk2(d.x, d.y), pk2(d.z, d.w)}; }
                if (H8) { const f32x4 a8 = a * s8, b8 = b * s8, c8 = c * s8, d8 = d * s8;
                    ((GAS v2u*)(H8 + (size_t)m * D) + ln)[64 * j] = (v2u){pk4_fp8(a8.x, a8.y, a8.z, a8.w), pk4_fp8(b8.x, b8.y, b8.z, b8.w)}; ((GAS v2u*)(H8 + (size_t)m1 * D) + ln)[64 * j] = (v2u){pk4_fp8(c8.x, c8.y, c8.z, c8.w), pk4_fp8(d8.x, d8.y, d8.z, d8.w)}; } }
        }
    }
}

__device__ __forceinline__ void conv_item(const bf16* P, const float* cw, const float* cb, bf16* XC, int c8, int m0) {
    const int t0 = m0 & (SEQ - 1);
    float w[4][8], bb[8];
#pragma unroll
    for (int k = 0; k < 4; ++k) { const f32x4 a = *(const GAS f32x4*)(cw + k * 1024 + c8), b = *(const GAS f32x4*)(cw + k * 1024 + c8 + 4); w[k][0] = a.x; w[k][1] = a.y; w[k][2] = a.z; w[k][3] = a.w; w[k][4] = b.x; w[k][5] = b.y; w[k][6] = b.z; w[k][7] = b.w; }
    { const f32x4 a = *(const GAS f32x4*)(cb + c8), b = *(const GAS f32x4*)(cb + c8 + 4); bb[0] = a.x; bb[1] = a.y; bb[2] = a.z; bb[3] = a.w; bb[4] = b.x; bb[5] = b.y; bb[6] = b.z; bb[7] = b.w; }
    v4u r[19];
#pragma unroll
    for (int i = 0; i < 19; ++i) r[i] = (t0 + i - 3 >= 0) ? *(const GAS v4u*)(P + (size_t)(m0 + i - 3) * PW + P_AX + c8) : (v4u){0u, 0u, 0u, 0u};
#pragma unroll
    for (int t = 0; t < 16; ++t) { float acc[8];
#pragma unroll
        for (int e = 0; e < 8; ++e) acc[e] = bb[e];
#pragma unroll
        for (int k = 0; k < 4; ++k) { const v4u q = r[t + k];
            acc[0] += w[k][0] * blo(q.x); acc[1] += w[k][1] * bhi(q.x); acc[2] += w[k][2] * blo(q.y); acc[3] += w[k][3] * bhi(q.y); acc[4] += w[k][4] * blo(q.z); acc[5] += w[k][5] * bhi(q.z); acc[6] += w[k][6] * blo(q.w); acc[7] += w[k][7] * bhi(q.w); }
        *(GAS v4u*)(XC + (size_t)(m0 + t) * 1024 + c8) = (v4u){pk2(acc[0], acc[1]), pk2(acc[2], acc[3]), pk2(acc[4], acc[5]), pk2(acc[6], acc[7])}; }
}

constexpr int LRU_LDS = 0;
template <bool FINAL> __device__ __forceinline__ void lru_chunk_phase(const Frame& F, const unsigned char* GT, const bf16* XC, const bf16* P, const float* ba, const float* bx, const float* lam,
                                                                    float* CA, float* CH, const float* HIN, bf16* YA, int u0, int u1) {
    LAS float* XA = (LAS float*)(F.lds + LRU_LDS); LAS float* XH = XA + 2048;
    const int c4l = F.lane, part = F.wave;
    {
#pragma unroll 1
        for (int uu = u0; uu < u1; ++uu) { const int c = uu >> 2, r = uu & 3;
            const int ch = 256 * r + 4 * c4l, gc = 256 * (ch >> 7) + (ch & 127); const size_t m0 = (size_t)c * 64 + 8 * part;
            const f32x4 lm = *(const GAS f32x4*)(lam + ch);
            float sp8[4];
#pragma unroll
            for (int e = 0; e < 4; ++e) sp8[e] = (-8.0f / 255.0f) * (flog(1.0f + fexp(-fabsf(lm[e]))) + fmaxf(-lm[e], 0.f));
            float av[8][4], uv[8][4]; float A[4] = {1.f, 1.f, 1.f, 1.f}, Hs[4] = {0.f, 0.f, 0.f, 0.f};
            v2u gwv[8];
#pragma unroll
            for (int t = 0; t < 8; ++t) {
                const unsigned rw = *(const GAS unsigned*)(GT + (m0 + t) * 2048 + gc), iw = *(const GAS unsigned*)(GT + (m0 + t) * 2048 + 128 + gc); const v2u xw = *(const GAS v2u*)(XC + (m0 + t) * 1024 + ch);
                gwv[t] = FINAL ? *(const GAS v2u*)(P + (m0 + t) * PW + P_AG + ch) : (v2u){0u, 0u};
                const float rp[4] = {(float)(rw & 0xFFu), (float)((rw >> 8) & 0xFFu), (float)((rw >> 16) & 0xFFu), (float)(rw >> 24)}, ip[4] = {(float)(iw & 0xFFu), (float)((iw >> 8) & 0xFFu), (float)((iw >> 16) & 0xFFu), (float)(iw >> 24)}, xc[4] = {blo(xw.x), bhi(xw.x), blo(xw.y), bhi(xw.y)};
#pragma unroll
                for (int e = 0; e < 4; ++e) { const float la = rp[e] * sp8[e], a = fexp(la);
                    const float u = __builtin_amdgcn_sqrtf(fmaxf(neg_expm1(2.0f * la, a * a), 0.f)) * (ip[e] * xc[e] * (1.0f / 255.0f));
                    av[t][e] = a; uv[t][e] = u; A[e] *= a; Hs[e] = a * Hs[e] + u; }
            }
            *(LAS f32x4*)(XA + part * 256 + 4 * c4l) = (f32x4){A[0], A[1], A[2], A[3]}; *(LAS f32x4*)(XH + part * 256 + 4 * c4l) = (f32x4){Hs[0], Hs[1], Hs[2], Hs[3]};
            __syncthreads();
            if (!FINAL) {
                if (part == 0) { f32x4 At = (f32x4){1.f, 1.f, 1.f, 1.f}, Ht = (f32x4){0.f, 0.f, 0.f, 0.f};
#pragma unroll
                    for (int qq = 0; qq < 8; ++qq) { const f32x4 a = *(const LAS f32x4*)(XA + qq * 256 + 4 * c4l), hh = *(const LAS f32x4*)(XH + qq * 256 + 4 * c4l); Ht = a * Ht + hh; At = At * a; }
                    *(GAS f32x4*)(CA + (size_t)c * 1024 + ch) = At; *(GAS f32x4*)(CH + (size_t)c * 1024 + ch) = Ht; }
            } else {
                f32x4 h = *(const GAS f32x4*)(HIN + (size_t)c * 1024 + ch);
#pragma unroll
                for (int qq = 0; qq < 7; ++qq) if (qq < part) { const f32x4 a = *(const LAS f32x4*)(XA + qq * 256 + 4 * c4l), hh = *(const LAS f32x4*)(XH + qq * 256 + 4 * c4l); h = a * h + hh; }
#pragma unroll
                for (int t = 0; t < 8; ++t) { const v2u gw = gwv[t]; const float g[4] = {blo(gw.x), bhi(gw.x), blo(gw.y), bhi(gw.y)}; float y[4];
#pragma unroll
                    for (int e = 0; e < 4; ++e) { h[e] = av[t][e] * h[e] + uv[t][e]; y[e] = gelu_tanh(g[e]) * h[e]; }
                    *(GAS v2u*)(YA + (m0 + t) * 1024 + ch) = (v2u){pk2(y[0], y[1]), pk2(y[2], y[3])}; }
            }
            __syncthreads();
        }
    }
}
__device__ __forceinline__ void lru_carry_phase(const Frame& F, const float* CA, const float* CH, float* HIN) {
    if (F.bx < 32) {
        LAS float* XA = (LAS float*)(F.lds + LRU_LDS); LAS float* XH = XA + 512;
        const int b = F.bx >> 4, ch = (F.bx & 15) * 64 + F.lane, part = F.wave;
        float a[16], hh[16]; float At = 1.f, Ht = 0.f;
#pragma unroll
        for (int k = 0; k < 16; ++k) { const size_t i = (size_t)(b * 128 + part * 16 + k) * 1024 + ch; a[k] = CA[i]; hh[k] = CH[i]; }
#pragma unroll
        for (int k = 0; k < 16; ++k) { Ht = a[k] * Ht + hh[k]; At *= a[k]; }
        XA[part * 64 + F.lane] = At; XH[part * 64 + F.lane] = Ht;
        __syncthreads();
        float h = 0.f;
#pragma unroll
        for (int pp = 0; pp < 7; ++pp) if (pp < part) h = XA[pp * 64 + F.lane] * h + XH[pp * 64 + F.lane];
#pragma unroll
        for (int k = 0; k < 16; ++k) { const size_t i = (size_t)(b * 128 + part * 16 + k) * 1024 + ch; HIN[i] = h; h = a[k] * h + hh[k]; }
        __syncthreads();
    }
}

typedef short bf16x8 __attribute__((ext_vector_type(8)));
__device__ __forceinline__ void lrgg_phase(const Frame& F, const bf16* H, const bf16* WlrT, const float* w2, const float* b2, float* GG) {
    LAS float* PART = (LAS float*)(F.lds); LAS float* LR = (LAS float*)(F.lds + 32768);
    const int w = F.wave, lane = F.lane, l15 = lane & 15, g4 = lane >> 4;
    for (int tb = F.vcu; tb < M / 64; tb += F.G) {
        bf16x8 bw[8];
#pragma unroll
        for (int ks = 0; ks < 8; ++ks) bw[ks] = *(const GAS bf16x8*)(WlrT + (size_t)l15 * 2048 + 256 * w + 32 * ks + 8 * g4);
#pragma unroll
        for (int mt = 0; mt < 4; ++mt) { f32x4 acc = (f32x4){0.f, 0.f, 0.f, 0.f}; const bf16* hr = H + (size_t)(64 * tb + 16 * mt + l15) * HP + 256 * w + 8 * g4;
            bf16x8 af[8];
#pragma unroll
            for (int ks = 0; ks < 8; ++ks) af[ks] = *(const GAS bf16x8*)(hr + 32 * ks);
#pragma unroll
            for (int ks = 0; ks < 8; ++ks) acc = __builtin_amdgcn_mfma_f32_16x16x32_bf16(af[ks], bw[ks], acc, 0, 0, 0);
            *(LAS f32x4*)(PART + ((w * 4 + mt) * 64 + lane) * 4) = acc; }
        __syncthreads();
#pragma unroll
        for (int o = F.tid; o < 1024; o += 512) { const int t = o >> 4, n = o & 15, mt = t >> 4, tl = t & 15, ln = n + 16 * (tl >> 2), r = tl & 3; float sum = 0.f;
#pragma unroll
            for (int ww = 0; ww < 8; ++ww) sum += PART[((ww * 4 + mt) * 64 + ln) * 4 + r];
            LR[t * 16 + n] = sum; }
        __syncthreads();
        { const int d = F.tid; float wc[16];
#pragma unroll
          for (int r = 0; r < 16; ++r) wc[r] = w2[r * 512 + d];
          const float bb = b2[d];
#pragma unroll 4
          for (int t = 0; t < 64; ++t) { const f32x4 a0 = *(const LAS f32x4*)(LR + t * 16), a1 = *(const LAS f32x4*)(LR + t * 16 + 4), a2 = *(const LAS f32x4*)(LR + t * 16 + 8), a3 = *(const LAS f32x4*)(LR + t * 16 + 12);
              float x = bb + a0.x * wc[0] + a0.y * wc[1] + a0.z * wc[2] + a0.w * wc[3] + a1.x * wc[4] + a1.y * wc[5] + a1.z * wc[6] + a1.w * wc[7] + a2.x * wc[8] + a2.y * wc[9] + a2.z * wc[10] + a2.w * wc[11] + a3.x * wc[12] + a3.y * wc[13] + a3.z * wc[14] + a3.w * wc[15];
              GG[(size_t)(64 * tb + t) * 512 + d] = log_sigm(x) * 0.0625f; } }
        __syncthreads();
    }
}

constexpr int LA_QT = 0, LA_QP = 17408, LA_KP = 34816, LA_KHT = 78336, LA_VT = 96768, LA_PS = 133632, LA_DEC = 142848, LA_T8 = 143360, LA_NRM = 147456, LA_END = 149504;
constexpr int QS = 272, TS = 144, OBS = 528;
constexpr size_t SLOC_HGRN_OFF = (size_t)128 * 128 * 256;
__device__ __forceinline__ bf16x8 mk8(v2u lo, v2u hi) { v4u t; t.x = lo.x; t.y = lo.y; t.z = hi.x; t.w = hi.y; return __builtin_bit_cast(bf16x8, t); }
template <int TYPE, bool FULL>
__device__ __forceinline__ void la_segment(const Frame& F, int item, const bf16* P, const float* GG, const float* LBl, const float* gn, float* SLOC, float* LDT, const float* SIN, bf16* Y) {
    constexpr int DV = TYPE == 0 ? 256 : 128, NVT = DV / 128, NSEG = TYPE == 0 ? 16 : 8, NCH = 128 / NSEG;
    const int lane = F.lane, w = F.wave, g4 = lane >> 4, l15 = lane & 15, p = lane;
    int bh, seg, b, h;
    if (TYPE == 0) { bh = item >> 4; seg = item & 15; b = bh >> 2; h = bh & 3; } else { bh = item >> 3; seg = item & 7; b = bh >> 3; h = bh & 7; }
    const int qoff = (TYPE == 0 ? P_BQ : P_CQ) + h * 128, koff = (TYPE == 0 ? P_BK : P_CF) + h * 128, voff = TYPE == 0 ? P_BV + h * 256 : P_CI + h * 128, goff = TYPE == 0 ? P_BG + h * 256 : P_CG + h * 128;
    LAS unsigned char* L = F.lds;
    float* slb = SLOC + (TYPE == 0 ? (size_t)0 : SLOC_HGRN_OFF); float* ldb = LDT + (TYPE == 0 ? 0 : 128 * 128);
    f32x4 S[NVT][8];
#pragma unroll
    for (int vt = 0; vt < NVT; ++vt)
#pragma unroll
        for (int dt = 0; dt < 8; ++dt) S[vt][dt] = (f32x4){0.f, 0.f, 0.f, 0.f};
    float ldsa = 0.f, ldsb = 0.f;
    if (FULL) {
        for (int i = F.tid; i < (64 * TS) / 4; i += 512) ((LAS unsigned*)(L + LA_PS))[i] = 0u;
        if (seg > 0) { const float* si = SIN + (TYPE == 0 ? (size_t)0 : SLOC_HGRN_OFF) + (size_t)item * (128 * DV);
#pragma unroll
            for (int vt = 0; vt < NVT; ++vt)
#pragma unroll
                for (int dt = 0; dt < 8; ++dt) S[vt][dt] = *(const GAS f32x4*)(si + ((size_t)(((w * NVT + vt) * 8 + dt) * 64 + lane)) * 4); }
        __syncthreads();
    }
    unsigned qr[8], kr[8]; f32x2 gr[8]; v2u vr[8];
#define LA_BAR() do { asm volatile("s_waitcnt lgkmcnt(0)" ::: "memory"); __builtin_amdgcn_s_barrier(); asm volatile("" ::: "memory"); } while (0)
#define LA_LOAD_RAW(chn) do { const bf16* Pr = P + (size_t)(b * SEQ + (seg * NCH + (chn)) * 64 + 8 * w) * PW; const float* Gr = GG + (size_t)(b * SEQ + (seg * NCH + (chn)) * 64 + 8 * w) * 512 + h * 128 + 2 * p; \
        _Pragma("unroll") for (int j = 0; j < 8; ++j) { const bf16* Pj = Pr + (size_t)j * PW; \
            qr[j] = FULL ? *(const GAS unsigned*)(Pj + qoff + 2 * p) : 0u; kr[j] = *(const GAS unsigned*)(Pj + koff + 2 * p); \
            if (TYPE == 0) gr[j] = *(const GAS f32x2*)(Gr + (size_t)j * 512); else gr[j] = (f32x2){0.f, 0.f}; \
            if (DV == 256) vr[j] = *(const GAS v2u*)(Pj + voff + 4 * p); else { vr[j].x = *(const GAS unsigned*)(Pj + voff + 2 * p); vr[j].y = 0u; } } } while (0)
    LA_LOAD_RAW(0);
    f32x4 gnv[NVT];
#pragma unroll
    for (int vt = 0; vt < NVT; ++vt) gnv[vt] = FULL ? *(const GAS f32x4*)(gn + (w * NVT + vt) * 16 + 4 * g4) : (f32x4){0.f, 0.f, 0.f, 0.f};
#pragma unroll 1
    for (int ch = 0; ch < NCH; ++ch) {
        const int m0 = b * SEQ + (seg * NCH + ch) * 64, sb = w, t0 = 8 * sb, I = sb >> 1;
        float ca[8], cb[8], ka[8], kb[8], qa[8], qb[8]; float ra = 0.f, rb = 0.f;
#pragma unroll
        for (int j = 0; j < 8; ++j) { float ga, gb;
            if (TYPE == 0) { ga = gr[j].x; gb = gr[j].y; ka[j] = blo(kr[j]); kb[j] = bhi(kr[j]); qa[j] = blo(qr[j]); qb[j] = bhi(qr[j]); }
            else { ga = blo(kr[j]); gb = bhi(kr[j]); ka[j] = 1.f - fexp(ga); kb[j] = 1.f - fexp(gb); qa[j] = blo(qr[j]); qb[j] = bhi(qr[j]); }
            ra += ga; rb += gb; ca[j] = ra; cb[j] = rb; }
        *(LAS f32x2*)(L + LA_T8 + (sb * 128 + 2 * p) * 4) = (f32x2){ra, rb};
        LA_BAR();
        float brefa[5], brefb[5]; brefa[0] = 0.f; brefb[0] = 0.f; float cba = 0.f, cbb = 0.f;
#pragma unroll
        for (int J = 0; J < 4; ++J) { const f32x2 u0 = *(const LAS f32x2*)(L + LA_T8 + ((2 * J) * 128 + 2 * p) * 4), u1 = *(const LAS f32x2*)(L + LA_T8 + ((2 * J + 1) * 128 + 2 * p) * 4);
            brefa[J + 1] = brefa[J] + (u0.x + u1.x); brefb[J + 1] = brefb[J] + (u0.y + u1.y);
            if (sb == 2 * J + 1) { cba = u0.x; cbb = u0.y; } }
        const float bIa = I == 0 ? brefa[0] : (I == 1 ? brefa[1] : (I == 2 ? brefa[2] : brefa[3])), bIb = I == 0 ? brefb[0] : (I == 1 ? brefb[1] : (I == 2 ? brefb[2] : brefb[3]));
        const float bla = brefa[4], blb = brefb[4];
        ldsa += bla; ldsb += blb;
        const float eha = fexp(bla - bIa), ehb = fexp(blb - bIb);
        const float eqa = fexp(bIa), eqb = fexp(bIb);
        unsigned kh_a[4], kh_b[4], vlo[4], vhi[4], v2lo[4], v2hi[4];
        float kfa[4], kfb[4];
#pragma unroll
        for (int Ip = 0; Ip < 4; ++Ip) { kfa[Ip] = fexp(fminf(brefa[Ip] - bIa, 0.f)); kfb[Ip] = fexp(fminf(brefb[Ip] - bIb, 0.f)); }
#pragma unroll
        for (int j = 0; j < 8; ++j) { const int t = t0 + j;
            const float cca = fmaxf(cba + ca[j], -60.f), ccb = fmaxf(cbb + cb[j], -60.f); const float e1a = fexp(cca), e1b = fexp(ccb), e2a = fexp(-cca), e2b = fexp(-ccb);
            const float kka = ka[j] * e2a, kkb = kb[j] * e2b;
            const float kha = kka * eha, khb = kkb * ehb;
            if (j & 1) { kh_a[j >> 1] |= f2bf(kha) << 16; kh_b[j >> 1] |= f2bf(khb) << 16; } else { kh_a[j >> 1] = f2bf(kha); kh_b[j >> 1] = f2bf(khb); }
            if (FULL) { const float qpa = qa[j] * e1a, qpb = qb[j] * e1b;
                *(LAS unsigned*)(L + LA_QP + t * QS + 4 * p) = pk2(qpa, qpb); *(LAS unsigned*)(L + LA_QT + t * QS + 4 * p) = pk2(qpa * eqa, qpb * eqb);
#pragma unroll
                for (int Ip = 0; Ip < 4; ++Ip) if (Ip >= I) { const int base = Ip == 0 ? 0 : (Ip == 1 ? 16 : (Ip == 2 ? 48 : 96));
                    *(LAS unsigned*)(L + LA_KP + (base + t) * QS + 4 * p) = pk2(kka * kfa[Ip], kkb * kfb[Ip]); } }
            const unsigned x = vr[j].x, y = vr[j].y;
            if (j & 1) { vlo[j >> 1] |= x << 16; vhi[j >> 1] |= x & 0xffff0000u; v2lo[j >> 1] |= y << 16; v2hi[j >> 1] |= y & 0xffff0000u; }
            else { vlo[j >> 1] = x & 0xffffu; vhi[j >> 1] = x >> 16; v2lo[j >> 1] = y & 0xffffu; v2hi[j >> 1] = y >> 16; } }
        *(LAS v4u*)(L + LA_KHT + (2 * p) * TS + 2 * t0) = (v4u){kh_a[0], kh_a[1], kh_a[2], kh_a[3]}; *(LAS v4u*)(L + LA_KHT + (2 * p + 1) * TS + 2 * t0) = (v4u){kh_b[0], kh_b[1], kh_b[2], kh_b[3]};
        if (DV == 256) { *(LAS v4u*)(L + LA_VT + (4 * p) * TS + 2 * t0) = (v4u){vlo[0], vlo[1], vlo[2], vlo[3]}; *(LAS v4u*)(L + LA_VT + (4 * p + 1) * TS + 2 * t0) = (v4u){vhi[0], vhi[1], vhi[2], vhi[3]};
                         *(LAS v4u*)(L + LA_VT + (4 * p + 2) * TS + 2 * t0) = (v4u){v2lo[0], v2lo[1], v2lo[2], v2lo[3]}; *(LAS v4u*)(L + LA_VT + (4 * p + 3) * TS + 2 * t0) = (v4u){v2hi[0], v2hi[1], v2hi[2], v2hi[3]}; }
        else { *(LAS v4u*)(L + LA_VT + (2 * p) * TS + 2 * t0) = (v4u){vlo[0], vlo[1], vlo[2], vlo[3]}; *(LAS v4u*)(L + LA_VT + (2 * p + 1) * TS + 2 * t0) = (v4u){vhi[0], vhi[1], vhi[2], vhi[3]}; }
        if (sb == 0) *(LAS f32x2*)(L + LA_DEC + 8 * p) = (f32x2){fexp(bla), fexp(blb)};
        if (ch + 1 < NCH) LA_LOAD_RAW(ch + 1);
        LA_BAR();
        v2u gwv[NVT][4];
        f32x4 oacc[TYPE == 0 ? 1 : NVT][4];
        if (FULL) {
            for (int blk = w; blk < 10; blk += 8) { const int I2 = blk >= 6 ? 3 : (blk >= 3 ? 2 : (blk >= 1 ? 1 : 0)), J2 = blk - (I2 * (I2 + 1)) / 2; const int base = I2 == 0 ? 0 : (I2 == 1 ? 16 : (I2 == 2 ? 48 : 96));
                const LAS unsigned char* kp = L + LA_KP + (base + 16 * J2 + l15) * QS + 16 * g4; const LAS unsigned char* qp = L + LA_QP + (16 * I2 + l15) * QS + 16 * g4;
                f32x4 acc = (f32x4){0.f, 0.f, 0.f, 0.f};
#pragma unroll
                for (int ks = 0; ks < 4; ++ks) acc = __builtin_amdgcn_mfma_f32_16x16x32_bf16(*(const LAS bf16x8*)(kp + 64 * ks), *(const LAS bf16x8*)(qp + 64 * ks), acc, 0, 0, 0);
                if (I2 == J2) {
#pragma unroll
                    for (int r = 0; r < 4; ++r) if (4 * g4 + r > l15) acc[r] = 0.f; }
                *(LAS v2u*)(L + LA_PS + (16 * I2 + l15) * TS + (16 * J2 + 4 * g4) * 2) = (v2u){pk2(acc[0], acc[1]), pk2(acc[2], acc[3])}; }
            LA_BAR();
            float ssq[4] = {0.f, 0.f, 0.f, 0.f};
#pragma unroll
            for (int vt = 0; vt < NVT; ++vt) {
                bf16x8 sf[4];
#pragma unroll
                for (int ks = 0; ks < 4; ++ks) { const f32x4 a = S[vt][2 * ks], c = S[vt][2 * ks + 1]; sf[ks] = mk8((v2u){pk2(a.x, a.y), pk2(a.z, a.w)}, (v2u){pk2(c.x, c.y), pk2(c.z, c.w)}); }
#pragma unroll
                for (int I2 = 0; I2 < 4; ++I2) {
                    f32x4 o = (f32x4){0.f, 0.f, 0.f, 0.f};
                    const LAS unsigned char* qt = L + LA_QT + (16 * I2 + l15) * QS + 8 * g4;
#pragma unroll
                    for (int ks = 0; ks < 4; ++ks) o = __builtin_amdgcn_mfma_f32_16x16x32_bf16(sf[ks], mk8(*(const LAS v2u*)(qt + 64 * ks), *(const LAS v2u*)(qt + 64 * ks + 32)), o, 0, 0, 0);
#pragma unroll
                    for (int ks = 0; ks < 2; ++ks) if (ks == 0 || I2 >= 2)
                        o = __builtin_amdgcn_mfma_f32_16x16x32_bf16(*(const LAS bf16x8*)(L + LA_VT + ((w * NVT + vt) * 16 + l15) * TS + (32 * ks + 8 * g4) * 2), *(const LAS bf16x8*)(L + LA_PS + (16 * I2 + l15) * TS + (32 * ks + 8 * g4) * 2), o, 0, 0, 0);
                    ssq[I2] += (o.x * o.x + o.y * o.y) + (o.z * o.z + o.w * o.w);
                    if (TYPE == 0) *(LAS v2u*)(L + LA_KP + (16 * I2 + l15) * OBS + ((w * NVT + vt) * 16 + 4 * g4) * 2) = (v2u){pk2(o.x, o.y), pk2(o.z, o.w)};
                    else oacc[vt][I2] = o;
                }
            }
#pragma unroll
            for (int I2 = 0; I2 < 4; ++I2) { float ss = ssq[I2]; ss += __shfl_xor(ss, 16); ss += __shfl_xor(ss, 32);
                if (g4 == 0) *(LAS float*)(L + LA_NRM + (w * 64 + 16 * I2 + l15) * 4) = ss; }
#pragma unroll
            for (int I2 = 0; I2 < 4; ++I2)
#pragma unroll
                for (int vt = 0; vt < NVT; ++vt) gwv[vt][I2] = *(const GAS v2u*)(P + (size_t)(m0 + 16 * I2 + l15) * PW + goff + (w * NVT + vt) * 16 + 4 * g4);
        }
        { bf16x8 bv[NVT][2];
#pragma unroll
          for (int vt = 0; vt < NVT; ++vt)
#pragma unroll
              for (int ks = 0; ks < 2; ++ks) bv[vt][ks] = *(const LAS bf16x8*)(L + LA_VT + ((w * NVT + vt) * 16 + l15) * TS + (32 * ks + 8 * g4) * 2);
#pragma unroll
          for (int dt = 0; dt < 8; ++dt) { const f32x4 dec = *(const LAS f32x4*)(L + LA_DEC + (dt * 16 + 4 * g4) * 4);
              const bf16x8 a0 = *(const LAS bf16x8*)(L + LA_KHT + (dt * 16 + l15) * TS + (8 * g4) * 2), a1 = *(const LAS bf16x8*)(L + LA_KHT + (dt * 16 + l15) * TS + (32 + 8 * g4) * 2);
#pragma unroll
              for (int vt = 0; vt < NVT; ++vt) { f32x4 sv = S[vt][dt] * dec; sv = __builtin_amdgcn_mfma_f32_16x16x32_bf16(a0, bv[vt][0], sv, 0, 0, 0); S[vt][dt] = __builtin_amdgcn_mfma_f32_16x16x32_bf16(a1, bv[vt][1], sv, 0, 0, 0); } } }
        if (FULL) {
            LA_BAR();
#pragma unroll
            for (int I2 = 0; I2 < 4; ++I2) { float tot = 0.f;
#pragma unroll
                for (int ww = 0; ww < 8; ++ww) tot += *(const LAS float*)(L + LA_NRM + (ww * 64 + 16 * I2 + l15) * 4);
                const float rstd = rsqrtf(tot * (1.f / DV) + EPS); const size_t m = (size_t)(m0 + 16 * I2 + l15);
#pragma unroll
                for (int vt = 0; vt < NVT; ++vt) { const int col = (w * NVT + vt) * 16 + 4 * g4; const v2u gw = gwv[vt][I2]; const f32x4 gg = gnv[vt]; f32x4 o; if (TYPE == 0) { const v2u ob = *(const LAS v2u*)(L + LA_KP + (16 * I2 + l15) * OBS + col * 2); o = (f32x4){blo(ob.x), bhi(ob.x), blo(ob.y), bhi(ob.y)}; } else o = oacc[vt][I2];
                    const float g0 = blo(gw.x), g1 = bhi(gw.x), g2 = blo(gw.y), g3 = bhi(gw.y);
                    float a0, a1, a2, a3; if (TYPE == 0) { a0 = g0 * sigm(g0); a1 = g1 * sigm(g1); a2 = g2 * sigm(g2); a3 = g3 * sigm(g3); } else { a0 = sigm(g0); a1 = sigm(g1); a2 = sigm(g2); a3 = sigm(g3); }
                    *(GAS v2u*)(Y + m * 1024 + h * DV + col) = (v2u){pk2(o.x * rstd * gg.x * a0, o.y * rstd * gg.y * a1), pk2(o.z * rstd * gg.z * a2, o.w * rstd * gg.w * a3)}; } }
        }
    }
    if (!FULL) {
        float* sl = slb + (size_t)item * (128 * DV);
#pragma unroll
        for (int vt = 0; vt < NVT; ++vt)
#pragma unroll
            for (int dt = 0; dt < 8; ++dt) *(GAS f32x4*)(sl + ((size_t)(((w * NVT + vt) * 8 + dt) * 64 + lane)) * 4) = S[vt][dt];
        if (w == 0) { ldb[(size_t)item * 128 + 2 * p] = ldsa; ldb[(size_t)item * 128 + 2 * p + 1] = ldsb; }
    }
    __syncthreads();
}

template <int TYPE> __device__ __forceinline__ void la_prefix(const Frame& F, int gtid, const float* SLOC, const float* LDT, float* SIN) {
    constexpr int DV = TYPE == 0 ? 256 : 128, NSEG = TYPE == 0 ? 16 : 8, NV4 = 128 * DV / 4;
    const int seq = gtid / NV4, e4 = gtid % NV4, dt = (e4 >> 6) & 7, ln = e4 & 63, d0 = dt * 16 + 4 * (ln >> 4);
    const float* slb = SLOC + (TYPE == 0 ? (size_t)0 : SLOC_HGRN_OFF) + (size_t)seq * NSEG * (128 * DV) + (size_t)e4 * 4;
    float* sib = SIN + (TYPE == 0 ? (size_t)0 : SLOC_HGRN_OFF) + (size_t)seq * NSEG * (128 * DV) + (size_t)e4 * 4;
    const float* ldb = LDT + (TYPE == 0 ? 0 : 128 * 128) + (size_t)seq * NSEG * 128 + d0;
    f32x4 sv[NSEG - 1], lv[NSEG - 1];
#pragma unroll
    for (int sg = 0; sg < NSEG - 1; ++sg) { sv[sg] = *(const GAS f32x4*)(slb + (size_t)sg * (128 * DV)); lv[sg] = *(const GAS f32x4*)(ldb + (size_t)sg * 128); }
    f32x4 S = (f32x4){0.f, 0.f, 0.f, 0.f};
#pragma unroll
    for (int sg = 0; sg < NSEG - 1; ++sg) { const f32x4 e = (f32x4){fexp(lv[sg].x), fexp(lv[sg].y), fexp(lv[sg].z), fexp(lv[sg].w)}; S = S * e + sv[sg]; *(GAS f32x4*)(sib + (size_t)(sg + 1) * (128 * DV)) = S; }
}

typedef const __attribute__((address_space(4))) Args* KArgs;
__device__ __forceinline__ KArgs kargs() { unsigned long long p = (unsigned long long)__builtin_amdgcn_kernarg_segment_ptr(); asm volatile("" : "+s"(p)); return (KArgs)p; }
__device__ __forceinline__ Frame mkframe(LAS unsigned char* lds, gu32* ctl) {
    Frame F; int tid = threadIdx.x; asm volatile("" : "+v"(tid)); int bx = blockIdx.x, G = gridDim.x; asm volatile("" : "+s"(bx), "+s"(G));
    F.lds = lds; F.MISC = (volatile LAS unsigned*)(lds + MISC_OFF); F.ctl = ctl;
    F.tid = tid; F.lane = tid & 63; F.wave = __builtin_amdgcn_readfirstlane(tid >> 6); F.G = G; F.bx = bx;
    F.vcu = (G % 8 == 0) ? (bx % 8) * (G / 8) + bx / 8 : bx;
    return F;
}
__global__ void __launch_bounds__(NWAVES * 64, 2) fwd_kernel(Args args_unused) {
    extern __shared__ __attribute__((aligned(16))) unsigned char lds_raw[];
    LAS unsigned char* lds = (LAS unsigned char*)lds_raw;
    XcdBarrier bar;
    int lo, hi;
    {
        KArgs A = kargs();
        gu32* ctl = (gu32*)(A->ws + WS_CTL);
        for (int u = threadIdx.x; u < (LDS_BYTES - LDSCTL_OFF) / 4; u += NWAVES * 64) ((LAS unsigned*)(lds + LDSCTL_OFF))[u] = 0u;
        __syncthreads();
        bar = xcd_barrier_post((unsigned*)(ctl + CW_BAR), (volatile LAS unsigned*)(lds + MISC_OFF) + 8);
        lo = A->ph_lo; hi = A->ph_hi;
    }
#define GRID_BAR() xcd_barrier(bar)
#define PH_SETUP KArgs A = kargs(); unsigned char* ws = A->ws; Frame F = mkframe(lds, (gu32*)(ws + WS_CTL)); (void)F;
#define WSP(T, off) ((T*)(ws + (off)))

    for (int rep = 0; rep < REP_P0; ++rep)
    if (lo <= 0 && 0 < hi) {
        PH_SETUP
        LAS float* scr = (LAS float*)(F.lds + RING_OFF + F.wave * 16384);
        const int gw = F.vcu * NWAVES + F.wave, NGW = F.G * NWAVES;
        int wslot = -1; float wmax = 0.f, s0c = 0.f;
#define WMAX_FLUSH() do { if (wslot >= 0) { for (int o = 1; o < 64; o <<= 1) wmax = fmaxf(wmax, __shfl_xor(wmax, o)); if (F.lane == 0) __hip_atomic_fetch_max((unsigned*)(ws + WS_CTL) + CW_WMAX + wslot, __float_as_uint(wmax), RLX_AGENT); } } while (0)
#define SLOT_ENTER(sl, SAMPLE) do { if (wslot != (sl)) { WMAX_FLUSH(); wslot = (sl); wmax = 0.f; float sm = (SAMPLE); for (int o = 1; o < 64; o <<= 1) sm = fmaxf(sm, __shfl_xor(sm, o)); s0c = fp8_scale(FP8_HEAD * sm); \
            if (F.lane == 0) __hip_atomic_fetch_max((unsigned*)(ws + WS_CTL) + CW_SMAX + wslot, __float_as_uint(sm), RLX_AGENT); } } while (0)
        for (int it = gw; it < NL * I_LAYER; it += NGW) {
            const int l = it / I_LAYER; int r = it % I_LAYER;
            unsigned char* wl = ws + WS_W + (size_t)l * WL_STRIDE;
            const size_t oGU = (size_t)l * D * FF, oD = (size_t)l * FF * D;
            if (r < 2 * I_GATE) { const bool up = r >= I_GATE; const int ri = up ? r - I_GATE : r;
                if (2 * l >= FP8_S0) { SLOT_ENTER(4 + 2 * l - FP8_S0, p0_absmax_item(A->in[2] + oGU, D, FF, 0, F.lane, 0));
                    wmax = fmaxf(wmax, up ? p0_item8<2>(A->in[3] + oGU, D, FF, wl + WL_GU1, scr, ri, F.lane, s0c) : p0_item8<1>(A->in[2] + oGU, D, FF, wl + WL_GU1, scr, ri, F.lane, s0c)); }
                else if (up) p0_item<2>(A->in[3] + oGU, D, FF, (bf16*)(wl + WL_GU1), scr, ri, F.lane); else p0_item<1>(A->in[2] + oGU, D, FF, (bf16*)(wl + WL_GU1), scr, ri, F.lane);
                continue; } r -= 2 * I_GATE;
            if (r < I_DOWN) { p0_item<0>(A->in[4] + oD, FF, D, (bf16*)(wl + WL_D1), scr, r, F.lane); continue; } r -= I_DOWN;
            if (r < 2 * I_GATE) { const bool up = r >= I_GATE; const int ri = up ? r - I_GATE : r;
                if (2 * l + 1 >= FP8_S0) { SLOT_ENTER(4 + 2 * l + 1 - FP8_S0, p0_absmax_item(A->in[26] + oGU, D, FF, 0, F.lane, 0));
                    wmax = fmaxf(wmax, up ? p0_item8<2>(A->in[27] + oGU, D, FF, wl + WL_GU2, scr, ri, F.lane, s0c) : p0_item8<1>(A->in[26] + oGU, D, FF, wl + WL_GU2, scr, ri, F.lane, s0c)); }
                else if (up) p0_item<2>(A->in[27] + oGU, D, FF, (bf16*)(wl + WL_GU2), scr, ri, F.lane); else p0_item<1>(A->in[26] + oGU, D, FF, (bf16*)(wl + WL_GU2), scr, ri, F.lane);
                continue; } r -= 2 * I_GATE;
            if (r < I_DOWN) { if (2 * l + 1 >= FP8_F2_S0) { SLOT_ENTER(6, p0_absmax_item(A->in[28] + oD, FF, D, 0, F.lane, 0)); wmax = fmaxf(wmax, p0_item8<0>(A->in[28] + oD, FF, D, wl + WL_D2, scr, r, F.lane, s0c)); }
                else p0_item<0>(A->in[28] + oD, FF, D, (bf16*)(wl + WL_D2), scr, r, F.lane);
                continue; } r -= I_DOWN;
            if (r < I_IN) { const float* wi = A->in[7] + (size_t)l * D * IN_W;
                if (r % NBLK_IN <= MG_NB0) p0_item<3>(wi, D, IN_W, (bf16*)(wl + WL_IN), scr, r, F.lane);
                if (r % NBLK_IN >= MG_NB0) { SLOT_ENTER(l, p0_absmax_item(wi, D, IN_W, MG_NB0 + 1, F.lane, MG_N0)); wmax = fmaxf(wmax, p0_item8<4>(wi, D, IN_W, wl + WL_IN + WL_IN8, scr, r, F.lane, s0c)); }
                continue; } r -= I_IN;
            if (r < 3 * I_BR) { const int br = r / I_BR; p0_item<0>(A->in[20 + br] + (size_t)l * 1024 * D, 1024, D, (bf16*)(wl + WL_BR) + (size_t)br * D * 1024, scr, r % I_BR, F.lane); continue; } r -= 3 * I_BR;
            p0_item<0>(A->in[23] + (size_t)l * D * D, D, D, (bf16*)(wl + WL_OUT), scr, r, F.lane);
        }
        WMAX_FLUSH();
#undef WMAX_FLUSH
#undef SLOT_ENTER
        const int gt = F.vcu * 512 + F.tid, NT = F.G * 512;
        for (int i = gt; i < NL * 2048 * 32; i += NT) { const int l = i / (2048 * 32), r = i % (2048 * 32), n = r >> 5, k8 = (r & 31) * 8;
            const int h = n >> 8, g = (n >> 7) & 1, j = n & 127, hp = 2 * (h >> 1) + (k8 >> 7), i0 = k8 & 127;
            v4u o = (v4u){0u, 0u, 0u, 0u};
            if (hp == h) { const float* w = (g ? A->in[12] : A->in[10]) + (size_t)l * 8 * 128 * 128 + (size_t)h * 128 * 128 + (size_t)i0 * 128 + j;
                o.x = pk2(w[0], w[128]); o.y = pk2(w[256], w[384]); o.z = pk2(w[512], w[640]); o.w = pk2(w[768], w[896]); }
            *(GAS v4u*)((bf16*)(ws + WS_W + (size_t)l * WL_STRIDE + WL_GT) + (size_t)n * 256 + k8) = o; }
        if (gt < 1024) { float* LB = WSP(float, WS_LB); const float* lg = A->in[18]; float v0 = lg[gt], v1 = lg[1024 + gt], v2 = lg[2048 + gt], v3 = lg[3072 + gt];
            const float mx = fmaxf(fmaxf(v0, v1), fmaxf(v2, v3)); v0 = expf(v0 - mx); v1 = expf(v1 - mx); v2 = expf(v2 - mx); v3 = expf(v3 - mx);
            const float inv = 1.f / (v0 + v1 + v2 + v3);
            LB[gt] = 0.f; LB[1024 + gt] = v1 * inv; LB[2048 + gt] = (v1 + v2) * inv; LB[3072 + gt] = (v1 + v2 + v3) * inv; }
        rowpass(F, A->in[0], nullptr, nullptr, nullptr, nullptr, nullptr, nullptr, nullptr, 0.f, A->in[1], WSP(bf16, WS_H));
        GRID_BAR();
    }
    if (lo <= 0 && 0 < hi) {
        PH_SETUP
        LAS float* scr = (LAS float*)(F.lds + RING_OFF + F.wave * 16384);
        const int gw = F.vcu * NWAVES + F.wave, NGW = F.G * NWAVES;
        bool redo = false;
        for (int l = 0; l < NL; ++l) { if (wscale_ok(ws, l)) continue; redo = true; const float sW = wscale(ws, l);
            for (int it = gw; it < I_MG; it += NGW) { const int kb = it / (NBLK_IN - MG_NB0), nb = MG_NB0 + it % (NBLK_IN - MG_NB0);
                (void)p0_item8<4>(A->in[7] + (size_t)l * D * IN_W, D, IN_W, ws + WS_W + (size_t)l * WL_STRIDE + WL_IN + WL_IN8, scr, kb * NBLK_IN + nb, F.lane, sW); } }
        for (int hs = FP8_S0; hs < 2 * NL; ++hs) { if (wscale_ok(ws, 4 + hs - FP8_S0)) continue; redo = true; const float sW = wscale(ws, 4 + hs - FP8_S0); const int l = hs >> 1, f = hs & 1;
            unsigned char* w8 = ws + WS_W + (size_t)l * WL_STRIDE + (f ? WL_GU2 : WL_GU1);
            for (int it = gw; it < 2 * I_GATE; it += NGW) {
                if (it < I_GATE) (void)p0_item8<1>((f ? A->in[26] : A->in[2]) + (size_t)l * D * FF, D, FF, w8, scr, it, F.lane, sW);
                else (void)p0_item8<2>((f ? A->in[27] : A->in[3]) + (size_t)l * D * FF, D, FF, w8, scr, it - I_GATE, F.lane, sW); } }
        if (FP8_F2_S0 < 2 * NL && !wscale_ok(ws, 6)) { redo = true; const float sW = wscale(ws, 6);
            for (int it = gw; it < I_DOWN; it += NGW) (void)p0_item8<0>(A->in[28] + (size_t)(NL - 1) * FF * D, FF, D, ws + WS_W + (size_t)(NL - 1) * WL_STRIDE + WL_D2, scr, it, F.lane, sW); }
        if (redo && hi > 1) GRID_BAR();
    }

    int ph = 1;
#define PH_BEGIN if (lo <= ph && ph < hi) { PH_SETUP unsigned char* wl = ws + WS_W + (size_t)l * WL_STRIDE; (void)wl;
#define PH_END(last) if (!(last) && ph + 1 < hi) GRID_BAR(); } ++ph;
#pragma unroll 1
    for (int s = 0; s < 2 * NL; ++s) {
        const int l = s >> 1, f = s & 1;
        for (int rep = 0; rep < REP_F1; ++rep) { if (rep) --ph;
        PH_BEGIN
            if (s >= FP8_S0) {
                pg8::Gemm g{WSP(bf16, WS_H8), (const bf16*)(wl + (f ? WL_GU2 : WL_GU1)), M, 2 * FF, D / 2, D / 2}; pg8::StaticOrder S; S.init(M, 2 * FF, F.G, F.bx);
                const float sc = 1.0f / (h8_scale((f ? A->in[25] : A->in[1]) + (size_t)l * D, F.lane) * wscale(ws, 4 + s - FP8_S0));
                const bool track = (s == FP8_F2_S0 - 1), out8 = (s >= FP8_F2_S0);
                LAS unsigned* mxw = (LAS unsigned*)(F.lds + MISC_OFF + 1024);
                if (F.tid == 0) *mxw = 0u;
                const float s8 = out8 ? fp8_scale(4.0f * __uint_as_float(((const gu32*)(ws + WS_CTL))[CW_WMAX + 7])) : 0.f;
                pg8::EpiSwiGLU8 E{WSP(bf16, WS_P), FF, sc, out8 ? WSP(unsigned char, WS_P) : nullptr, s8, track ? mxw : nullptr};
                pg8::gemm_phase<pg8::EpiSwiGLU8, pg8::StaticOrder, GEMM_ALIGN, GEMM_SP2, 0, true>(F.lds + RING_OFF, g, S, E);
                if (track && F.tid == 0) __hip_atomic_fetch_max((unsigned*)(ws + WS_CTL) + CW_WMAX + 7, *mxw, RLX_AGENT);
            } else {
            pg8::Gemm g{WSP(bf16, WS_H), (const bf16*)(wl + (f ? WL_GU2 : WL_GU1)), M, 2 * FF, D, HP}; pg8::StaticOrder S; S.init(M, 2 * FF, F.G, F.bx);
            pg8::EpiSwiGLU E{WSP(bf16, WS_P), FF};
            pg8::gemm_phase<pg8::EpiSwiGLU, pg8::StaticOrder, GEMM_ALIGN, GEMM_SP2, HP == D ? 0 : HP>(F.lds + RING_OFF, g, S, E);
            }
        PH_END(false) }
        for (int rep = 0; rep < REP_F2; ++rep) { if (rep) --ph;
        PH_BEGIN
            if (s >= FP8_F2_S0) {
                pg8::Gemm g{WSP(bf16, WS_P), (const bf16*)(wl + WL_D2), M, D, FF / 2, FF / 2}; pg8::StaticOrder S; S.init(M, D, F.G, F.bx);
                const float sc = 1.0f / (fp8_scale(4.0f * __uint_as_float(((const gu32*)(ws + WS_CTL))[CW_WMAX + 7])) * wscale(ws, 6));
                pg8::EpiRaw8 E{WSP(bf16, WS_Y), D, sc};
                pg8::gemm_phase<pg8::EpiRaw8, pg8::StaticOrder, GEMM_ALIGN, GEMM_SP2, 0, true>(F.lds + RING_OFF, g, S, E);
            } else {
            pg8::Gemm g{WSP(bf16, WS_P), (const bf16*)(wl + (f ? WL_D2 : WL_D1)), M, D, FF, FF}; pg8::StaticOrder S; S.init(M, D, F.G, F.bx);
            pg8::EpiRawBf16 E{WSP(bf16, WS_Y), D};
            pg8::gemm_phase<pg8::EpiRawBf16, pg8::StaticOrder, GEMM_ALIGN, GEMM_SP2>(F.lds + RING_OFF, g, S, E);
            }
        PH_END(false) }
        for (int rep = 0; rep < REP_RP; ++rep) { if (rep) --ph;
        PH_BEGIN
            const float* gpost = A->in[f ? 29 : 5] + (size_t)l * D;
            const float* gpre = f ? (l + 1 < NL ? A->in[1] + (size_t)(l + 1) * D : nullptr) : A->in[6] + (size_t)l * D;
            const bool lastp = (s == 2 * NL - 1);
            rowpass(F, (s == 0) ? A->in[0] : nullptr, WSP(unsigned short, WS_XH), WSP(unsigned char, WS_XL), WSP(bf16, WS_Y), lastp ? A->out : nullptr, WSP(unsigned short, WS_XH), WSP(unsigned char, WS_XL), gpost, 0.5f, gpre, (gpre && !(f == 1 && s + 1 >= FP8_S0)) ? WSP(bf16, WS_H) : nullptr, (f == 0 || (gpre && s + 1 >= FP8_S0)) ? WSP(unsigned char, WS_H8) : nullptr);
        PH_END(s == 2 * NL - 1 && rep == REP_RP - 1) }
        if (f == 0) {
            for (int rep = 0; rep < REP_M1; ++rep) { if (rep) --ph;
        PH_BEGIN
                { pg8::Gemm g{WSP(bf16, WS_H), (const bf16*)(wl + WL_IN), M, PW, D, HP}; pg8::StaticOrder S; S.init(M, PW, F.G, F.bx);
                  pg8::EpiWin E{WSP(bf16, WS_P), PW, WSP(float, WS_LB) + l * 1024};
                  pg8::gemm_phase<pg8::EpiWin, pg8::StaticOrder, GEMM_ALIGN, GEMM_SP2, HP == D ? 0 : HP>(F.lds + RING_OFF, g, S, E); }
                { Frame F2 = mkframe(lds, (gu32*)(ws + WS_CTL));
                  pg8::Gemm g{WSP(bf16, WS_H8), (const bf16*)(wl + WL_IN + WL_IN8), M, 6144, D / 2, D / 2}; pg8::StaticOrder S; S.init(M, 6144, F2.G, F2.bx);
                  const float sc = 1.0f / (h8_scale(A->in[6] + (size_t)l * D, F2.lane) * wscale(ws, l));
                  pg8::EpiWinGate E{WSP(unsigned char, WS_MGQ), sc};
                  pg8::gemm_phase<pg8::EpiWinGate, pg8::StaticOrder, GEMM_ALIGN, GEMM_SP2, 0, true>(F2.lds + RING_OFF, g, S, E); }
            PH_END(false) }
            for (int rep = 0; rep < REP_M3; ++rep) { if (rep) --ph;
            PH_BEGIN
                { Frame F2 = mkframe(lds, (gu32*)(ws + WS_CTL));
                  lrgg_phase(F2, WSP(bf16, WS_H), (const bf16*)(wl + WL_IN) + (size_t)NIN * D, A->in[15] + (size_t)l * 16 * 512, A->in[16] + l * 512, WSP(float, WS_GG));
                  pg8::GateOrder S2; S2.init(M, 2048, F2.G, F2.bx); pg8::Unit u;
#pragma unroll 1
                  for (int i = 0; S2.next(i, u); ++i) conv_item(WSP(bf16, WS_P), A->in[8] + (size_t)l * 4 * 1024, A->in[9] + (size_t)l * 1024, WSP(bf16, WS_XC), 256 * (u.pn >> 1) + 8 * (F2.tid & 31), 256 * u.pm + 16 * (F2.tid >> 5));
                  VM_WAIT(); __syncthreads(); }
                int kgate = 256; asm volatile("" : "+s"(kgate));
                pg8::Gemm g{WSP(bf16, WS_XC), (const bf16*)(wl + WL_GT), M, 2048, kgate, 1024}; pg8::GateOrder S; S.init(M, 2048, F.G, F.bx);
                pg8::EpiGate8 E{WSP(unsigned char, WS_GT), A->in[11] + l * 1024, A->in[13] + l * 1024};
                pg8::gemm_phase<pg8::EpiGate8, pg8::GateOrder, GEMM_ALIGN, GEMM_SP2, 1024>(F.lds + RING_OFF, g, S, E);
            PH_END(false) }
            for (int rep = 0; rep < REP_M4; ++rep) { if (rep) --ph;
            PH_BEGIN
                lru_chunk_phase<false>(F, WSP(unsigned char, WS_GT), WSP(bf16, WS_XC), WSP(bf16, WS_P), A->in[11] + l * 1024, A->in[13] + l * 1024, A->in[14] + l * 1024, WSP(float, WS_CA), WSP(float, WS_CH), WSP(float, WS_HIN), WSP(bf16, WS_YA), F.bx < 128 ? LRUA_G * F.bx : 128 * LRUA_G + (8 - LRUA_G) * (F.bx - 128), F.bx < 128 ? LRUA_G * F.bx + LRUA_G : 128 * LRUA_G + (8 - LRUA_G) * (F.bx - 127));
                if (F.bx < 128) la_segment<0, false>(F, F.bx, WSP(bf16, WS_P), WSP(float, WS_GG), WSP(float, WS_LB) + l * 1024, A->in[17] + l * 256, WSP(float, WS_SLOC), WSP(float, WS_LDT), WSP(float, WS_SIN), WSP(bf16, WS_YB));
                else la_segment<1, false>(F, F.bx - 128, WSP(bf16, WS_P), WSP(float, WS_GG), WSP(float, WS_LB) + l * 1024, A->in[19] + l * 128, WSP(float, WS_SLOC), WSP(float, WS_LDT), WSP(float, WS_SIN), WSP(bf16, WS_YC));
            PH_END(false) }
            for (int rep = 0; rep < REP_M5; ++rep) { if (rep) --ph;
            PH_BEGIN
                lru_carry_phase(F, WSP(float, WS_CA), WSP(float, WS_CH), WSP(float, WS_HIN));
                if (F.bx < 128) la_prefix<0>(F, F.bx * 512 + F.tid, WSP(float, WS_SLOC), WSP(float, WS_LDT), WSP(float, WS_SIN));
                else la_prefix<1>(F, (F.bx - 128) * 512 + F.tid, WSP(float, WS_SLOC), WSP(float, WS_LDT), WSP(float, WS_SIN));
            PH_END(false) }
            for (int rep = 0; rep < REP_M6; ++rep) { if (rep) --ph;
            PH_BEGIN
                if (rep == 0) lru_chunk_phase<true>(F, WSP(unsigned char, WS_GT), WSP(bf16, WS_XC), WSP(bf16, WS_P), A->in[11] + l * 1024, A->in[13] + l * 1024, A->in[14] + l * 1024, WSP(float, WS_CA), WSP(float, WS_CH), WSP(float, WS_HIN), WSP(bf16, WS_YA), F.bx < 128 ? LRUC_G * F.bx : 128 * LRUC_G + (8 - LRUC_G) * (F.bx - 128), F.bx < 128 ? LRUC_G * F.bx + LRUC_G : 128 * LRUC_G + (8 - LRUC_G) * (F.bx - 127));
                if (F.bx < 128) { if (rep == 0 || PROBE_SECOND != 2) la_segment<0, true>(F, F.bx, WSP(bf16, WS_P), WSP(float, WS_GG), WSP(float, WS_LB) + l * 1024, A->in[17] + l * 256, WSP(float, WS_SLOC), WSP(float, WS_LDT), WSP(float, WS_SIN), WSP(bf16, WS_YB)); }
                else if (rep == 0 || PROBE_SECOND != 1) la_segment<1, true>(F, F.bx - 128, WSP(bf16, WS_P), WSP(float, WS_GG), WSP(float, WS_LB) + l * 1024, A->in[19] + l * 128, WSP(float, WS_SLOC), WSP(float, WS_LDT), WSP(float, WS_SIN), WSP(bf16, WS_YC));
            PH_END(false) }
            for (int rep = 0; rep < REP_M7; ++rep) { if (rep) --ph;
        PH_BEGIN
                pg8::Gemm g{WSP(bf16, WS_YA), (const bf16*)(wl + WL_BR), M, D, 1024, 1024}; pg8::BranchOrder S; S.init(M, D, F.G, F.bx);
                S.astride = (size_t)M * 1024 * 2; S.bstride = (size_t)D * 1024 * 2;
                pg8::EpiBranchFused E{WSP(unsigned char, WS_MGQ), WSP(bf16, WS_MG), D};
                pg8::gemm_phase<pg8::EpiBranchFused, pg8::BranchOrder, GEMM_ALIGN, GEMM_SP2>(F.lds + RING_OFF, g, S, E);
            PH_END(false) }
            for (int rep = 0; rep < REP_M8; ++rep) { if (rep) --ph;
        PH_BEGIN
                pg8::Gemm g{WSP(bf16, WS_MG), (const bf16*)(wl + WL_OUT), M, D, D, D}; pg8::StaticOrder S; S.init(M, D, F.G, F.bx);
                pg8::EpiRawBf16 E{WSP(bf16, WS_Y), D};
                pg8::gemm_phase<pg8::EpiRawBf16, pg8::StaticOrder, GEMM_ALIGN, GEMM_SP2>(F.lds + RING_OFF, g, S, E);
            PH_END(false) }
            for (int rep = 0; rep < REP_RP; ++rep) { if (rep) --ph;
            PH_BEGIN
                rowpass(F, nullptr, WSP(unsigned short, WS_XH), WSP(unsigned char, WS_XL), WSP(bf16, WS_Y), nullptr, WSP(unsigned short, WS_XH), WSP(unsigned char, WS_XL), A->in[24] + (size_t)l * D, 1.0f, A->in[25] + (size_t)l * D, 2 * l + 1 >= FP8_S0 ? nullptr : WSP(bf16, WS_H), 2 * l + 1 >= FP8_S0 ? WSP(unsigned char, WS_H8) : nullptr);
            PH_END(false) }
        }
    }
}

static int gridDimOk() { return 1; }
extern "C" void kernel_launch(void* const* d_in, const int* in_sizes, int n_in, void* d_out, int out_size, void* d_ws, size_t ws_size, hipStream_t stream) {
    static int grid = 0;
    if (grid == 0) {
        if (n_in != 30 || in_sizes[0] != M * D || out_size != M * D || ws_size < WS_END || gridDimOk() == 0) { fprintf(stderr, "kernel_launch: unexpected shapes (n_in %d, in0 %d, out %d, ws %zu < %zu)\n", n_in, n_in > 0 ? in_sizes[0] : -1, out_size, ws_size, (size_t)WS_END); grid = -1; return; }
        int dev = 0, cus = 0, per_cu = 0;
        if (hipGetDevice(&dev) != hipSuccess || hipDeviceGetAttribute(&cus, hipDeviceAttributeMultiprocessorCount, dev) != hipSuccess) { grid = -1; return; }
        if (hipFuncSetAttribute((const void*)fwd_kernel, hipFuncAttributeMaxDynamicSharedMemorySize, LDS_BYTES) != hipSuccess) { fprintf(stderr, "kernel_launch: hipFuncSetAttribute failed\n"); grid = -1; return; }
        if (hipOccupancyMaxActiveBlocksPerMultiprocessor(&per_cu, (const void*)fwd_kernel, NWAVES * 64, LDS_BYTES) != hipSuccess || per_cu < 1) fprintf(stderr, "kernel_launch: occupancy query says %d\n", per_cu);
        (void)hipGetLastError();
        grid = cus;
    }
    if (grid < 0) return;
    if (hipMemsetAsync((char*)d_ws + WS_CTL, 0, CTL_ZERO_BYTES, stream) != hipSuccess) return;
    Args a{};
    for (int i = 0; i < 30; ++i) a.in[i] = (const float*)d_in[i];
    a.out = (float*)d_out; a.ws = (unsigned char*)d_ws; a.ph_lo = 0; a.ph_hi = 1 << 20;
    hipLaunchKernelGGL(fwd_kernel, dim3(grid), dim3(NWAVES * 64), LDS_BYTES, stream, a);
}
```

```cpp
#include <hip/hip_runtime.h>
#include <cstdio>
#include <cstdint>
#ifndef FP8_S0
#define FP8_S0 5
#endif
#ifndef FP8_F2_S0
#define FP8_F2_S0 6
#endif
#ifndef G8_L0
#define G8_L0 1
#endif
#ifndef LRUA_G
#define LRUA_G 5
#endif
#ifndef LRUC_G
#define LRUC_G 6
#endif
#ifndef REP_M2
#define REP_M2 1
#endif
#ifndef REP_M4
#define REP_M4 1
#endif
#ifndef REP_M5
#define REP_M5 1
#endif
#ifndef REP_M6
#define REP_M6 1
#endif
#ifndef REP_F1
#define REP_F1 1
#endif
#ifndef REP_F2
#define REP_F2 1
#endif
#ifndef REP_M1
#define REP_M1 1
#endif
#ifndef REP_M3
#define REP_M3 1
#endif
#ifndef REP_M7
#define REP_M7 1
#endif
#ifndef REP_M8
#define REP_M8 1
#endif
#ifndef REP_P0
#define REP_P0 1
#endif
#ifndef REP_LAG
#define REP_LAG 1
#endif
#ifndef REP_LAH
#define REP_LAH 1
#endif
#ifndef GEMM_SP2
#define GEMM_SP2 true
#endif
#ifndef GEMM_ALIGN
#define GEMM_ALIGN true
#endif
#ifndef PROBE_SECOND
#define PROBE_SECOND 0
#endif
#ifndef REP_RP
#define REP_RP 1
#endif
namespace pg8 {
#define PG8_LAS __attribute__((address_space(3)))
typedef unsigned short bf16_t;
typedef short bf16x8 __attribute__((ext_vector_type(8)));
typedef float f32x4 __attribute__((ext_vector_type(4)));
typedef unsigned u32x4 __attribute__((ext_vector_type(4)));
constexpr int BM = 256, BK = 64, HALF = 128, HTB = HALF * BK * 2  , STAGE_BYTES = 8 * HTB, NXCD = 8, WGM = 8;

__host__ __device__ __forceinline__ int lds_byte(int r, int c) { const int st = (r >> 4) * 2 + (c >> 5), rr = r & 15, cc = c & 31, ob = rr * 64 + cc * 2; return st * 1024 + (ob ^ (((ob >> 9) & 1) << 5)); }
__host__ __device__ __forceinline__ void stage_rc(int b, int& R, int& C) { const int st = b / 1024, sb = b % 1024, swz = sb ^ (((sb >> 9) & 1) << 5); R = (st >> 1) * 16 + swz / 64; C = (st & 1) * 32 + (swz % 64) / 2; }
__host__ __device__ __forceinline__ int perm32(int rho) { const int n = rho >> 4, i = rho & 15; return 8 * (i >> 2) + 4 * n + (i & 3); }

struct Unit { int pm, pn, seg; };
struct Gemm { const bf16_t* A; const bf16_t* Bt; int M, N, K, lda; };

struct StaticOrder {
    int nM, nN, nwg, G, c;
    __host__ __device__ void init(int M, int N, int G_, int c_) { nM = M / BM; nN = N / BM; nwg = nM * nN; G = G_; c = c_; }
    __host__ __device__ __forceinline__ bool next(int i, Unit& u) const {
        const long L = (long)i * G + c; if (L >= nwg) return false;
        int wgid = (int)L; { const int q = nwg / NXCD, r = nwg % NXCD, xcd = wgid % NXCD, off = wgid / NXCD; wgid = (xcd < r ? xcd * (q + 1) : r * (q + 1) + (xcd - r) * q) + off; }
        const int nig = WGM * nN, gid = wgid / nig, fm = gid * WGM, gsz = (nM - fm) < WGM ? (nM - fm) : WGM;
        u.pm = fm + ((wgid % nig) % gsz); u.pn = (wgid % nig) / gsz; u.seg = 0; return true;
    }
    __device__ __forceinline__ const char* pa(const Gemm& g, const Unit& u, size_t tstep) const { return (const char*)g.A + (size_t)u.pm * tstep; }
    __device__ __forceinline__ const char* pb(const Gemm& g, const Unit& u, size_t tstep) const { return (const char*)g.Bt + (size_t)u.pn * tstep; }
    __device__ __forceinline__ void a_ready(const Unit&) const {}
    __device__ __forceinline__ void done(const Unit&) const {}
};

typedef float f32x2c __attribute__((ext_vector_type(2))); typedef __bf16 bf16x2c __attribute__((ext_vector_type(2)));
__device__ __forceinline__ unsigned cvt_pk_bf16(float lo, float hi) { f32x2c v = {lo, hi}; bf16x2c b = __builtin_convertvector(v, bf16x2c); return __builtin_bit_cast(unsigned, b); }
typedef float f32x2 __attribute__((ext_vector_type(2)));
__device__ __forceinline__ float bf_lo(unsigned w) { return __uint_as_float(w << 16); }
__device__ __forceinline__ float bf_hi(unsigned w) { return __uint_as_float(w & 0xffff0000u); }
__device__ __forceinline__ float sigmoidf_fast(float x) { return __builtin_amdgcn_rcpf(1.0f + __builtin_amdgcn_exp2f(-1.44269504089f * x)); }
typedef unsigned u32x2 __attribute__((ext_vector_type(2)));

struct EpiF32 {
    static constexpr bool PERM = false, AFTER_DRAIN = false, SEGMENTED = false;
    float* C; int ldc;
    __device__ __forceinline__ void operator()(const f32x4 (&acc)[2][2][4][2], const Unit& u, int wr, int wc, int fr, int fq) const {
        const int row0 = u.pm * BM + wr * 64 + fr, col0 = u.pn * BM + wc * 32 + 4 * fq;
#pragma unroll
        for (int ai = 0; ai < 2; ++ai)
#pragma unroll
            for (int m = 0; m < 4; ++m) { float* rowp = C + (size_t)(row0 + ai * HALF + m * 16) * ldc + col0;
#pragma unroll
                for (int bj = 0; bj < 2; ++bj)
#pragma unroll
                    for (int n = 0; n < 2; ++n) *(f32x4*)(rowp + bj * HALF + n * 16) = acc[ai][bj][m][n]; }
    }
};
struct EpiRawBf16 {
    static constexpr bool PERM = true, AFTER_DRAIN = false, SEGMENTED = false;
    bf16_t* O; int ldc;
    __device__ __forceinline__ void operator()(const f32x4 (&acc)[2][2][4][2], const Unit& u, int wr, int wc, int fr, int fq) const {
        const int row0 = u.pm * BM + wr * 64 + fr, col0 = u.pn * BM + wc * 32 + 8 * fq;
#pragma unroll
        for (int ai = 0; ai < 2; ++ai)
#pragma unroll
            for (int m = 0; m < 4; ++m) { bf16_t* rowp = O + (size_t)(row0 + ai * HALF + m * 16) * ldc + col0;
#pragma unroll
                for (int bj = 0; bj < 2; ++bj) { const f32x4 v0 = acc[ai][bj][m][0], v1 = acc[ai][bj][m][1];
                    u32x4 w; w.x = cvt_pk_bf16(v0[0], v0[1]); w.y = cvt_pk_bf16(v0[2], v0[3]); w.z = cvt_pk_bf16(v1[0], v1[1]); w.w = cvt_pk_bf16(v1[2], v1[3]);
                    *(u32x4*)(rowp + bj * HALF) = w; } }
    }
};
struct EpiWin {
    static constexpr bool PERM = true, AFTER_DRAIN = false, SEGMENTED = false;
    bf16_t* O; int ldc; const float* lb;
    __device__ __forceinline__ void operator()(const f32x4 (&acc)[2][2][4][2], const Unit& u, int wr, int wc, int fr, int fq) const {
        const int row0 = u.pm * BM + wr * 64 + fr, colt = wc * 32 + 8 * fq;
        const int kind = (u.pn == 8 || u.pn == 9) ? 1 : ((u.pn >= 20 && u.pn < 24) ? 2 : ((u.pn >= 24 && u.pn < 28) ? 3 : 0));
        float lbv[2][8];
#pragma unroll
        for (int bj = 0; bj < 2; ++bj)
#pragma unroll
            for (int k = 0; k < 8; ++k) lbv[bj][k] = kind == 3 ? lb[(u.pn - 24) * BM + bj * HALF + colt + k] : 0.f;
#pragma unroll
        for (int ai = 0; ai < 2; ++ai)
#pragma unroll
            for (int m = 0; m < 4; ++m) { const size_t row = (size_t)(row0 + ai * HALF + m * 16);
#pragma unroll
                for (int bj = 0; bj < 2; ++bj) { const f32x4 v0 = acc[ai][bj][m][0], v1 = acc[ai][bj][m][1];
                    f32x4 x0 = v0, x1 = v1;
                    if (kind == 1) { x0 = x0 * 0.08838834764831845f; x1 = x1 * 0.08838834764831845f; }
                    else if (kind == 2) {
#pragma unroll
                        for (int j = 0; j < 4; ++j) { x0[j] = x0[j] * sigmoidf_fast(x0[j]); x1[j] = x1[j] * sigmoidf_fast(x1[j]); } }
                    else if (kind == 3) {
#pragma unroll
                        for (int j = 0; j < 4; ++j) { const float la = lbv[bj][j], lc = lbv[bj][4 + j];
                            x0[j] = 0.69314718056f * __builtin_amdgcn_logf(la + (1.0f - la) * sigmoidf_fast(x0[j])); x1[j] = 0.69314718056f * __builtin_amdgcn_logf(lc + (1.0f - lc) * sigmoidf_fast(x1[j])); } }
                    u32x4 w; w.x = cvt_pk_bf16(x0[0], x0[1]); w.y = cvt_pk_bf16(x0[2], x0[3]); w.z = cvt_pk_bf16(x1[0], x1[1]); w.w = cvt_pk_bf16(x1[2], x1[3]);
                    *(u32x4*)(O + row * ldc + u.pn * BM + colt + bj * HALF) = w; } }
    }
};
struct EpiWinGate {
    static constexpr bool PERM = true, AFTER_DRAIN = false, SEGMENTED = false;
    unsigned char* Q; float sc;
    __device__ __forceinline__ void operator()(const f32x4 (&acc)[2][2][4][2], const Unit& u, int wr, int wc, int fr, int fq) const {
        const int row0 = u.pm * BM + wr * 64 + fr, colt = wc * 32 + 8 * fq;
#pragma unroll
        for (int ai = 0; ai < 2; ++ai)
#pragma unroll
            for (int m = 0; m < 4; ++m) { const size_t row = (size_t)(row0 + ai * HALF + m * 16);
#pragma unroll
                for (int bj = 0; bj < 2; ++bj) { const f32x4 v0 = acc[ai][bj][m][0] * sc, v1 = acc[ai][bj][m][1] * sc; unsigned q[8];
#pragma unroll
                    for (int j = 0; j < 4; ++j) { const float s0 = 255.0f * __builtin_amdgcn_rcpf(1.0f + __builtin_amdgcn_exp2f(-1.44269504089f * __builtin_amdgcn_fmed3f(v0[j], -30.f, 30.f))) + 0.5f,
                                                              s1 = 255.0f * __builtin_amdgcn_rcpf(1.0f + __builtin_amdgcn_exp2f(-1.44269504089f * __builtin_amdgcn_fmed3f(v1[j], -30.f, 30.f))) + 0.5f;
                        q[j] = (unsigned)__builtin_amdgcn_fmed3f(s0, 1.0f, 255.0f); q[4 + j] = (unsigned)__builtin_amdgcn_fmed3f(s1, 1.0f, 255.0f); }
                    u32x2 w; w.x = q[0] | (q[1] << 8) | (q[2] << 16) | (q[3] << 24); w.y = q[4] | (q[5] << 8) | (q[6] << 16) | (q[7] << 24);
                    *(u32x2*)(Q + row * 6144 + u.pn * BM + colt + bj * HALF) = w; } }
    }
};
struct EpiWinFull {
    static constexpr bool PERM = true, AFTER_DRAIN = false, SEGMENTED = false;
    bf16_t* O; int ldc; unsigned char* Q; const float* lb;
    __device__ __forceinline__ void operator()(const f32x4 (&acc)[2][2][4][2], const Unit& u, int wr, int wc, int fr, int fq) const {
        const int row0 = u.pm * BM + wr * 64 + fr, colt = wc * 32 + 8 * fq; const bool gate = u.pn >= 36;
        const int kind = (u.pn == 8 || u.pn == 9) ? 1 : ((u.pn >= 20 && u.pn < 24) ? 2 : ((u.pn >= 24 && u.pn < 28) ? 3 : 0));
        float lbv[2][8];
#pragma unroll
        for (int bj = 0; bj < 2; ++bj)
#pragma unroll
            for (int k = 0; k < 8; ++k) lbv[bj][k] = kind == 3 ? lb[(u.pn - 24) * BM + bj * HALF + colt + k] : 0.f;
#pragma unroll
        for (int ai = 0; ai < 2; ++ai)
#pragma unroll
            for (int m = 0; m < 4; ++m) { const size_t row = (size_t)(row0 + ai * HALF + m * 16);
#pragma unroll
                for (int bj = 0; bj < 2; ++bj) { const f32x4 v0 = acc[ai][bj][m][0], v1 = acc[ai][bj][m][1];
                    if (gate) { unsigned q[8];
#pragma unroll
                        for (int j = 0; j < 4; ++j) { const float s0 = 255.0f * __builtin_amdgcn_rcpf(1.0f + __builtin_amdgcn_exp2f(-1.44269504089f * __builtin_amdgcn_fmed3f(v0[j], -30.f, 30.f))) + 0.5f,
                                                                  s1 = 255.0f * __builtin_amdgcn_rcpf(1.0f + __builtin_amdgcn_exp2f(-1.44269504089f * __builtin_amdgcn_fmed3f(v1[j], -30.f, 30.f))) + 0.5f;
                            q[j] = (unsigned)__builtin_amdgcn_fmed3f(s0, 1.0f, 255.0f); q[4 + j] = (unsigned)__builtin_amdgcn_fmed3f(s1, 1.0f, 255.0f); }
                        u32x2 w; w.x = q[0] | (q[1] << 8) | (q[2] << 16) | (q[3] << 24); w.y = q[4] | (q[5] << 8) | (q[6] << 16) | (q[7] << 24);
                        *(u32x2*)(Q + row * 6144 + (u.pn - 36) * BM + colt + bj * HALF) = w; }
                    else { f32x4 x0 = v0, x1 = v1;
                        if (kind == 1) { x0 = x0 * 0.08838834764831845f; x1 = x1 * 0.08838834764831845f; }
                        else if (kind == 2) {
#pragma unroll
                            for (int j = 0; j < 4; ++j) { x0[j] = x0[j] * sigmoidf_fast(x0[j]); x1[j] = x1[j] * sigmoidf_fast(x1[j]); } }
                        else if (kind == 3) {
#pragma unroll
                            for (int j = 0; j < 4; ++j) { const float la = lbv[bj][j], lc = lbv[bj][4 + j];
                                x0[j] = 0.69314718056f * __builtin_amdgcn_logf(la + (1.0f - la) * sigmoidf_fast(x0[j])); x1[j] = 0.69314718056f * __builtin_amdgcn_logf(lc + (1.0f - lc) * sigmoidf_fast(x1[j])); } }
                        u32x4 w; w.x = cvt_pk_bf16(x0[0], x0[1]); w.y = cvt_pk_bf16(x0[2], x0[3]); w.z = cvt_pk_bf16(x1[0], x1[1]); w.w = cvt_pk_bf16(x1[2], x1[3]);
                        *(u32x4*)(O + row * ldc + u.pn * BM + colt + bj * HALF) = w; } } }
    }
};
struct EpiGate8 {
    static constexpr bool PERM = true, AFTER_DRAIN = false, SEGMENTED = false;
    unsigned char* Q; const float* ba; const float* bx;
    __device__ __forceinline__ void operator()(const f32x4 (&acc)[2][2][4][2], const Unit& u, int wr, int wc, int fr, int fq) const {
        const int row0 = u.pm * BM + wr * 64 + fr, colt = wc * 32 + 8 * fq, ch = u.pn * HALF + colt;
        float b[2][8];
#pragma unroll
        for (int k = 0; k < 8; ++k) { b[0][k] = ba[ch + k]; b[1][k] = bx[ch + k]; }
#pragma unroll
        for (int ai = 0; ai < 2; ++ai)
#pragma unroll
            for (int m = 0; m < 4; ++m) { unsigned char* rowp = Q + (size_t)(row0 + ai * HALF + m * 16) * 2048 + u.pn * BM + colt;
#pragma unroll
                for (int bj = 0; bj < 2; ++bj) { const f32x4 v0 = acc[ai][bj][m][0], v1 = acc[ai][bj][m][1]; unsigned q[8];
#pragma unroll
                    for (int j = 0; j < 4; ++j) { q[j] = (unsigned)(255.0f * sigmoidf_fast(v0[j] + b[bj][j]) + 0.5f); q[4 + j] = (unsigned)(255.0f * sigmoidf_fast(v1[j] + b[bj][4 + j]) + 0.5f); }
                    u32x2 w; w.x = q[0] | (q[1] << 8) | (q[2] << 16) | (q[3] << 24); w.y = q[4] | (q[5] << 8) | (q[6] << 16) | (q[7] << 24);
                    *(u32x2*)(rowp + bj * HALF) = w; } }
    }
};
struct EpiSwiGLU {
    static constexpr bool PERM = true, AFTER_DRAIN = false, SEGMENTED = false;
    bf16_t* O; int ldc;
    __device__ __forceinline__ void operator()(const f32x4 (&acc)[2][2][4][2], const Unit& u, int wr, int wc, int fr, int fq) const {
        const int row0 = u.pm * BM + wr * 64 + fr, col0 = u.pn * HALF + wc * 32 + 8 * fq;
#pragma unroll
        for (int ai = 0; ai < 2; ++ai)
#pragma unroll
            for (int m = 0; m < 4; ++m) { bf16_t* rowp = O + (size_t)(row0 + ai * HALF + m * 16) * ldc + col0;
                float r[8];
#pragma unroll
                for (int n = 0; n < 2; ++n)
#pragma unroll
                    for (int j = 0; j < 4; ++j) { const float g = acc[ai][0][m][n][j], up = acc[ai][1][m][n][j]; r[n * 4 + j] = g * sigmoidf_fast(g) * up; }
                u32x4 w; w.x = cvt_pk_bf16(r[0], r[1]); w.y = cvt_pk_bf16(r[2], r[3]); w.z = cvt_pk_bf16(r[4], r[5]); w.w = cvt_pk_bf16(r[6], r[7]);
                *(u32x4*)rowp = w; }
    }
};
__device__ __forceinline__ unsigned cvt_pk4_fp8(float a, float b, float c, float d) { int w = 0; w = __builtin_amdgcn_cvt_pk_fp8_f32(a, b, w, false); w = __builtin_amdgcn_cvt_pk_fp8_f32(c, d, w, true); return (unsigned)w; }
struct EpiSwiGLU8 {
    static constexpr bool PERM = true, AFTER_DRAIN = false, SEGMENTED = false;
    bf16_t* O; int ldc; float sc; unsigned char* O8; float s8; PG8_LAS unsigned* mx;
    __device__ __forceinline__ void operator()(const f32x4 (&acc)[2][2][4][2], const Unit& u, int wr, int wc, int fr, int fq) const {
        const int row0 = u.pm * BM + wr * 64 + fr, col0 = u.pn * HALF + wc * 32 + 8 * fq;
        float lm = 0.f;
#pragma unroll
        for (int ai = 0; ai < 2; ++ai)
#pragma unroll
            for (int m = 0; m < 4; ++m) { const size_t ro = (size_t)(row0 + ai * HALF + m * 16) * ldc + col0;
                float r[8];
#pragma unroll
                for (int n = 0; n < 2; ++n)
#pragma unroll
                    for (int j = 0; j < 4; ++j) { const float g = acc[ai][0][m][n][j] * sc, up = acc[ai][1][m][n][j] * sc; r[n * 4 + j] = g * sigmoidf_fast(g) * up; }
#pragma unroll
                for (int k = 0; k < 8; ++k) lm = fmaxf(lm, fabsf(r[k]));
                if (O8) {
#pragma unroll
                    for (int k = 0; k < 8; ++k) r[k] = __builtin_amdgcn_fmed3f(r[k] * s8, -448.0f, 448.0f);
                    u32x2 w; w.x = cvt_pk4_fp8(r[0], r[1], r[2], r[3]); w.y = cvt_pk4_fp8(r[4], r[5], r[6], r[7]); *(u32x2*)(O8 + ro) = w; }
                else {
                    u32x4 w; w.x = cvt_pk_bf16(r[0], r[1]); w.y = cvt_pk_bf16(r[2], r[3]); w.z = cvt_pk_bf16(r[4], r[5]); w.w = cvt_pk_bf16(r[6], r[7]);
                    *(u32x4*)(O + ro) = w; } }
        if (mx) {
#pragma unroll
            for (int o = 1; o < 64; o <<= 1) lm = fmaxf(lm, __shfl_xor(lm, o));
            if ((fr | fq) == 0) __hip_atomic_fetch_max(mx, __float_as_uint(lm), __ATOMIC_RELAXED, __HIP_MEMORY_SCOPE_WORKGROUP);
            asm volatile("s_waitcnt lgkmcnt(0)" ::: "memory"); }
    }
};
struct EpiRaw8 {
    static constexpr bool PERM = true, AFTER_DRAIN = false, SEGMENTED = false;
    bf16_t* O; int ldc; float sc;
    __device__ __forceinline__ void operator()(const f32x4 (&acc)[2][2][4][2], const Unit& u, int wr, int wc, int fr, int fq) const {
        const int row0 = u.pm * BM + wr * 64 + fr, col0 = u.pn * BM + wc * 32 + 8 * fq;
#pragma unroll
        for (int ai = 0; ai < 2; ++ai)
#pragma unroll
            for (int m = 0; m < 4; ++m) { bf16_t* rowp = O + (size_t)(row0 + ai * HALF + m * 16) * ldc + col0;
#pragma unroll
                for (int bj = 0; bj < 2; ++bj) { const f32x4 v0 = acc[ai][bj][m][0] * sc, v1 = acc[ai][bj][m][1] * sc;
                    u32x4 w; w.x = cvt_pk_bf16(v0[0], v0[1]); w.y = cvt_pk_bf16(v0[2], v0[3]); w.z = cvt_pk_bf16(v1[0], v1[1]); w.w = cvt_pk_bf16(v1[2], v1[3]);
                    *(u32x4*)(rowp + bj * HALF) = w; } }
    }
};
struct GateOrder : StaticOrder {
    __device__ __forceinline__ const char* pa(const Gemm& g, const Unit& u, size_t tstep) const { return (const char*)g.A + (size_t)(u.pn >> 1) * 512 + (size_t)u.pm * tstep; }
};
struct BranchOrder : StaticOrder {
    size_t astride, bstride;
    __device__ __forceinline__ bool next(int i, Unit& u) const { const int ti = i / 3, sg = i - 3 * ti; if (!StaticOrder::next(ti, u)) return false; u.seg = sg; return true; }
    __device__ __forceinline__ const char* pa(const Gemm& g, const Unit& u, size_t tstep) const { return (const char*)g.A + (size_t)u.seg * astride + (size_t)u.pm * tstep; }
    __device__ __forceinline__ const char* pb(const Gemm& g, const Unit& u, size_t tstep) const { return (const char*)g.Bt + (size_t)u.seg * bstride + (size_t)u.pn * tstep; }
};
__device__ __forceinline__ float ub0(unsigned w) { return (float)(w & 0xFFu); }
__device__ __forceinline__ float ub1(unsigned w) { return (float)((w >> 8) & 0xFFu); }
__device__ __forceinline__ float ub2(unsigned w) { return (float)((w >> 16) & 0xFFu); }
__device__ __forceinline__ float ub3(unsigned w) { return (float)(w >> 24); }
struct EpiBranchFused {
    static constexpr bool PERM = true, AFTER_DRAIN = false, SEGMENTED = true;
    const unsigned char* Q; bf16_t* MO; int ld;
    __device__ __forceinline__ void operator()(f32x4 (&acc)[2][2][4][2], const Unit& u, int wr, int wc, int fr, int fq) const {
        const int row0 = u.pm * BM + wr * 64 + fr, col0 = u.pn * BM + wc * 32 + 8 * fq; const int sg = u.seg; const bool fin = sg == 2;
        const unsigned char* qn = Q + (size_t)row0 * 6144 + sg * 2048 + col0; const unsigned char* qd = fin ? qn : qn + 2048;
        u32x2 gn[2][4][2], gd[2][4][2];
#define BR_LOAD(ai_) do { _Pragma("unroll") for (int m = 0; m < 4; ++m) _Pragma("unroll") for (int bj = 0; bj < 2; ++bj) { const size_t go = (size_t)((ai_) * HALF + m * 16) * 6144 + bj * HALF; \
            gn[ai_][m][bj] = *(const u32x2*)(qn + go); gd[ai_][m][bj] = *(const u32x2*)(qd + go); } } while (0)
        BR_LOAD(0); BR_LOAD(1);
#pragma unroll
        for (int ai = 0; ai < 2; ++ai) {
#pragma unroll
            for (int m = 0; m < 4; ++m)
#pragma unroll
                for (int bj = 0; bj < 2; ++bj) { const u32x2 a = gn[ai][m][bj], d = gd[ai][m][bj];
                    const float an[8] = {ub0(a.x), ub1(a.x), ub2(a.x), ub3(a.x), ub0(a.y), ub1(a.y), ub2(a.y), ub3(a.y)};
                    const float dn[8] = {ub0(d.x), ub1(d.x), ub2(d.x), ub3(d.x), ub0(d.y), ub1(d.y), ub2(d.y), ub3(d.y)};
                    float f[8];
#pragma unroll
                    for (int k = 0; k < 8; ++k) { const float rd = __builtin_amdgcn_rcpf(dn[k]); f[k] = an[k] * (fin ? (1.0f / 255.0f) : rd); }
                    f32x4 v0 = acc[ai][bj][m][0], v1 = acc[ai][bj][m][1];
                    v0[0] *= f[0]; v0[1] *= f[1]; v0[2] *= f[2]; v0[3] *= f[3]; v1[0] *= f[4]; v1[1] *= f[5]; v1[2] *= f[6]; v1[3] *= f[7];
                    acc[ai][bj][m][0] = v0; acc[ai][bj][m][1] = v1;
                    if (fin) { u32x4 w; w.x = cvt_pk_bf16(v0[0], v0[1]); w.y = cvt_pk_bf16(v0[2], v0[3]); w.z = cvt_pk_bf16(v1[0], v1[1]); w.w = cvt_pk_bf16(v1[2], v1[3]);
                        *(u32x4*)(MO + (size_t)(row0 + ai * HALF + m * 16) * ld + col0 + bj * HALF) = w; } }
        }
#undef BR_LOAD
    }
};

typedef int i32x4 __attribute__((ext_vector_type(4))); typedef int i32x8 __attribute__((ext_vector_type(8)));
__device__ __forceinline__ i32x8 cat8(const bf16x8 a, const bf16x8 b) { const i32x4 x = __builtin_bit_cast(i32x4, a), y = __builtin_bit_cast(i32x4, b); return __builtin_shufflevector(x, y, 0, 1, 2, 3, 4, 5, 6, 7); }
__device__ __forceinline__ void mfma_fp8_acc(f32x4& acc, const i32x8 b, const i32x8 a) { asm volatile("v_mfma_f32_16x16x128_f8f6f4 %0, %1, %2, %0" : "+v"(acc) : "v"(b), "v"(a)); }
template <class Epi, class Sched, bool ALIGN_EPI = false, bool SP2 = false, int LDA = 0  , bool FP8 = false>
__device__ __forceinline__ void gemm_phase(PG8_LAS unsigned char* lds, const Gemm g, const Sched& S, const Epi& E) {
    int tid_l = threadIdx.x; asm volatile("" : "+v"(tid_l)); const int tid = tid_l, wid = __builtin_amdgcn_readfirstlane(tid >> 6), lane = tid & 63, wr = wid >> 2, wc = wid & 3, fr = lane & 15, fq = lane >> 4;
    const int K = g.K, nt = K / BK;
    unsigned voffA[2], voffB[2];
#pragma unroll
    for (int i = 0; i < 2; ++i) { int R, C; stage_rc(tid * 16 + i * 8192, R, C); const int Rb = Epi::PERM ? ((R & ~31) + perm32(R & 31)) : R;
        voffA[i] = (unsigned)(R * (LDA ? LDA : K) + C) * 2u; voffB[i] = (unsigned)(Rb * K + C) * 2u; }
    const size_t kstep = (size_t)(BK * 2);
    const size_t hstepB = (size_t)HALF * K * 2, hstepA = LDA ? (size_t)HALF * LDA * 2 : hstepB;
    const size_t tstepA = 2 * hstepA, tstepB = 2 * hstepB;
    const unsigned ldsw = (unsigned)wid * 1024u;
    const int aoff = lds_byte(wr * 64 + fr, fq * 8), boff = lds_byte(wc * 32 + fr, fq * 8);
#define PG8_SA(b, h) (((b) * 2 + (h)) * HTB)
#define PG8_SB(b, h) ((4 + (b) * 2 + (h)) * HTB)
#define PG8_STAGE(bufoff, gbase, voff) do { _Pragma("unroll") for (int _i = 0; _i < 2; ++_i) \
        __builtin_amdgcn_global_load_lds((const unsigned*)((const char*)(gbase) + (voff)[_i]), (PG8_LAS unsigned*)(lds + (bufoff) + ldsw + _i * 8192), 16, 0, 0); } while (0)
#define PG8_LDA(dst, b, h) do { _Pragma("unroll") for (int m = 0; m < 4; ++m) _Pragma("unroll") for (int k = 0; k < 2; ++k) dst[m][k] = *(const PG8_LAS bf16x8*)(lds + PG8_SA(b, h) + aoff + m * 2048 + k * 1024); } while (0)
#define PG8_LDB(dst, b, h) do { _Pragma("unroll") for (int n = 0; n < 2; ++n) _Pragma("unroll") for (int k = 0; k < 2; ++k) dst[n][k] = *(const PG8_LAS bf16x8*)(lds + PG8_SB(b, h) + boff + n * 2048 + k * 1024); } while (0)
#define PG8_MMA(ai, bj, At, Bt) do { __builtin_amdgcn_s_setprio(1); _Pragma("unroll") for (int m = 0; m < 4; ++m) _Pragma("unroll") for (int n = 0; n < 2; ++n) { \
        if constexpr (FP8) mfma_fp8_acc(acc[ai][bj][m][n], cat8(Bt[n][0], Bt[n][1]), cat8(At[m][0], At[m][1])); \
        else { _Pragma("unroll") for (int k = 0; k < 2; ++k) acc[ai][bj][m][n] = __builtin_amdgcn_mfma_f32_16x16x32_bf16(Bt[n][k], At[m][k], acc[ai][bj][m][n], 0, 0, 0); } } __builtin_amdgcn_s_setprio(0); } while (0)
#define PG8_WAIT_V(n) asm volatile("s_waitcnt vmcnt(" #n ")" ::: "memory")
#define PG8_WAIT_L(n) asm volatile("s_waitcnt lgkmcnt(" #n ")" ::: "memory")
#define PG8_BAR __builtin_amdgcn_s_barrier()
#define PG8_SCHED __builtin_amdgcn_sched_barrier(0)
    Unit cur, nxt; int ui = 0;
    if (!S.next(0, cur)) return;
    f32x4 acc[2][2][4][2];
#pragma unroll
    for (int a = 0; a < 2; ++a)
#pragma unroll
        for (int b = 0; b < 2; ++b)
#pragma unroll
            for (int m = 0; m < 4; ++m)
#pragma unroll
                for (int n = 0; n < 2; ++n) acc[a][b][m][n] = (f32x4){0.f, 0.f, 0.f, 0.f};
    bf16x8 At[4][2], B0[2][2], B1[2][2];
    const char* cA = S.pa(g, cur, tstepA); const char* cB = S.pb(g, cur, tstepB);
    S.a_ready(cur);
    if constexpr (SP2) {
        PG8_STAGE(PG8_SB(0, 0), cB, voffB); PG8_STAGE(PG8_SB(0, 1), cB + hstepB, voffB); PG8_STAGE(PG8_SA(0, 0), cA, voffA); PG8_STAGE(PG8_SA(0, 1), cA + hstepA, voffA);
        if (wr == 1) PG8_BAR;
        PG8_WAIT_V(2); PG8_BAR;
        PG8_STAGE(PG8_SB(1, 0), cB + kstep, voffB); PG8_STAGE(PG8_SA(1, 0), cA + kstep, voffA); PG8_STAGE(PG8_SB(1, 1), cB + hstepB + kstep, voffB);
        PG8_WAIT_V(6); PG8_BAR;
    } else {
        PG8_STAGE(PG8_SB(0, 0), cB, voffB); PG8_STAGE(PG8_SA(0, 0), cA, voffA); PG8_STAGE(PG8_SB(0, 1), cB + hstepB, voffB); PG8_STAGE(PG8_SA(0, 1), cA + hstepA, voffA);
        if (wr == 1) PG8_BAR;
        PG8_WAIT_V(4); PG8_BAR;
        PG8_STAGE(PG8_SB(1, 0), cB + kstep, voffB); PG8_STAGE(PG8_SA(1, 0), cA + kstep, voffA); PG8_STAGE(PG8_SB(1, 1), cB + hstepB + kstep, voffB);
        PG8_WAIT_V(6); PG8_BAR;
    }
    for (;;) {
        const bool has_next = S.next(ui + 1, nxt);
        const char* nA = has_next ? S.pa(g, nxt, tstepA) : cA; const char* nB = has_next ? S.pb(g, nxt, tstepB) : cB;
        for (int t = 0; t < nt; t += 2) {
            const bool last = (t == nt - 2);
            const char* a1 = cA + (size_t)(t + 1) * kstep;
            const char* a2 = last ? nA : cA + (size_t)(t + 2) * kstep; const char* b2 = last ? nB : cB + (size_t)(t + 2) * kstep;
            const char* a3 = a2 + kstep; const char* b3 = b2 + kstep;
            if (last && has_next) S.a_ready(nxt);
            if constexpr (SP2) {
            PG8_LDB(B0, 0, 0); PG8_LDB(B1, 0, 1); PG8_SCHED; PG8_LDA(At, 0, 0); PG8_STAGE(PG8_SA(1, 1), a1 + hstepA, voffA);
            PG8_WAIT_V(8); PG8_WAIT_L(0); PG8_BAR; PG8_MMA(0, 0, At, B0); PG8_MMA(0, 1, At, B1); PG8_BAR; PG8_SCHED;
            PG8_LDA(At, 0, 1); PG8_STAGE(PG8_SB(0, 0), b2, voffB); PG8_STAGE(PG8_SB(0, 1), b2 + hstepB, voffB); PG8_STAGE(PG8_SA(0, 0), a2, voffA);
            PG8_WAIT_V(8); PG8_WAIT_L(0); PG8_BAR; PG8_MMA(1, 0, At, B0); PG8_MMA(1, 1, At, B1); PG8_BAR; PG8_SCHED;
            PG8_LDB(B0, 1, 0); PG8_LDB(B1, 1, 1); PG8_SCHED; PG8_LDA(At, 1, 0); PG8_STAGE(PG8_SA(0, 1), a2 + hstepA, voffA);
            PG8_WAIT_V(8); PG8_WAIT_L(0); PG8_BAR; PG8_MMA(0, 0, At, B0); PG8_MMA(0, 1, At, B1); PG8_BAR; PG8_SCHED;
            PG8_LDA(At, 1, 1); PG8_STAGE(PG8_SB(1, 0), b3, voffB); PG8_STAGE(PG8_SB(1, 1), b3 + hstepB, voffB); PG8_STAGE(PG8_SA(1, 0), a3, voffA);
            PG8_WAIT_V(8); PG8_WAIT_L(0); PG8_BAR; PG8_MMA(1, 0, At, B0); PG8_MMA(1, 1, At, B1); PG8_BAR; PG8_SCHED;
            } else {
            PG8_LDB(B0, 0, 0); PG8_SCHED; PG8_LDA(At, 0, 0); PG8_STAGE(PG8_SA(1, 1), a1 + hstepA, voffA);
            PG8_WAIT_L(8); PG8_BAR; PG8_WAIT_L(0); PG8_MMA(0, 0, At, B0); PG8_BAR; PG8_SCHED;
            PG8_LDB(B1, 0, 1); PG8_STAGE(PG8_SB(0, 0), b2, voffB);
            PG8_BAR; PG8_WAIT_L(0); PG8_MMA(0, 1, At, B1); PG8_BAR;
            PG8_LDA(At, 0, 1); PG8_STAGE(PG8_SA(0, 0), a2, voffA);
            PG8_BAR; PG8_WAIT_L(0); PG8_MMA(1, 0, At, B0); PG8_BAR; PG8_SCHED;
            PG8_STAGE(PG8_SB(0, 1), b2 + hstepB, voffB);
            PG8_WAIT_V(6); PG8_BAR; PG8_MMA(1, 1, At, B1); PG8_BAR;
            PG8_LDB(B0, 1, 0); PG8_SCHED; PG8_LDA(At, 1, 0); PG8_STAGE(PG8_SA(0, 1), a2 + hstepA, voffA);
            PG8_WAIT_L(8); PG8_BAR; PG8_WAIT_L(0); PG8_MMA(0, 0, At, B0); PG8_BAR; PG8_SCHED;
            PG8_LDB(B1, 1, 1); PG8_STAGE(PG8_SB(1, 0), b3, voffB);
            PG8_BAR; PG8_WAIT_L(0); PG8_MMA(0, 1, At, B1); PG8_BAR;
            PG8_LDA(At, 1, 1); PG8_STAGE(PG8_SA(1, 0), a3, voffA);
            PG8_BAR; PG8_WAIT_L(0); PG8_MMA(1, 0, At, B0); PG8_BAR; PG8_SCHED;
            PG8_STAGE(PG8_SB(1, 1), b3 + hstepB, voffB);
            PG8_WAIT_V(6); PG8_BAR; PG8_MMA(1, 1, At, B1); PG8_BAR;
            }
        }
        if constexpr (ALIGN_EPI) { if (wr == 0) PG8_BAR; }
        if constexpr (FP8) asm volatile("s_nop 15\n\ts_nop 15" ::: "memory");
        if constexpr (!Epi::AFTER_DRAIN) { E(acc, cur, wr, wc, fr, fq); S.done(cur); }
        if (!has_next) break;
        if (!Epi::SEGMENTED || cur.seg == 2)
#pragma unroll
        for (int a = 0; a < 2; ++a)
#pragma unroll
            for (int b = 0; b < 2; ++b)
#pragma unroll
                for (int m = 0; m < 4; ++m)
#pragma unroll
                    for (int n = 0; n < 2; ++n) acc[a][b][m][n] = (f32x4){0.f, 0.f, 0.f, 0.f};
        cur = nxt; cA = nA; cB = nB; ++ui;
        if constexpr (ALIGN_EPI) { if (wr == 1) PG8_BAR; }
    }
    PG8_WAIT_V(0);
    if constexpr (!ALIGN_EPI) { if (wr == 0) PG8_BAR; }
    PG8_BAR;
    if constexpr (Epi::AFTER_DRAIN) { E.fused(acc, cur, wr, wc, fr, fq, lds, wid, lane); S.done(cur); }
#undef PG8_SA
#undef PG8_SB
#undef PG8_STAGE
#undef PG8_LDA
#undef PG8_LDB
#undef PG8_MMA
#undef PG8_WAIT_V
#undef PG8_WAIT_L
#undef PG8_BAR
#undef PG8_SCHED
}
}

constexpr int NWAVES = 8;
constexpr int M = 16384, D = 2048, FF = 5632, SEQ = 8192, NL = 4;
constexpr int IN_W = 15376, NIN = 15360, PW = 9216;
constexpr int P_AX = 0, P_AG = 1024, P_BQ = 2048, P_BK = 2560, P_BV = 3072, P_BG = 4096, P_CQ = 5120, P_CF = 6144, P_CI = 7168, P_CG = 8192, P_MG = 9216;
#ifndef H_PITCH
#define H_PITCH 2048
#endif
constexpr int HP = H_PITCH;
constexpr float EPS = 1e-6f;
constexpr size_t MiB = 1u << 20;
constexpr size_t WS_CTL = 0, CTL_ZERO_BYTES = 1 * MiB;
constexpr size_t WS_LB = 1 * MiB;
constexpr size_t WS_CA = 2 * MiB, WS_CH = 3 * MiB, WS_HIN = 4 * MiB, WS_LDT = 5 * MiB;
constexpr size_t WS_W = 8 * MiB, WL_STRIDE = 217 * MiB;
constexpr size_t WL_GU1 = 0, WL_D1 = 44 * MiB, WL_IN = 66 * MiB, WL_GT = 127 * MiB, WL_BR = 131 * MiB, WL_OUT = 143 * MiB, WL_GU2 = 151 * MiB, WL_D2 = 195 * MiB;
constexpr size_t WS_MGQ = (1068 + 288) * MiB;
constexpr size_t WS_XH = 940 * MiB, WS_XL = 1004 * MiB;
constexpr size_t WS_H = 876 * MiB, WS_Y = (1068 + 256) * MiB  , WS_P = 1068 * MiB, WS_YA = 1556 * MiB, WS_YB = 1588 * MiB, WS_YC = 1620 * MiB, WS_XC = 1652 * MiB, WS_GT = 1684 * MiB, WS_MG = 1748 * MiB, WS_SLOC = 1812 * MiB, WS_GG = 1844 * MiB, WS_SIN = 1876 * MiB, WS_END = 1908 * MiB;
static_assert(WS_W + 4 * WL_STRIDE <= WS_H && WS_P + (size_t)M * PW * 2 <= WS_YA, "ws map");
constexpr int CW_TMO = 0, CW_CODE = 1, CW_WMAX = 64  , CW_SMAX = CW_WMAX + 16  , CW_BAR = 4096;
constexpr size_t WS_H8 = 1036 * MiB;
constexpr int RING_OFF = 0, RING_BYTES = 131072;
constexpr int LDSCTL_OFF = 149504, MISC_OFF = LDSCTL_OFF + 320;
constexpr int LDS_BYTES = 155648;

#define GAS __attribute__((address_space(1)))
#define LAS __attribute__((address_space(3)))
typedef unsigned short bf16;
typedef unsigned v4u __attribute__((ext_vector_type(4)));
typedef unsigned v2u __attribute__((ext_vector_type(2)));
typedef float f32x4 __attribute__((ext_vector_type(4)));
typedef float f32x2 __attribute__((ext_vector_type(2)));
typedef GAS unsigned gu32;
static_assert(FP8_F2_S0 - 1 >= FP8_S0 && FP8_S0 >= 1 && FP8_S0 <= 2 * NL, "fp8 down GEMM: the half-step before it must be an fp8 gate|up step");
__host__ __device__ constexpr int SL_GU(int s) { return 4 + s - FP8_S0; }
__host__ __device__ constexpr int SL_DN(int s) { return 4 + (2 * NL - FP8_S0) + (s - FP8_F2_S0); }
__host__ __device__ constexpr int SL_ACT(int s) { return 4 + (2 * NL - FP8_S0) + (2 * NL - FP8_F2_S0) + (s - FP8_F2_S0); }
static_assert(SL_ACT(2 * NL) <= 16, "control-word slots");
#define RLX_AGENT __ATOMIC_RELAXED, __HIP_MEMORY_SCOPE_AGENT
#define LDS_WAIT() asm volatile("s_waitcnt lgkmcnt(0)" ::: "memory")
#define VM_WAIT() asm volatile("s_waitcnt vmcnt(0)" ::: "memory")
typedef float f32x2_t __attribute__((ext_vector_type(2))); typedef __bf16 bf16x2_t __attribute__((ext_vector_type(2)));
__device__ __forceinline__ unsigned pk2(float lo, float hi) { f32x2_t v = {lo, hi}; bf16x2_t b = __builtin_convertvector(v, bf16x2_t); return __builtin_bit_cast(unsigned, b); }
__device__ __forceinline__ unsigned f2bf(float f) { return pk2(f, 0.f) & 0xffffu; }
__device__ __forceinline__ float bf2f(unsigned short b) { return __uint_as_float(((unsigned)b) << 16); }
__device__ __forceinline__ float blo(unsigned w) { return __uint_as_float(w << 16); }
__device__ __forceinline__ float bhi(unsigned w) { return __uint_as_float(w & 0xffff0000u); }
__device__ __forceinline__ float fexp(float x) { return __builtin_amdgcn_exp2f(1.44269504089f * x); }
__device__ __forceinline__ float flog(float x) { return 0.69314718056f * __builtin_amdgcn_logf(x); }
__device__ __forceinline__ float frcp(float x) { return __builtin_amdgcn_rcpf(x); }
__device__ __forceinline__ float sigm(float x) { return frcp(1.0f + __builtin_amdgcn_exp2f(-1.44269504089f * x)); }
__device__ __forceinline__ float log_sigm(float x) { return fminf(x, 0.f) - flog(1.0f + fexp(-fabsf(x))); }
__device__ __forceinline__ float gelu_tanh(float x) { const float u = 0.7978845608028654f * (x + 0.044715f * x * x * x); const float t = 1.0f - 2.0f * frcp(fexp(2.0f * u) + 1.0f); return 0.5f * x * (1.0f + t); }
__device__ __forceinline__ float neg_expm1(float x, float ex) { const float ser = -x * (1.0f + x * (0.5f + x * (0.16666667f + x * (0.041666668f + x * 0.0083333338f)))); return x > -0.1f ? ser : 1.0f - ex; }

#define XB_TMO      128
#define XB_XCNT(j)  (256  + 64 * (j))
#define XB_XSUB(j)  (1280 + 64 * (j))
#define XB_XGEN(j)  (2304 + 64 * (j))
#define XB_TOP      3328
#define XB_TOPGEN   3392
#define XCD_BAR_WORDS 3456
#define XB_SPIN_CAP (1u << 18)

__device__ __forceinline__ unsigned xb_ld(unsigned* p)              { return __hip_atomic_load(p, __ATOMIC_RELAXED, __HIP_MEMORY_SCOPE_AGENT); }
__device__ __forceinline__ unsigned xb_add(unsigned* p, unsigned v) { return __hip_atomic_fetch_add(p, v, __ATOMIC_RELAXED, __HIP_MEMORY_SCOPE_AGENT); }
__device__ __forceinline__ unsigned xb_xcc_id() { return (unsigned)__builtin_amdgcn_s_getreg((3 << 11) | 20) & 0xFu; }
#define XB_SPIN(cond, bar) do { unsigned _sp = 0; while (cond) { __builtin_amdgcn_s_sleep(1); \
    if ((++_sp & 255u) == 0u) { if (xb_ld(&(bar)[XB_TMO])) break; if (_sp > XB_SPIN_CAP) { atomicAdd(&(bar)[XB_TMO], 1u); break; } } } } while (0)

struct XcdBarrier {
    unsigned* bar; unsigned x;
    volatile LAS unsigned* st;
};

__device__ __forceinline__ XcdBarrier xcd_barrier_post(unsigned* bar, volatile LAS unsigned* st) {
    XcdBarrier b; b.bar = bar; b.x = xb_xcc_id(); b.st = st;
    if (threadIdx.x == 0) (void)xb_add(&bar[XB_XCNT(b.x)], 1u);
    return b;
}
__device__ __forceinline__ void xcd_barrier_complete(unsigned* bar, unsigned x, unsigned& nloc, unsigned& nx) {
    const unsigned G = gridDim.x * gridDim.y * gridDim.z;
    unsigned sum, cnt, mine, sp = 0u;
    for (;;) {
        sum = 0u; cnt = 0u; mine = 0u;
#pragma unroll
        for (unsigned j = 0; j < 16; ++j) { const unsigned c = xb_ld(&bar[XB_XCNT(j)]); sum += c; cnt += (c > 0u) ? 1u : 0u; mine = (j == x) ? c : mine; }
        if (sum == G) break;
        __builtin_amdgcn_s_sleep(1);
        if ((++sp & 255u) == 0u) { if (xb_ld(&bar[XB_TMO])) break; if (sp > XB_SPIN_CAP) { atomicAdd(&bar[XB_TMO], 1u); break; } }
    }
    nloc = mine > 0u ? mine : 1u; nx = cnt > 0u ? cnt : 1u;
}

__device__ __forceinline__ void xcd_barrier(const XcdBarrier& b) {
    asm volatile("s_waitcnt vmcnt(0)" ::: "memory");
    __syncthreads();
    if (threadIdx.x == 0) {
        unsigned* bar = b.bar;
        __builtin_amdgcn_s_waitcnt(0);
        unsigned nloc = b.st[0], nx = b.st[1];
        if (nloc == 0u) { xcd_barrier_complete(bar, b.x, nloc, nx); b.st[0] = nloc; b.st[1] = nx; }
        const unsigned old = xb_add(&bar[XB_XSUB(b.x)], 1u);
        const unsigned gen = old / nloc;
        if (old + 1u == (gen + 1u) * nloc) {
            __builtin_amdgcn_fence(__ATOMIC_RELEASE, "agent");
            asm volatile("s_waitcnt vmcnt(0)" ::: "memory");
            const unsigned og = xb_add(&bar[XB_TOP], 1u);
            const unsigned tg = og / nx;
            if (og + 1u == (tg + 1u) * nx) xb_add(&bar[XB_TOPGEN], 1u);
            else XB_SPIN(xb_ld(&bar[XB_TOPGEN]) == tg, bar);
            __builtin_amdgcn_fence(__ATOMIC_ACQUIRE, "agent");
            xb_add(&bar[XB_XGEN(b.x)], 1u);
            asm volatile("s_waitcnt vmcnt(0)" ::: "memory");
        } else {
            XB_SPIN(xb_ld(&bar[XB_XGEN(b.x)]) == gen, bar);
            __builtin_amdgcn_fence(__ATOMIC_ACQUIRE, "agent");
            asm volatile("s_waitcnt vmcnt(0)" ::: "memory");
        }
    }
    __syncthreads();
}

struct Args { const float* in[30]; float* out; unsigned char* ws; int ph_lo, ph_hi; };
struct Frame {
    LAS unsigned char* lds;
    volatile LAS unsigned* MISC;
    gu32* ctl;
    int tid, lane, wave, vcu, G, bx;
};
__device__ __forceinline__ float wave_sum(float v) {
#pragma unroll
    for (int o = 1; o < 64; o <<= 1) v += __shfl_xor(v, o);
    return v;
}
__device__ __forceinline__ unsigned pk4_fp8(float a, float b, float c, float d) { int w = 0; w = __builtin_amdgcn_cvt_pk_fp8_f32(a, b, w, false); w = __builtin_amdgcn_cvt_pk_fp8_f32(c, d, w, true); return (unsigned)w; }
__device__ __forceinline__ float pow2_floor(float t) { return __uint_as_float(__float_as_uint(t) & 0x7F800000u); }
__device__ __forceinline__ float fp8_scale(float amax) { return pow2_floor(fminf(440.0f / fmaxf(amax, 1e-30f), 1.0e12f)); }
#ifndef FP8_HEAD
#define FP8_HEAD 8.0f
#endif
__device__ __forceinline__ bool wscale_ok(const unsigned char* ws, int slot) { const gu32* c = (const gu32*)(ws + WS_CTL);
    return __uint_as_float(c[CW_WMAX + slot]) * fp8_scale(FP8_HEAD * __uint_as_float(c[CW_SMAX + slot])) <= 448.0f; }
__device__ __forceinline__ float wscale(const unsigned char* ws, int slot) { const gu32* c = (const gu32*)(ws + WS_CTL);
    const float amax = __uint_as_float(c[CW_WMAX + slot]), s0 = fp8_scale(FP8_HEAD * __uint_as_float(c[CW_SMAX + slot])); return amax * s0 <= 448.0f ? s0 : fp8_scale(amax); }
__device__ __forceinline__ float h8_scale(const float* g, int ln) {
    float gm = 0.f;
#pragma unroll
    for (int j = 0; j < 4; ++j) { const f32x4 a = ((const GAS f32x4*)g)[2 * (64 * j + ln)], b = ((const GAS f32x4*)g)[2 * (64 * j + ln) + 1];
        gm = fmaxf(gm, fmaxf(fmaxf(fmaxf(fabsf(a.x), fabsf(a.y)), fmaxf(fabsf(a.z), fabsf(a.w))), fmaxf(fmaxf(fabsf(b.x), fabsf(b.y)), fmaxf(fabsf(b.z), fabsf(b.w))))); }
#pragma unroll
    for (int o = 1; o < 64; o <<= 1) gm = fmaxf(gm, __shfl_xor(gm, o));
    return fp8_scale(45.2548339959f * gm);
}
template <int MAP> __device__ __forceinline__ int dest_row(int n) {
    if (MAP == 1) return 256 * (n >> 7) + (n & 127);
    if (MAP == 2) return 256 * (n >> 7) + 128 + (n & 127);
    if (MAP == 3) return n < 5120 ? n : (n < 5136 ? 15360 + (n - 5120) : n - 16);
    if (MAP == 5) return n < 5120 ? n : (n < 5136 ? 15360 + (n - 5120) : n - 16);
    if (MAP == 4) return n - 9232;
    return n;
}
template <int MAP> __device__ __forceinline__ void p0_item(const float* W, int K, int N, bf16* WT, LAS float* scr, int item, int lane) {
    const int nblk = (N + 31) / 32, kb = item / nblk, nb = item % nblk, k0 = 64 * kb, n0 = 32 * nb;
    const int nn = n0 + (lane & 31); const bool okr = nn < N;
#pragma unroll
    for (int i = 0; i < 32; ++i) { const int kk = 2 * i + (lane >> 5); scr[kk * 33 + (lane & 31)] = okr ? W[(size_t)(k0 + kk) * N + nn] : 0.f; }
    LDS_WAIT(); asm volatile("" ::: "memory");
    const int c = lane & 7;
#pragma unroll
    for (int j = 0; j < 4; ++j) { const int n = (lane >> 3) + 8 * j; const LAS float* s = scr + (8 * c) * 33 + n;
        v4u o; o.x = pk2(s[0 * 33], s[1 * 33]); o.y = pk2(s[2 * 33], s[3 * 33]); o.z = pk2(s[4 * 33], s[5 * 33]); o.w = pk2(s[6 * 33], s[7 * 33]);
        if (n0 + n < N && !(MAP == 3 && n0 + n >= 9232)) __builtin_nontemporal_store(o, (GAS v4u*)(WT + (size_t)dest_row<MAP>(n0 + n) * K + k0 + 8 * c)); }
    LDS_WAIT(); asm volatile("" ::: "memory");
}
__device__ __forceinline__ float p0_absmax_item(const float* W, int K, int N, int item, int lane, int nmin) {
    (void)K; const int nblk = (N + 31) / 32, kb = item / nblk, nb = item % nblk, k0 = 64 * kb, n0 = 32 * nb;
    const int nn = n0 + (lane & 31); const bool okr = nn < N && nn >= nmin;
    float m = 0.f;
#pragma unroll
    for (int i = 0; i < 32; ++i) { const int kk = 2 * i + (lane >> 5); m = fmaxf(m, fabsf(okr ? W[(size_t)(k0 + kk) * N + nn] : 0.f)); }
    return m;
}
template <int MAP> __device__ __forceinline__ float p0_item8(const float* W, int K, int N, unsigned char* W8, LAS float* scr, int item, int lane, float sW) {
    const int nblk = (N + 31) / 32, kb = item / nblk, nb = item % nblk, k0 = 64 * kb, n0 = 32 * nb;
    const int nn = n0 + (lane & 31); const bool okr = nn < N;
    float mx = 0.f; const bool cnt = !(MAP == 4 && nn < 9232);
#pragma unroll
    for (int i = 0; i < 32; ++i) { const int kk = 2 * i + (lane >> 5); const float v = okr ? W[(size_t)(k0 + kk) * N + nn] : 0.f; scr[kk * 33 + (lane & 31)] = v; mx = fmaxf(mx, cnt ? fabsf(v) : 0.f); }
    LDS_WAIT(); asm volatile("" ::: "memory");
    const int c = lane & 7;
#pragma unroll
    for (int j = 0; j < 4; ++j) { const int n = (lane >> 3) + 8 * j; const LAS float* s = scr + (8 * c) * 33 + n;
        v2u o; o.x = pk4_fp8(s[0 * 33] * sW, s[1 * 33] * sW, s[2 * 33] * sW, s[3 * 33] * sW); o.y = pk4_fp8(s[4 * 33] * sW, s[5 * 33] * sW, s[6 * 33] * sW, s[7 * 33] * sW);
        if (n0 + n < N && !(MAP == 4 && n0 + n < 9232)) __builtin_nontemporal_store(o, (GAS v2u*)(W8 + (size_t)dest_row<MAP>(n0 + n) * K + k0 + 8 * c)); }
    LDS_WAIT(); asm volatile("" ::: "memory");
    return mx;
}
constexpr int NBLK_IN = (IN_W + 31) / 32, MG_N0 = IN_W - 6144  , MG_NB0 = MG_N0 / 32, I_MG = (D / 64) * (NBLK_IN - MG_NB0);
constexpr size_t WL_IN8 = 40 * MiB;
constexpr int I_GATE = (D / 64) * (FF / 32), I_DOWN = (FF / 64) * (D / 32), I_IN = (D / 64) * ((IN_W + 31) / 32), I_BR = (1024 / 64) * (D / 32), I_OUT = (D / 64) * (D / 32);
constexpr int I_LAYER = 2 * (2 * I_GATE + I_DOWN) + I_IN + 3 * I_BR + I_OUT;

__device__ __forceinline__ void x_pack8(const f32x4 va, const f32x4 vb, v4u& hi, v2u& lo) {
    unsigned r[8];
#pragma unroll
    for (int k = 0; k < 4; ++k) { const float fa = va[k], fb = vb[k]; const unsigned ua = __float_as_uint(fa), ub = __float_as_uint(fb);
        r[k] = (ua + 0x7Fu + ((ua >> 8) & 1u)) >> 8; r[4 + k] = (ub + 0x7Fu + ((ub >> 8) & 1u)) >> 8; }
    hi.x = (r[0] >> 8) | ((r[1] >> 8) << 16); hi.y = (r[2] >> 8) | ((r[3] >> 8) << 16); hi.z = (r[4] >> 8) | ((r[5] >> 8) << 16); hi.w = (r[6] >> 8) | ((r[7] >> 8) << 16);
    lo.x = (r[0] & 0xFFu) | ((r[1] & 0xFFu) << 8) | ((r[2] & 0xFFu) << 16) | (r[3] << 24); lo.y = (r[4] & 0xFFu) | ((r[5] & 0xFFu) << 8) | ((r[6] & 0xFFu) << 16) | (r[7] << 24);
}
__device__ __forceinline__ f32x4 x_unpack4(const unsigned h0, const unsigned h1, const unsigned lo) {
    f32x4 v; v.x = __uint_as_float((h0 << 16) | ((lo & 0xFFu) << 8)); v.y = __uint_as_float((h0 & 0xFFFF0000u) | (lo & 0xFF00u));
    v.z = __uint_as_float((h1 << 16) | ((lo >> 8) & 0xFF00u)); v.w = __uint_as_float((h1 & 0xFFFF0000u) | ((lo >> 16) & 0xFF00u)); return v;
}
__device__ __forceinline__ f32x4 bf4(const unsigned a, const unsigned b) { return (f32x4){blo(a), bhi(a), blo(b), bhi(b)}; }
__device__ __forceinline__ void rowpass(const Frame& F, const float* xin32, const unsigned short* xih, const unsigned char* xil, const bf16* Y, float* xo32, unsigned short* xoh, unsigned char* xol,
                                        const float* gpost, float scale, const float* gpre, bf16* H, unsigned char* H8 = nullptr) {
    const int gw = F.vcu * NWAVES + F.wave, NGW = F.G * NWAVES, ln = F.lane;
    const float s8 = H8 ? h8_scale(gpre, ln) : 0.f;
    f32x4 gq[8];
#pragma unroll
    for (int j = 0; j < 4; ++j) { gq[2 * j] = Y ? ((const GAS f32x4*)gpost)[2 * (64 * j + ln)] : (f32x4){0.f, 0.f, 0.f, 0.f}; gq[2 * j + 1] = Y ? ((const GAS f32x4*)gpost)[2 * (64 * j + ln) + 1] : (f32x4){0.f, 0.f, 0.f, 0.f}; }
    for (int m = gw; m < M; m += 2 * NGW) {
        const int m1 = m + NGW;
        f32x4 x0[8], x1[8];
        if (xin32) { const GAS f32x4* xr0 = (const GAS f32x4*)(xin32 + (size_t)m * D) + 2 * ln; const GAS f32x4* xr1 = (const GAS f32x4*)(xin32 + (size_t)m1 * D) + 2 * ln;
#pragma unroll
            for (int j = 0; j < 4; ++j) { x0[2 * j] = xr0[128 * j]; x0[2 * j + 1] = xr0[128 * j + 1]; x1[2 * j] = xr1[128 * j]; x1[2 * j + 1] = xr1[128 * j + 1]; } }
        else { const GAS v4u* h0 = (const GAS v4u*)(xih + (size_t)m * D) + ln; const GAS v4u* h1 = (const GAS v4u*)(xih + (size_t)m1 * D) + ln;
            const GAS v2u* l0 = (const GAS v2u*)(xil + (size_t)m * D) + ln; const GAS v2u* l1 = (const GAS v2u*)(xil + (size_t)m1 * D) + ln;
            v4u a0[4], a1[4]; v2u b0[4], b1[4];
#pragma unroll
            for (int j = 0; j < 4; ++j) { a0[j] = __builtin_nontemporal_load(h0 + 64 * j); a1[j] = __builtin_nontemporal_load(h1 + 64 * j); b0[j] = __builtin_nontemporal_load(l0 + 64 * j); b1[j] = __builtin_nontemporal_load(l1 + 64 * j); }
#pragma unroll
            for (int j = 0; j < 4; ++j) { x0[2 * j] = x_unpack4(a0[j].x, a0[j].y, b0[j].x); x0[2 * j + 1] = x_unpack4(a0[j].z, a0[j].w, b0[j].y); x1[2 * j] = x_unpack4(a1[j].x, a1[j].y, b1[j].x); x1[2 * j + 1] = x_unpack4(a1[j].z, a1[j].w, b1[j].y); } }
        if (Y) {
            const GAS v4u* yr0 = (const GAS v4u*)(Y + (size_t)m * D) + ln; const GAS v4u* yr1 = (const GAS v4u*)(Y + (size_t)m1 * D) + ln;
            v4u y0[4], y1[4]; float s0 = 0.f, s1 = 0.f;
#pragma unroll
            for (int j = 0; j < 4; ++j) { y0[j] = __builtin_nontemporal_load(yr0 + 64 * j); y1[j] = __builtin_nontemporal_load(yr1 + 64 * j); }
#pragma unroll
            for (int j = 0; j < 4; ++j) { const f32x4 a = bf4(y0[j].x, y0[j].y), b = bf4(y0[j].z, y0[j].w), c = bf4(y1[j].x, y1[j].y), d = bf4(y1[j].z, y1[j].w);
                s0 += ((a.x * a.x + a.y * a.y) + (a.z * a.z + a.w * a.w)) + ((b.x * b.x + b.y * b.y) + (b.z * b.z + b.w * b.w));
                s1 += ((c.x * c.x + c.y * c.y) + (c.z * c.z + c.w * c.w)) + ((d.x * d.x + d.y * d.y) + (d.z * d.z + d.w * d.w)); }
#pragma unroll
            for (int o = 1; o < 64; o <<= 1) { s0 += __shfl_xor(s0, o); s1 += __shfl_xor(s1, o); }
            const float r0 = scale * rsqrtf(s0 * (1.f / D) + EPS), r1 = scale * rsqrtf(s1 * (1.f / D) + EPS);
#pragma unroll
            for (int j = 0; j < 4; ++j) { x0[2 * j] = x0[2 * j] + bf4(y0[j].x, y0[j].y) * gq[2 * j] * r0; x0[2 * j + 1] = x0[2 * j + 1] + bf4(y0[j].z, y0[j].w) * gq[2 * j + 1] * r0;
                x1[2 * j] = x1[2 * j] + bf4(y1[j].x, y1[j].y) * gq[2 * j] * r1; x1[2 * j + 1] = x1[2 * j + 1] + bf4(y1[j].z, y1[j].w) * gq[2 * j + 1] * r1; }
            if (xo32) { GAS f32x4* xo0 = (GAS f32x4*)(xo32 + (size_t)m * D) + 2 * ln; GAS f32x4* xo1 = (GAS f32x4*)(xo32 + (size_t)m1 * D) + 2 * ln;
#pragma unroll
                for (int j = 0; j < 4; ++j) { xo0[128 * j] = x0[2 * j]; xo0[128 * j + 1] = x0[2 * j + 1]; xo1[128 * j] = x1[2 * j]; xo1[128 * j + 1] = x1[2 * j + 1]; } }
            else { GAS v4u* h0 = (GAS v4u*)(xoh + (size_t)m * D) + ln; GAS v4u* h1 = (GAS v4u*)(xoh + (size_t)m1 * D) + ln;
                GAS v2u* l0 = (GAS v2u*)(xol + (size_t)m * D) + ln; GAS v2u* l1 = (GAS v2u*)(xol + (size_t)m1 * D) + ln;
#pragma unroll
                for (int j = 0; j < 4; ++j) { v4u a; v2u b; x_pack8(x0[2 * j], x0[2 * j + 1], a, b); __builtin_nontemporal_store(a, h0 + 64 * j); __builtin_nontemporal_store(b, l0 + 64 * j); x_pack8(x1[2 * j], x1[2 * j + 1], a, b); __builtin_nontemporal_store(a, h1 + 64 * j); __builtin_nontemporal_store(b, l1 + 64 * j); } }
        }
        if (H || H8) {
            float s0 = 0.f, s1 = 0.f;
#pragma unroll
            for (int j = 0; j < 8; ++j) { s0 += (x0[j].x * x0[j].x + x0[j].y * x0[j].y) + (x0[j].z * x0[j].z + x0[j].w * x0[j].w); s1 += (x1[j].x * x1[j].x + x1[j].y * x1[j].y) + (x1[j].z * x1[j].z + x1[j].w * x1[j].w); }
#pragma unroll
            for (int o = 1; o < 64; o <<= 1) { s0 += __shfl_xor(s0, o); s1 += __shfl_xor(s1, o); }
            const float r0 = rsqrtf(s0 * (1.f / D) + EPS), r1 = rsqrtf(s1 * (1.f / D) + EPS);
            GAS v4u* ho0 = (GAS v4u*)(H + (size_t)m * HP) + ln; GAS v4u* ho1 = (GAS v4u*)(H + (size_t)m1 * HP) + ln;
#pragma unroll
            for (int j = 0; j < 4; ++j) { const f32x4 ga = ((const GAS f32x4*)gpre)[2 * (64 * j + ln)], gb = ((const GAS f32x4*)gpre)[2 * (64 * j + ln) + 1];
                const f32x4 a = x0[2 * j] * ga * r0, b = x0[2 * j + 1] * gb * r0, c = x1[2 * j] * ga * r1, d = x1[2 * j + 1] * gb * r1;
                if (H) { ho0[64 * j] = (v4u){pk2(a.x, a.y), pk2(a.z, a.w), pk2(b.x, b.y), pk2(b.z, b.w)}; ho1[64 * j] = (v4u){pk2(c.x, c.y), pk2(c.z, c.w), pk2(d.x, d.y), pk2(d.z, d.w)}; }
                if (H8) { const f32x4 a8 = a * s8, b8 = b * s8, c8 = c * s8, d8 = d * s8;
                    ((GAS v2u*)(H8 + (size_t)m * D) + ln)[64 * j] = (v2u){pk4_fp8(a8.x, a8.y, a8.z, a8.w), pk4_fp8(b8.x, b8.y, b8.z, b8.w)}; ((GAS v2u*)(H8 + (size_t)m1 * D) + ln)[64 * j] = (v2u){pk4_fp8(c8.x, c8.y, c8.z, c8.w), pk4_fp8(d8.x, d8.y, d8.z, d8.w)}; } }
        }
    }
}

__device__ __forceinline__ void conv_item(const bf16* P, const float* cw, const float* cb, bf16* XC, int c8, int m0) {
    const int t0 = m0 & (SEQ - 1);
    float w[4][8], bb[8];
#pragma unroll
    for (int k = 0; k < 4; ++k) { const f32x4 a = *(const GAS f32x4*)(cw + k * 1024 + c8), b = *(const GAS f32x4*)(cw + k * 1024 + c8 + 4); w[k][0] = a.x; w[k][1] = a.y; w[k][2] = a.z; w[k][3] = a.w; w[k][4] = b.x; w[k][5] = b.y; w[k][6] = b.z; w[k][7] = b.w; }
    { const f32x4 a = *(const GAS f32x4*)(cb + c8), b = *(const GAS f32x4*)(cb + c8 + 4); bb[0] = a.x; bb[1] = a.y; bb[2] = a.z; bb[3] = a.w; bb[4] = b.x; bb[5] = b.y; bb[6] = b.z; bb[7] = b.w; }
    v4u r[19];
#pragma unroll
    for (int i = 0; i < 19; ++i) r[i] = (t0 + i - 3 >= 0) ? *(const GAS v4u*)(P + (size_t)(m0 + i - 3) * PW + P_AX + c8) : (v4u){0u, 0u, 0u, 0u};
#pragma unroll
    for (int t = 0; t < 16; ++t) { float acc[8];
#pragma unroll
        for (int e = 0; e < 8; ++e) acc[e] = bb[e];
#pragma unroll
        for (int k = 0; k < 4; ++k) { const v4u q = r[t + k];
            acc[0] += w[k][0] * blo(q.x); acc[1] += w[k][1] * bhi(q.x); acc[2] += w[k][2] * blo(q.y); acc[3] += w[k][3] * bhi(q.y); acc[4] += w[k][4] * blo(q.z); acc[5] += w[k][5] * bhi(q.z); acc[6] += w[k][6] * blo(q.w); acc[7] += w[k][7] * bhi(q.w); }
        *(GAS v4u*)(XC + (size_t)(m0 + t) * 1024 + c8) = (v4u){pk2(acc[0], acc[1]), pk2(acc[2], acc[3]), pk2(acc[4], acc[5]), pk2(acc[6], acc[7])}; }
}

constexpr int LRU_LDS = 0;
template <bool FINAL> __device__ __forceinline__ void lru_chunk_phase(const Frame& F, const unsigned char* GT, const bf16* XC, const bf16* P, const float* ba, const float* bx, const float* lam,
                                                                    float* CA, float* CH, const float* HIN, bf16* YA, int u0, int u1) {
    LAS float* XA = (LAS float*)(F.lds + LRU_LDS); LAS float* XH = XA + 2048;
    const int c4l = F.lane, part = F.wave;
    {
#pragma unroll 1
        for (int uu = u0; uu < u1; ++uu) { const int c = uu >> 2, r = uu & 3;
            const int ch = 256 * r + 4 * c4l, gc = 256 * (ch >> 7) + (ch & 127); const size_t m0 = (size_t)c * 64 + 8 * part;
            const f32x4 lm = *(const GAS f32x4*)(lam + ch);
            float sp8[4];
#pragma unroll
            for (int e = 0; e < 4; ++e) sp8[e] = (-8.0f / 255.0f) * (flog(1.0f + fexp(-fabsf(lm[e]))) + fmaxf(-lm[e], 0.f));
            float av[8][4], uv[8][4]; float A[4] = {1.f, 1.f, 1.f, 1.f}, Hs[4] = {0.f, 0.f, 0.f, 0.f};
            v2u gwv[8];
#pragma unroll
            for (int t = 0; t < 8; ++t) {
                const unsigned rw = *(const GAS unsigned*)(GT + (m0 + t) * 2048 + gc), iw = *(const GAS unsigned*)(GT + (m0 + t) * 2048 + 128 + gc); const v2u xw = *(const GAS v2u*)(XC + (m0 + t) * 1024 + ch);
                gwv[t] = FINAL ? *(const GAS v2u*)(P + (m0 + t) * PW + P_AG + ch) : (v2u){0u, 0u};
                const float rp[4] = {(float)(rw & 0xFFu), (float)((rw >> 8) & 0xFFu), (float)((rw >> 16) & 0xFFu), (float)(rw >> 24)}, ip[4] = {(float)(iw & 0xFFu), (float)((iw >> 8) & 0xFFu), (float)((iw >> 16) & 0xFFu), (float)(iw >> 24)}, xc[4] = {blo(xw.x), bhi(xw.x), blo(xw.y), bhi(xw.y)};
#pragma unroll
                for (int e = 0; e < 4; ++e) { const float la = rp[e] * sp8[e], a = fexp(la);
                    const float u = __builtin_amdgcn_sqrtf(fmaxf(neg_expm1(2.0f * la, a * a), 0.f)) * (ip[e] * xc[e] * (1.0f / 255.0f));
                    av[t][e] = a; uv[t][e] = u; A[e] *= a; Hs[e] = a * Hs[e] + u; }
            }
            *(LAS f32x4*)(XA + part * 256 + 4 * c4l) = (f32x4){A[0], A[1], A[2], A[3]}; *(LAS f32x4*)(XH + part * 256 + 4 * c4l) = (f32x4){Hs[0], Hs[1], Hs[2], Hs[3]};
            __syncthreads();
            if (!FINAL) {
                if (part == 0) { f32x4 At = (f32x4){1.f, 1.f, 1.f, 1.f}, Ht = (f32x4){0.f, 0.f, 0.f, 0.f};
#pragma unroll
                    for (int qq = 0; qq < 8; ++qq) { const f32x4 a = *(const LAS f32x4*)(XA + qq * 256 + 4 * c4l), hh = *(const LAS f32x4*)(XH + qq * 256 + 4 * c4l); Ht = a * Ht + hh; At = At * a; }
                    *(GAS f32x4*)(CA + (size_t)c * 1024 + ch) = At; *(GAS f32x4*)(CH + (size_t)c * 1024 + ch) = Ht; }
            } else {
                f32x4 h = *(const GAS f32x4*)(HIN + (size_t)c * 1024 + ch);
#pragma unroll
                for (int qq = 0; qq < 7; ++qq) if (qq < part) { const f32x4 a = *(const LAS f32x4*)(XA + qq * 256 + 4 * c4l), hh = *(const LAS f32x4*)(XH + qq * 256 + 4 * c4l); h = a * h + hh; }
#pragma unroll
                for (int t = 0; t < 8; ++t) { const v2u gw = gwv[t]; const float g[4] = {blo(gw.x), bhi(gw.x), blo(gw.y), bhi(gw.y)}; float y[4];
#pragma unroll
                    for (int e = 0; e < 4; ++e) { h[e] = av[t][e] * h[e] + uv[t][e]; y[e] = gelu_tanh(g[e]) * h[e]; }
                    *(GAS v2u*)(YA + (m0 + t) * 1024 + ch) = (v2u){pk2(y[0], y[1]), pk2(y[2], y[3])}; }
            }
            __syncthreads();
        }
    }
}
__device__ __forceinline__ void lru_carry_phase(const Frame& F, const float* CA, const float* CH, float* HIN) {
    if (F.bx < 32) {
        LAS float* XA = (LAS float*)(F.lds + LRU_LDS); LAS float* XH = XA + 512;
        const int b = F.bx >> 4, ch = (F.bx & 15) * 64 + F.lane, part = F.wave;
        float a[16], hh[16]; float At = 1.f, Ht = 0.f;
#pragma unroll
        for (int k = 0; k < 16; ++k) { const size_t i = (size_t)(b * 128 + part * 16 + k) * 1024 + ch; a[k] = CA[i]; hh[k] = CH[i]; }
#pragma unroll
        for (int k = 0; k < 16; ++k) { Ht = a[k] * Ht + hh[k]; At *= a[k]; }
        XA[part * 64 + F.lane] = At; XH[part * 64 + F.lane] = Ht;
        __syncthreads();
        float h = 0.f;
#pragma unroll
        for (int pp = 0; pp < 7; ++pp) if (pp < part) h = XA[pp * 64 + F.lane] * h + XH[pp * 64 + F.lane];
#pragma unroll
        for (int k = 0; k < 16; ++k) { const size_t i = (size_t)(b * 128 + part * 16 + k) * 1024 + ch; HIN[i] = h; h = a[k] * h + hh[k]; }
        __syncthreads();
    }
}

typedef short bf16x8 __attribute__((ext_vector_type(8)));
__device__ __forceinline__ void lrgg_phase(const Frame& F, const bf16* H, const bf16* WlrT, const float* w2, const float* b2, float* GG) {
    LAS float* PART = (LAS float*)(F.lds); LAS float* LR = (LAS float*)(F.lds + 32768);
    const int w = F.wave, lane = F.lane, l15 = lane & 15, g4 = lane >> 4;
    for (int tb = F.vcu; tb < M / 64; tb += F.G) {
        bf16x8 bw[8];
#pragma unroll
        for (int ks = 0; ks < 8; ++ks) bw[ks] = *(const GAS bf16x8*)(WlrT + (size_t)l15 * 2048 + 256 * w + 32 * ks + 8 * g4);
#pragma unroll
        for (int mt = 0; mt < 4; ++mt) { f32x4 acc = (f32x4){0.f, 0.f, 0.f, 0.f}; const bf16* hr = H + (size_t)(64 * tb + 16 * mt + l15) * HP + 256 * w + 8 * g4;
            bf16x8 af[8];
#pragma unroll
            for (int ks = 0; ks < 8; ++ks) af[ks] = *(const GAS bf16x8*)(hr + 32 * ks);
#pragma unroll
            for (int ks = 0; ks < 8; ++ks) acc = __builtin_amdgcn_mfma_f32_16x16x32_bf16(af[ks], bw[ks], acc, 0, 0, 0);
            *(LAS f32x4*)(PART + ((w * 4 + mt) * 64 + lane) * 4) = acc; }
        __syncthreads();
#pragma unroll
        for (int o = F.tid; o < 1024; o += 512) { const int t = o >> 4, n = o & 15, mt = t >> 4, tl = t & 15, ln = n + 16 * (tl >> 2), r = tl & 3; float sum = 0.f;
#pragma unroll
            for (int ww = 0; ww < 8; ++ww) sum += PART[((ww * 4 + mt) * 64 + ln) * 4 + r];
            LR[t * 16 + n] = sum; }
        __syncthreads();
        { const int d = F.tid; float wc[16];
#pragma unroll
          for (int r = 0; r < 16; ++r) wc[r] = w2[r * 512 + d];
          const float bb = b2[d];
#pragma unroll 4
          for (int t = 0; t < 64; ++t) { const f32x4 a0 = *(const LAS f32x4*)(LR + t * 16), a1 = *(const LAS f32x4*)(LR + t * 16 + 4), a2 = *(const LAS f32x4*)(LR + t * 16 + 8), a3 = *(const LAS f32x4*)(LR + t * 16 + 12);
              float x = bb + a0.x * wc[0] + a0.y * wc[1] + a0.z * wc[2] + a0.w * wc[3] + a1.x * wc[4] + a1.y * wc[5] + a1.z * wc[6] + a1.w * wc[7] + a2.x * wc[8] + a2.y * wc[9] + a2.z * wc[10] + a2.w * wc[11] + a3.x * wc[12] + a3.y * wc[13] + a3.z * wc[14] + a3.w * wc[15];
              GG[(size_t)(64 * tb + t) * 512 + d] = log_sigm(x) * 0.0625f; } }
        __syncthreads();
    }
}

constexpr int LA_QT = 0, LA_QP = 17408, LA_KP = 34816, LA_KHT = 78336, LA_VT = 96768, LA_PS = 133632, LA_DEC = 142848, LA_T8 = 143360, LA_NRM = 147456, LA_END = 149504;
constexpr int QS = 272, TS = 144, OBS = 528;
constexpr size_t SLOC_HGRN_OFF = (size_t)128 * 128 * 256;
__device__ __forceinline__ bf16x8 mk8(v2u lo, v2u hi) { v4u t; t.x = lo.x; t.y = lo.y; t.z = hi.x; t.w = hi.y; return __builtin_bit_cast(bf16x8, t); }
template <int TYPE, bool FULL>
__device__ __forceinline__ void la_segment(const Frame& F, int item, const bf16* P, const float* GG, const float* LBl, const float* gn, float* SLOC, float* LDT, const float* SIN, bf16* Y) {
    constexpr int DV = TYPE == 0 ? 256 : 128, NVT = DV / 128, NSEG = TYPE == 0 ? 16 : 8, NCH = 128 / NSEG;
    const int lane = F.lane, w = F.wave, g4 = lane >> 4, l15 = lane & 15, p = lane;
    int bh, seg, b, h;
    if (TYPE == 0) { bh = item >> 4; seg = item & 15; b = bh >> 2; h = bh & 3; } else { bh = item >> 3; seg = item & 7; b = bh >> 3; h = bh & 7; }
    const int qoff = (TYPE == 0 ? P_BQ : P_CQ) + h * 128, koff = (TYPE == 0 ? P_BK : P_CF) + h * 128, voff = TYPE == 0 ? P_BV + h * 256 : P_CI + h * 128, goff = TYPE == 0 ? P_BG + h * 256 : P_CG + h * 128;
    LAS unsigned char* L = F.lds;
    float* slb = SLOC + (TYPE == 0 ? (size_t)0 : SLOC_HGRN_OFF); float* ldb = LDT + (TYPE == 0 ? 0 : 128 * 128);
    f32x4 S[NVT][8];
#pragma unroll
    for (int vt = 0; vt < NVT; ++vt)
#pragma unroll
        for (int dt = 0; dt < 8; ++dt) S[vt][dt] = (f32x4){0.f, 0.f, 0.f, 0.f};
    float ldsa = 0.f, ldsb = 0.f;
    if (FULL) {
        for (int i = F.tid; i < (64 * TS) / 4; i += 512) ((LAS unsigned*)(L + LA_PS))[i] = 0u;
        if (seg > 0) { const float* si = SIN + (TYPE == 0 ? (size_t)0 : SLOC_HGRN_OFF) + (size_t)item * (128 * DV);
#pragma unroll
            for (int vt = 0; vt < NVT; ++vt)
#pragma unroll
                for (int dt = 0; dt < 8; ++dt) S[vt][dt] = *(const GAS f32x4*)(si + ((size_t)(((w * NVT + vt) * 8 + dt) * 64 + lane)) * 4); }
        __syncthreads();
    }
    unsigned qr[8], kr[8]; f32x2 gr[8]; v2u vr[8];
#define LA_BAR() do { asm volatile("s_waitcnt lgkmcnt(0)" ::: "memory"); __builtin_amdgcn_s_barrier(); asm volatile("" ::: "memory"); } while (0)
#define LA_LOAD_RAW(chn) do { const bf16* Pr = P + (size_t)(b * SEQ + (seg * NCH + (chn)) * 64 + 8 * w) * PW; const float* Gr = GG + (size_t)(b * SEQ + (seg * NCH + (chn)) * 64 + 8 * w) * 512 + h * 128 + 2 * p; \
        _Pragma("unroll") for (int j = 0; j < 8; ++j) { const bf16* Pj = Pr + (size_t)j * PW; \
            qr[j] = FULL ? *(const GAS unsigned*)(Pj + qoff + 2 * p) : 0u; kr[j] = *(const GAS unsigned*)(Pj + koff + 2 * p); \
            if (TYPE == 0) gr[j] = *(const GAS f32x2*)(Gr + (size_t)j * 512); else gr[j] = (f32x2){0.f, 0.f}; \
            if (DV == 256) vr[j] = *(const GAS v2u*)(Pj + voff + 4 * p); else { vr[j].x = *(const GAS unsigned*)(Pj + voff + 2 * p); vr[j].y = 0u; } } } while (0)
    LA_LOAD_RAW(0);
    f32x4 gnv[NVT];
#pragma unroll
    for (int vt = 0; vt < NVT; ++vt) gnv[vt] = FULL ? *(const GAS f32x4*)(gn + (w * NVT + vt) * 16 + 4 * g4) : (f32x4){0.f, 0.f, 0.f, 0.f};
#pragma unroll 1
    for (int ch = 0; ch < NCH; ++ch) {
        const int m0 = b * SEQ + (seg * NCH + ch) * 64, sb = w, t0 = 8 * sb, I = sb >> 1;
        float ca[8], cb[8], ka[8], kb[8], qa[8], qb[8]; float ra = 0.f, rb = 0.f;
#pragma unroll
        for (int j = 0; j < 8; ++j) { float ga, gb;
            if (TYPE == 0) { ga = gr[j].x; gb = gr[j].y; ka[j] = blo(kr[j]); kb[j] = bhi(kr[j]); qa[j] = blo(qr[j]); qb[j] = bhi(qr[j]); }
            else { ga = blo(kr[j]); gb = bhi(kr[j]); ka[j] = 1.f - fexp(ga); kb[j] = 1.f - fexp(gb); qa[j] = blo(qr[j]); qb[j] = bhi(qr[j]); }
            ra += ga; rb += gb; ca[j] = ra; cb[j] = rb; }
        *(LAS f32x2*)(L + LA_T8 + (sb * 128 + 2 * p) * 4) = (f32x2){ra, rb};
        LA_BAR();
        float brefa[5], brefb[5]; brefa[0] = 0.f; brefb[0] = 0.f; float cba = 0.f, cbb = 0.f;
#pragma unroll
        for (int J = 0; J < 4; ++J) { const f32x2 u0 = *(const LAS f32x2*)(L + LA_T8 + ((2 * J) * 128 + 2 * p) * 4), u1 = *(const LAS f32x2*)(L + LA_T8 + ((2 * J + 1) * 128 + 2 * p) * 4);
            brefa[J + 1] = brefa[J] + (u0.x + u1.x); brefb[J + 1] = brefb[J] + (u0.y + u1.y);
            if (sb == 2 * J + 1) { cba = u0.x; cbb = u0.y; } }
        const float bIa = I == 0 ? brefa[0] : (I == 1 ? brefa[1] : (I == 2 ? brefa[2] : brefa[3])), bIb = I == 0 ? brefb[0] : (I == 1 ? brefb[1] : (I == 2 ? brefb[2] : brefb[3]));
        const float bla = brefa[4], blb = brefb[4];
        ldsa += bla; ldsb += blb;
        const float eha = fexp(bla - bIa), ehb = fexp(blb - bIb);
        const float eqa = fexp(bIa), eqb = fexp(bIb);
        unsigned kh_a[4], kh_b[4], vlo[4], vhi[4], v2lo[4], v2hi[4];
        float kfa[4], kfb[4];
#pragma unroll
        for (int Ip = 0; Ip < 4; ++Ip) { kfa[Ip] = fexp(fminf(brefa[Ip] - bIa, 0.f)); kfb[Ip] = fexp(fminf(brefb[Ip] - bIb, 0.f)); }
#pragma unroll
        for (int j = 0; j < 8; ++j) { const int t = t0 + j;
            const float cca = fmaxf(cba + ca[j], -60.f), ccb = fmaxf(cbb + cb[j], -60.f); const float e1a = fexp(cca), e1b = fexp(ccb), e2a = fexp(-cca), e2b = fexp(-ccb);
            const float kka = ka[j] * e2a, kkb = kb[j] * e2b;
            const float kha = kka * eha, khb = kkb * ehb;
            if (j & 1) { kh_a[j >> 1] |= f2bf(kha) << 16; kh_b[j >> 1] |= f2bf(khb) << 16; } else { kh_a[j >> 1] = f2bf(kha); kh_b[j >> 1] = f2bf(khb); }
            if (FULL) { const float qpa = qa[j] * e1a, qpb = qb[j] * e1b;
                *(LAS unsigned*)(L + LA_QP + t * QS + 4 * p) = pk2(qpa, qpb); *(LAS unsigned*)(L + LA_QT + t * QS + 4 * p) = pk2(qpa * eqa, qpb * eqb);
#pragma unroll
                for (int Ip = 0; Ip < 4; ++Ip) if (Ip >= I) { const int base = Ip == 0 ? 0 : (Ip == 1 ? 16 : (Ip == 2 ? 48 : 96));
                    *(LAS unsigned*)(L + LA_KP + (base + t) * QS + 4 * p) = pk2(kka * kfa[Ip], kkb * kfb[Ip]); } }
            const unsigned x = vr[j].x, y = vr[j].y;
            if (j & 1) { vlo[j >> 1] |= x << 16; vhi[j >> 1] |= x & 0xffff0000u; v2lo[j >> 1] |= y << 16; v2hi[j >> 1] |= y & 0xffff0000u; }
            else { vlo[j >> 1] = x & 0xffffu; vhi[j >> 1] = x >> 16; v2lo[j >> 1] = y & 0xffffu; v2hi[j >> 1] = y >> 16; } }
        *(LAS v4u*)(L + LA_KHT + (2 * p) * TS + 2 * t0) = (v4u){kh_a[0], kh_a[1], kh_a[2], kh_a[3]}; *(LAS v4u*)(L + LA_KHT + (2 * p + 1) * TS + 2 * t0) = (v4u){kh_b[0], kh_b[1], kh_b[2], kh_b[3]};
        if (DV == 256) { *(LAS v4u*)(L + LA_VT + (4 * p) * TS + 2 * t0) = (v4u){vlo[0], vlo[1], vlo[2], vlo[3]}; *(LAS v4u*)(L + LA_VT + (4 * p + 1) * TS + 2 * t0) = (v4u){vhi[0], vhi[1], vhi[2], vhi[3]};
                         *(LAS v4u*)(L + LA_VT + (4 * p + 2) * TS + 2 * t0) = (v4u){v2lo[0], v2lo[1], v2lo[2], v2lo[3]}; *(LAS v4u*)(L + LA_VT + (4 * p + 3) * TS + 2 * t0) = (v4u){v2hi[0], v2hi[1], v2hi[2], v2hi[3]}; }
        else { *(LAS v4u*)(L + LA_VT + (2 * p) * TS + 2 * t0) = (v4u){vlo[0], vlo[1], vlo[2], vlo[3]}; *(LAS v4u*)(L + LA_VT + (2 * p + 1) * TS + 2 * t0) = (v4u){vhi[0], vhi[1], vhi[2], vhi[3]}; }
        if (sb == 0) *(LAS f32x2*)(L + LA_DEC + 8 * p) = (f32x2){fexp(bla), fexp(blb)};
        if (ch + 1 < NCH) LA_LOAD_RAW(ch + 1);
        LA_BAR();
        v2u gwv[NVT][4];
        f32x4 oacc[TYPE == 0 ? 1 : NVT][4];
        if (FULL) {
            for (int blk = w; blk < 10; blk += 8) { const int I2 = blk >= 6 ? 3 : (blk >= 3 ? 2 : (blk >= 1 ? 1 : 0)), J2 = blk - (I2 * (I2 + 1)) / 2; const int base = I2 == 0 ? 0 : (I2 == 1 ? 16 : (I2 == 2 ? 48 : 96));
                const LAS unsigned char* kp = L + LA_KP + (base + 16 * J2 + l15) * QS + 16 * g4; const LAS unsigned char* qp = L + LA_QP + (16 * I2 + l15) * QS + 16 * g4;
                f32x4 acc = (f32x4){0.f, 0.f, 0.f, 0.f};
#pragma unroll
                for (int ks = 0; ks < 4; ++ks) acc = __builtin_amdgcn_mfma_f32_16x16x32_bf16(*(const LAS bf16x8*)(kp + 64 * ks), *(const LAS bf16x8*)(qp + 64 * ks), acc, 0, 0, 0);
                if (I2 == J2) {
#pragma unroll
                    for (int r = 0; r < 4; ++r) if (4 * g4 + r > l15) acc[r] = 0.f; }
                *(LAS v2u*)(L + LA_PS + (16 * I2 + l15) * TS + (16 * J2 + 4 * g4) * 2) = (v2u){pk2(acc[0], acc[1]), pk2(acc[2], acc[3])}; }
            LA_BAR();
            float ssq[4] = {0.f, 0.f, 0.f, 0.f};
#pragma unroll
            for (int vt = 0; vt < NVT; ++vt) {
                bf16x8 sf[4];
#pragma unroll
                for (int ks = 0; ks < 4; ++ks) { const f32x4 a = S[vt][2 * ks], c = S[vt][2 * ks + 1]; sf[ks] = mk8((v2u){pk2(a.x, a.y), pk2(a.z, a.w)}, (v2u){pk2(c.x, c.y), pk2(c.z, c.w)}); }
#pragma unroll
                for (int I2 = 0; I2 < 4; ++I2) {
                    f32x4 o = (f32x4){0.f, 0.f, 0.f, 0.f};
                    const LAS unsigned char* qt = L + LA_QT + (16 * I2 + l15) * QS + 8 * g4;
#pragma unroll
                    for (int ks = 0; ks < 4; ++ks) o = __builtin_amdgcn_mfma_f32_16x16x32_bf16(sf[ks], mk8(*(const LAS v2u*)(qt + 64 * ks), *(const LAS v2u*)(qt + 64 * ks + 32)), o, 0, 0, 0);
#pragma unroll
                    for (int ks = 0; ks < 2; ++ks) if (ks == 0 || I2 >= 2)
                        o = __builtin_amdgcn_mfma_f32_16x16x32_bf16(*(const LAS bf16x8*)(L + LA_VT + ((w * NVT + vt) * 16 + l15) * TS + (32 * ks + 8 * g4) * 2), *(const LAS bf16x8*)(L + LA_PS + (16 * I2 + l15) * TS + (32 * ks + 8 * g4) * 2), o, 0, 0, 0);
                    ssq[I2] += (o.x * o.x + o.y * o.y) + (o.z * o.z + o.w * o.w);
                    if (TYPE == 0) *(LAS v2u*)(L + LA_KP + (16 * I2 + l15) * OBS + ((w * NVT + vt) * 16 + 4 * g4) * 2) = (v2u){pk2(o.x, o.y), pk2(o.z, o.w)};
                    else oacc[vt][I2] = o;
                }
            }
#pragma unroll
            for (int I2 = 0; I2 < 4; ++I2) { float ss = ssq[I2]; ss += __shfl_xor(ss, 16); ss += __shfl_xor(ss, 32);
                if (g4 == 0) *(LAS float*)(L + LA_NRM + (w * 64 + 16 * I2 + l15) * 4) = ss; }
#pragma unroll
            for (int I2 = 0; I2 < 4; ++I2)
#pragma unroll
                for (int vt = 0; vt < NVT; ++vt) gwv[vt][I2] = *(const GAS v2u*)(P + (size_t)(m0 + 16 * I2 + l15) * PW + goff + (w * NVT + vt) * 16 + 4 * g4);
        }
        { bf16x8 bv[NVT][2];
#pragma unroll
          for (int vt = 0; vt < NVT; ++vt)
#pragma unroll
              for (int ks = 0; ks < 2; ++ks) bv[vt][ks] = *(const LAS bf16x8*)(L + LA_VT + ((w * NVT + vt) * 16 + l15) * TS + (32 * ks + 8 * g4) * 2);
#pragma unroll
          for (int dt = 0; dt < 8; ++dt) { const f32x4 dec = *(const LAS f32x4*)(L + LA_DEC + (dt * 16 + 4 * g4) * 4);
              const bf16x8 a0 = *(const LAS bf16x8*)(L + LA_KHT + (dt * 16 + l15) * TS + (8 * g4) * 2), a1 = *(const LAS bf16x8*)(L + LA_KHT + (dt * 16 + l15) * TS + (32 + 8 * g4) * 2);
#pragma unroll
              for (int vt = 0; vt < NVT; ++vt) { f32x4 sv = S[vt][dt] * dec; sv = __builtin_amdgcn_mfma_f32_16x16x32_bf16(a0, bv[vt][0], sv, 0, 0, 0); S[vt][dt] = __builtin_amdgcn_mfma_f32_16x16x32_bf16(a1, bv[vt][1], sv, 0, 0, 0); } } }
        if (FULL) {
            LA_BAR();
#pragma unroll
            for (int I2 = 0; I2 < 4; ++I2) { float tot = 0.f;
#pragma unroll
                for (int ww = 0; ww < 8; ++ww) tot += *(const LAS float*)(L + LA_NRM + (ww * 64 + 16 * I2 + l15) * 4);
                const float rstd = rsqrtf(tot * (1.f / DV) + EPS); const size_t m = (size_t)(m0 + 16 * I2 + l15);
#pragma unroll
                for (int vt = 0; vt < NVT; ++vt) { const int col = (w * NVT + vt) * 16 + 4 * g4; const v2u gw = gwv[vt][I2]; const f32x4 gg = gnv[vt]; f32x4 o; if (TYPE == 0) { const v2u ob = *(const LAS v2u*)(L + LA_KP + (16 * I2 + l15) * OBS + col * 2); o = (f32x4){blo(ob.x), bhi(ob.x), blo(ob.y), bhi(ob.y)}; } else o = oacc[vt][I2];
                    const float g0 = blo(gw.x), g1 = bhi(gw.x), g2 = blo(gw.y), g3 = bhi(gw.y);
                    float a0, a1, a2, a3; if (TYPE == 0) { a0 = g0 * sigm(g0); a1 = g1 * sigm(g1); a2 = g2 * sigm(g2); a3 = g3 * sigm(g3); } else { a0 = sigm(g0); a1 = sigm(g1); a2 = sigm(g2); a3 = sigm(g3); }
                    *(GAS v2u*)(Y + m * 1024 + h * DV + col) = (v2u){pk2(o.x * rstd * gg.x * a0, o.y * rstd * gg.y * a1), pk2(o.z * rstd * gg.z * a2, o.w * rstd * gg.w * a3)}; } }
        }
    }
    if (!FULL) {
        float* sl = slb + (size_t)item * (128 * DV);
#pragma unroll
        for (int vt = 0; vt < NVT; ++vt)
#pragma unroll
            for (int dt = 0; dt < 8; ++dt) *(GAS f32x4*)(sl + ((size_t)(((w * NVT + vt) * 8 + dt) * 64 + lane)) * 4) = S[vt][dt];
        if (w == 0) { ldb[(size_t)item * 128 + 2 * p] = ldsa; ldb[(size_t)item * 128 + 2 * p + 1] = ldsb; }
    }
    __syncthreads();
}

template <int TYPE> __device__ __forceinline__ void la_prefix(const Frame& F, int gtid, const float* SLOC, const float* LDT, float* SIN) {
    constexpr int DV = TYPE == 0 ? 256 : 128, NSEG = TYPE == 0 ? 16 : 8, NV4 = 128 * DV / 4;
    const int seq = gtid / NV4, e4 = gtid % NV4, dt = (e4 >> 6) & 7, ln = e4 & 63, d0 = dt * 16 + 4 * (ln >> 4);
    const float* slb = SLOC + (TYPE == 0 ? (size_t)0 : SLOC_HGRN_OFF) + (size_t)seq * NSEG * (128 * DV) + (size_t)e4 * 4;
    float* sib = SIN + (TYPE == 0 ? (size_t)0 : SLOC_HGRN_OFF) + (size_t)seq * NSEG * (128 * DV) + (size_t)e4 * 4;
    const float* ldb = LDT + (TYPE == 0 ? 0 : 128 * 128) + (size_t)seq * NSEG * 128 + d0;
    f32x4 sv[NSEG - 1], lv[NSEG - 1];
#pragma unroll
    for (int sg = 0; sg < NSEG - 1; ++sg) { sv[sg] = *(const GAS f32x4*)(slb + (size_t)sg * (128 * DV)); lv[sg] = *(const GAS f32x4*)(ldb + (size_t)sg * 128); }
    f32x4 S = (f32x4){0.f, 0.f, 0.f, 0.f};
#pragma unroll
    for (int sg = 0; sg < NSEG - 1; ++sg) { const f32x4 e = (f32x4){fexp(lv[sg].x), fexp(lv[sg].y), fexp(lv[sg].z), fexp(lv[sg].w)}; S = S * e + sv[sg]; *(GAS f32x4*)(sib + (size_t)(sg + 1) * (128 * DV)) = S; }
}

typedef const __attribute__((address_space(4))) Args* KArgs;
__device__ __forceinline__ KArgs kargs() { unsigned long long p = (unsigned long long)__builtin_amdgcn_kernarg_segment_ptr(); asm volatile("" : "+s"(p)); return (KArgs)p; }
__device__ __forceinline__ Frame mkframe(LAS unsigned char* lds, gu32* ctl) {
    Frame F; int tid = threadIdx.x; asm volatile("" : "+v"(tid)); int bx = blockIdx.x, G = gridDim.x; asm volatile("" : "+s"(bx), "+s"(G));
    F.lds = lds; F.MISC = (volatile LAS unsigned*)(lds + MISC_OFF); F.ctl = ctl;
    F.tid = tid; F.lane = tid & 63; F.wave = __builtin_amdgcn_readfirstlane(tid >> 6); F.G = G; F.bx = bx;
    F.vcu = (G % 8 == 0) ? (bx % 8) * (G / 8) + bx / 8 : bx;
    return F;
}
__global__ void __launch_bounds__(NWAVES * 64, 2) fwd_kernel(Args args_unused) {
    extern __shared__ __attribute__((aligned(16))) unsigned char lds_raw[];
    LAS unsigned char* lds = (LAS unsigned char*)lds_raw;
    XcdBarrier bar;
    int lo, hi;
    {
        KArgs A = kargs();
        gu32* ctl = (gu32*)(A->ws + WS_CTL);
        for (int u = threadIdx.x; u < (LDS_BYTES - LDSCTL_OFF) / 4; u += NWAVES * 64) ((LAS unsigned*)(lds + LDSCTL_OFF))[u] = 0u;
        __syncthreads();
        bar = xcd_barrier_post((unsigned*)(ctl + CW_BAR), (volatile LAS unsigned*)(lds + MISC_OFF) + 8);
        lo = A->ph_lo; hi = A->ph_hi;
    }
#define GRID_BAR() xcd_barrier(bar)
#define PH_SETUP KArgs A = kargs(); unsigned char* ws = A->ws; Frame F = mkframe(lds, (gu32*)(ws + WS_CTL)); (void)F;
#define WSP(T, off) ((T*)(ws + (off)))

    for (int rep = 0; rep < REP_P0; ++rep)
    if (lo <= 0 && 0 < hi) {
        PH_SETUP
        LAS float* scr = (LAS float*)(F.lds + RING_OFF + F.wave * 16384);
        const int gw = F.vcu * NWAVES + F.wave, NGW = F.G * NWAVES;
        int wslot = -1; float wmax = 0.f, s0c = 0.f;
#define WMAX_FLUSH() do { if (wslot >= 0) { for (int o = 1; o < 64; o <<= 1) wmax = fmaxf(wmax, __shfl_xor(wmax, o)); if (F.lane == 0) __hip_atomic_fetch_max((unsigned*)(ws + WS_CTL) + CW_WMAX + wslot, __float_as_uint(wmax), RLX_AGENT); } } while (0)
#define SLOT_ENTER(sl, SAMPLE) do { if (wslot != (sl)) { WMAX_FLUSH(); wslot = (sl); wmax = 0.f; float sm = (SAMPLE); for (int o = 1; o < 64; o <<= 1) sm = fmaxf(sm, __shfl_xor(sm, o)); s0c = fp8_scale(FP8_HEAD * sm); \
            if (F.lane == 0) __hip_atomic_fetch_max((unsigned*)(ws + WS_CTL) + CW_SMAX + wslot, __float_as_uint(sm), RLX_AGENT); } } while (0)
        for (int it = gw; it < NL * I_LAYER; it += NGW) {
            const int l = it / I_LAYER; int r = it % I_LAYER;
            unsigned char* wl = ws + WS_W + (size_t)l * WL_STRIDE;
            const size_t oGU = (size_t)l * D * FF, oD = (size_t)l * FF * D;
            if (r < 2 * I_GATE) { const bool up = r >= I_GATE; const int ri = up ? r - I_GATE : r;
                if (2 * l >= FP8_S0) { SLOT_ENTER(SL_GU(2 * l), p0_absmax_item(A->in[2] + oGU, D, FF, 0, F.lane, 0));
                    wmax = fmaxf(wmax, up ? p0_item8<2>(A->in[3] + oGU, D, FF, wl + WL_GU1, scr, ri, F.lane, s0c) : p0_item8<1>(A->in[2] + oGU, D, FF, wl + WL_GU1, scr, ri, F.lane, s0c)); }
                else if (up) p0_item<2>(A->in[3] + oGU, D, FF, (bf16*)(wl + WL_GU1), scr, ri, F.lane); else p0_item<1>(A->in[2] + oGU, D, FF, (bf16*)(wl + WL_GU1), scr, ri, F.lane);
                continue; } r -= 2 * I_GATE;
            if (r < I_DOWN) { if (2 * l >= FP8_F2_S0) { SLOT_ENTER(SL_DN(2 * l), p0_absmax_item(A->in[4] + oD, FF, D, 0, F.lane, 0)); wmax = fmaxf(wmax, p0_item8<0>(A->in[4] + oD, FF, D, wl + WL_D1, scr, r, F.lane, s0c)); }
                else p0_item<0>(A->in[4] + oD, FF, D, (bf16*)(wl + WL_D1), scr, r, F.lane);
                continue; } r -= I_DOWN;
            if (r < 2 * I_GATE) { const bool up = r >= I_GATE; const int ri = up ? r - I_GATE : r;
                if (2 * l + 1 >= FP8_S0) { SLOT_ENTER(SL_GU(2 * l + 1), p0_absmax_item(A->in[26] + oGU, D, FF, 0, F.lane, 0));
                    wmax = fmaxf(wmax, up ? p0_item8<2>(A->in[27] + oGU, D, FF, wl + WL_GU2, scr, ri, F.lane, s0c) : p0_item8<1>(A->in[26] + oGU, D, FF, wl + WL_GU2, scr, ri, F.lane, s0c)); }
                else if (up) p0_item<2>(A->in[27] + oGU, D, FF, (bf16*)(wl + WL_GU2), scr, ri, F.lane); else p0_item<1>(A->in[26] + oGU, D, FF, (bf16*)(wl + WL_GU2), scr, ri, F.lane);
                continue; } r -= 2 * I_GATE;
            if (r < I_DOWN) { if (2 * l + 1 >= FP8_F2_S0) { SLOT_ENTER(SL_DN(2 * l + 1), p0_absmax_item(A->in[28] + oD, FF, D, 0, F.lane, 0)); wmax = fmaxf(wmax, p0_item8<0>(A->in[28] + oD, FF, D, wl + WL_D2, scr, r, F.lane, s0c)); }
                else p0_item<0>(A->in[28] + oD, FF, D, (bf16*)(wl + WL_D2), scr, r, F.lane);
                continue; } r -= I_DOWN;
            if (r < I_IN) { const float* wi = A->in[7] + (size_t)l * D * IN_W;
                if (l < G8_L0) { p0_item<5>(wi, D, IN_W, (bf16*)(wl + WL_IN), scr, r, F.lane); continue; }
                if (r % NBLK_IN <= MG_NB0) p0_item<3>(wi, D, IN_W, (bf16*)(wl + WL_IN), scr, r, F.lane);
                if (r % NBLK_IN >= MG_NB0) { SLOT_ENTER(l, p0_absmax_item(wi, D, IN_W, MG_NB0 + 1, F.lane, MG_N0)); wmax = fmaxf(wmax, p0_item8<4>(wi, D, IN_W, wl + WL_IN + WL_IN8, scr, r, F.lane, s0c)); }
                continue; } r -= I_IN;
            if (r < 3 * I_BR) { const int br = r / I_BR; p0_item<0>(A->in[20 + br] + (size_t)l * 1024 * D, 1024, D, (bf16*)(wl + WL_BR) + (size_t)br * D * 1024, scr, r % I_BR, F.lane); continue; } r -= 3 * I_BR;
            p0_item<0>(A->in[23] + (size_t)l * D * D, D, D, (bf16*)(wl + WL_OUT), scr, r, F.lane);
        }
        WMAX_FLUSH();
#undef WMAX_FLUSH
#undef SLOT_ENTER
        const int gt = F.vcu * 512 + F.tid, NT = F.G * 512;
        for (int i = gt; i < NL * 2048 * 32; i += NT) { const int l = i / (2048 * 32), r = i % (2048 * 32), n = r >> 5, k8 = (r & 31) * 8;
            const int h = n >> 8, g = (n >> 7) & 1, j = n & 127, hp = 2 * (h >> 1) + (k8 >> 7), i0 = k8 & 127;
            v4u o = (v4u){0u, 0u, 0u, 0u};
            if (hp == h) { const float* w = (g ? A->in[12] : A->in[10]) + (size_t)l * 8 * 128 * 128 + (size_t)h * 128 * 128 + (size_t)i0 * 128 + j;
                o.x = pk2(w[0], w[128]); o.y = pk2(w[256], w[384]); o.z = pk2(w[512], w[640]); o.w = pk2(w[768], w[896]); }
            *(GAS v4u*)((bf16*)(ws + WS_W + (size_t)l * WL_STRIDE + WL_GT) + (size_t)n * 256 + k8) = o; }
        if (gt < 1024) { float* LB = WSP(float, WS_LB); const float* lg = A->in[18]; float v0 = lg[gt], v1 = lg[1024 + gt], v2 = lg[2048 + gt], v3 = lg[3072 + gt];
            const float mx = fmaxf(fmaxf(v0, v1), fmaxf(v2, v3)); v0 = expf(v0 - mx); v1 = expf(v1 - mx); v2 = expf(v2 - mx); v3 = expf(v3 - mx);
            const float inv = 1.f / (v0 + v1 + v2 + v3);
            LB[gt] = 0.f; LB[1024 + gt] = v1 * inv; LB[2048 + gt] = (v1 + v2) * inv; LB[3072 + gt] = (v1 + v2 + v3) * inv; }
        rowpass(F, A->in[0], nullptr, nullptr, nullptr, nullptr, nullptr, nullptr, nullptr, 0.f, A->in[1], WSP(bf16, WS_H));
        GRID_BAR();
    }
    if (lo <= 0 && 0 < hi) {
        PH_SETUP
        LAS float* scr = (LAS float*)(F.lds + RING_OFF + F.wave * 16384);
        const int gw = F.vcu * NWAVES + F.wave, NGW = F.G * NWAVES;
        bool redo = false;
        for (int l = G8_L0; l < NL; ++l) { if (wscale_ok(ws, l)) continue; redo = true; const float sW = wscale(ws, l);
            for (int it = gw; it < I_MG; it += NGW) { const int kb = it / (NBLK_IN - MG_NB0), nb = MG_NB0 + it % (NBLK_IN - MG_NB0);
                (void)p0_item8<4>(A->in[7] + (size_t)l * D * IN_W, D, IN_W, ws + WS_W + (size_t)l * WL_STRIDE + WL_IN + WL_IN8, scr, kb * NBLK_IN + nb, F.lane, sW); } }
        for (int hs = FP8_S0; hs < 2 * NL; ++hs) { if (wscale_ok(ws, SL_GU(hs))) continue; redo = true; const float sW = wscale(ws, SL_GU(hs)); const int l = hs >> 1, f = hs & 1;
            unsigned char* w8 = ws + WS_W + (size_t)l * WL_STRIDE + (f ? WL_GU2 : WL_GU1);
            for (int it = gw; it < 2 * I_GATE; it += NGW) {
                if (it < I_GATE) (void)p0_item8<1>((f ? A->in[26] : A->in[2]) + (size_t)l * D * FF, D, FF, w8, scr, it, F.lane, sW);
                else (void)p0_item8<2>((f ? A->in[27] : A->in[3]) + (size_t)l * D * FF, D, FF, w8, scr, it - I_GATE, F.lane, sW); } }
        for (int hs = FP8_F2_S0; hs < 2 * NL; ++hs) { if (wscale_ok(ws, SL_DN(hs))) continue; redo = true; const float sW = wscale(ws, SL_DN(hs)); const int l = hs >> 1, f = hs & 1;
            for (int it = gw; it < I_DOWN; it += NGW) (void)p0_item8<0>((f ? A->in[28] : A->in[4]) + (size_t)l * FF * D, FF, D, ws + WS_W + (size_t)l * WL_STRIDE + (f ? WL_D2 : WL_D1), scr, it, F.lane, sW); }
        if (redo && hi > 1) GRID_BAR();
    }

    int ph = 1;
#define PH_BEGIN if (lo <= ph && ph < hi) { PH_SETUP unsigned char* wl = ws + WS_W + (size_t)l * WL_STRIDE; (void)wl;
#define PH_END(last) if (!(last) && ph + 1 < hi) GRID_BAR(); } ++ph;
#pragma unroll 1
    for (int s = 0; s < 2 * NL; ++s) {
        const int l = s >> 1, f = s & 1;
        for (int rep = 0; rep < REP_F1; ++rep) { if (rep) --ph;
        PH_BEGIN
            if (s >= FP8_S0) {
                pg8::Gemm g{WSP(bf16, WS_H8), (const bf16*)(wl + (f ? WL_GU2 : WL_GU1)), M, 2 * FF, D / 2, D / 2}; pg8::StaticOrder S; S.init(M, 2 * FF, F.G, F.bx);
                const float sc = 1.0f / (h8_scale((f ? A->in[25] : A->in[1]) + (size_t)l * D, F.lane) * wscale(ws, SL_GU(s)));
                const bool track = (s + 1 >= FP8_F2_S0 && s + 1 < 2 * NL), out8 = (s >= FP8_F2_S0);
                LAS unsigned* mxw = (LAS unsigned*)(F.lds + MISC_OFF + 1024);
                if (F.tid == 0) *mxw = 0u;
                const float s8 = out8 ? fp8_scale(4.0f * __uint_as_float(((const gu32*)(ws + WS_CTL))[CW_WMAX + SL_ACT(s)])) : 0.f;
                pg8::EpiSwiGLU8 E{WSP(bf16, WS_P), FF, sc, out8 ? WSP(unsigned char, WS_P) : nullptr, s8, track ? mxw : nullptr};
                pg8::gemm_phase<pg8::EpiSwiGLU8, pg8::StaticOrder, GEMM_ALIGN, GEMM_SP2, 0, true>(F.lds + RING_OFF, g, S, E);
                if (track && F.tid == 0) __hip_atomic_fetch_max((unsigned*)(ws + WS_CTL) + CW_WMAX + SL_ACT(s + 1), *mxw, RLX_AGENT);
            } else {
            pg8::Gemm g{WSP(bf16, WS_H), (const bf16*)(wl + (f ? WL_GU2 : WL_GU1)), M, 2 * FF, D, HP}; pg8::StaticOrder S; S.init(M, 2 * FF, F.G, F.bx);
            pg8::EpiSwiGLU E{WSP(bf16, WS_P), FF};
            pg8::gemm_phase<pg8::EpiSwiGLU, pg8::StaticOrder, GEMM_ALIGN, GEMM_SP2, HP == D ? 0 : HP>(F.lds + RING_OFF, g, S, E);
            }
        PH_END(false) }
        for (int rep = 0; rep < REP_F2; ++rep) { if (rep) --ph;
        PH_BEGIN
            if (s >= FP8_F2_S0) {
                pg8::Gemm g{WSP(bf16, WS_P), (const bf16*)(wl + (f ? WL_D2 : WL_D1)), M, D, FF / 2, FF / 2}; pg8::StaticOrder S; S.init(M, D, F.G, F.bx);
                const float sc = 1.0f / (fp8_scale(4.0f * __uint_as_float(((const gu32*)(ws + WS_CTL))[CW_WMAX + SL_ACT(s)])) * wscale(ws, SL_DN(s)));
                pg8::EpiRaw8 E{WSP(bf16, WS_Y), D, sc};
                pg8::gemm_phase<pg8::EpiRaw8, pg8::StaticOrder, GEMM_ALIGN, GEMM_SP2, 0, true>(F.lds + RING_OFF, g, S, E);
            } else {
            pg8::Gemm g{WSP(bf16, WS_P), (const bf16*)(wl + (f ? WL_D2 : WL_D1)), M, D, FF, FF}; pg8::StaticOrder S; S.init(M, D, F.G, F.bx);
            pg8::EpiRawBf16 E{WSP(bf16, WS_Y), D};
            pg8::gemm_phase<pg8::EpiRawBf16, pg8::StaticOrder, GEMM_ALIGN, GEMM_SP2>(F.lds + RING_OFF, g, S, E);
            }
        PH_END(false) }
        for (int rep = 0; rep < REP_RP; ++rep) { if (rep) --ph;
        PH_BEGIN
            const float* gpost = A->in[f ? 29 : 5] + (size_t)l * D;
            const float* gpre = f ? (l + 1 < NL ? A->in[1] + (size_t)(l + 1) * D : nullptr) : A->in[6] + (size_t)l * D;
            const bool lastp = (s == 2 * NL - 1);
            rowpass(F, (s == 0) ? A->in[0] : nullptr, WSP(unsigned short, WS_XH), WSP(unsigned char, WS_XL), WSP(bf16, WS_Y), lastp ? A->out : nullptr, WSP(unsigned short, WS_XH), WSP(unsigned char, WS_XL), gpost, 0.5f, gpre, (gpre && !(f == 1 && s + 1 >= FP8_S0)) ? WSP(bf16, WS_H) : nullptr, ((f == 0 && l >= G8_L0) || (f == 1 && gpre && s + 1 >= FP8_S0)) ? WSP(unsigned char, WS_H8) : nullptr);
        PH_END(s == 2 * NL - 1 && rep == REP_RP - 1) }
        if (f == 0) {
            for (int rep = 0; rep < REP_M1; ++rep) { if (rep) --ph;
        PH_BEGIN
                if (l < G8_L0) {
                  pg8::Gemm g{WSP(bf16, WS_H), (const bf16*)(wl + WL_IN), M, NIN, D, HP}; pg8::StaticOrder S; S.init(M, NIN, F.G, F.bx);
                  pg8::EpiWinFull E{WSP(bf16, WS_P), PW, WSP(unsigned char, WS_MGQ), WSP(float, WS_LB) + l * 1024};
                  pg8::gemm_phase<pg8::EpiWinFull, pg8::StaticOrder, GEMM_ALIGN, GEMM_SP2, HP == D ? 0 : HP>(F.lds + RING_OFF, g, S, E);
                } else {
                { pg8::Gemm g{WSP(bf16, WS_H), (const bf16*)(wl + WL_IN), M, PW, D, HP}; pg8::StaticOrder S; S.init(M, PW, F.G, F.bx);
                  pg8::EpiWin E{WSP(bf16, WS_P), PW, WSP(float, WS_LB) + l * 1024};
                  pg8::gemm_phase<pg8::EpiWin, pg8::StaticOrder, GEMM_ALIGN, GEMM_SP2, HP == D ? 0 : HP>(F.lds + RING_OFF, g, S, E); }
                { Frame F2 = mkframe(lds, (gu32*)(ws + WS_CTL));
                  pg8::Gemm g{WSP(bf16, WS_H8), (const bf16*)(wl + WL_IN + WL_IN8), M, 6144, D / 2, D / 2}; pg8::StaticOrder S; S.init(M, 6144, F2.G, F2.bx);
                  const float sc = 1.0f / (h8_scale(A->in[6] + (size_t)l * D, F2.lane) * wscale(ws, l));
                  pg8::EpiWinGate E{WSP(unsigned char, WS_MGQ), sc};
                  pg8::gemm_phase<pg8::EpiWinGate, pg8::StaticOrder, GEMM_ALIGN, GEMM_SP2, 0, true>(F2.lds + RING_OFF, g, S, E); }
                }
            PH_END(false) }
            for (int rep = 0; rep < REP_M3; ++rep) { if (rep) --ph;
            PH_BEGIN
                { Frame F2 = mkframe(lds, (gu32*)(ws + WS_CTL));
                  lrgg_phase(F2, WSP(bf16, WS_H), (const bf16*)(wl + WL_IN) + (size_t)NIN * D, A->in[15] + (size_t)l * 16 * 512, A->in[16] + l * 512, WSP(float, WS_GG));
                  pg8::GateOrder S2; S2.init(M, 2048, F2.G, F2.bx); pg8::Unit u;
#pragma unroll 1
                  for (int i = 0; S2.next(i, u); ++i) conv_item(WSP(bf16, WS_P), A->in[8] + (size_t)l * 4 * 1024, A->in[9] + (size_t)l * 1024, WSP(bf16, WS_XC), 256 * (u.pn >> 1) + 8 * (F2.tid & 31), 256 * u.pm + 16 * (F2.tid >> 5));
                  VM_WAIT(); __syncthreads(); }
                int kgate = 256; asm volatile("" : "+s"(kgate));
                pg8::Gemm g{WSP(bf16, WS_XC), (const bf16*)(wl + WL_GT), M, 2048, kgate, 1024}; pg8::GateOrder S; S.init(M, 2048, F.G, F.bx);
                pg8::EpiGate8 E{WSP(unsigned char, WS_GT), A->in[11] + l * 1024, A->in[13] + l * 1024};
                pg8::gemm_phase<pg8::EpiGate8, pg8::GateOrder, GEMM_ALIGN, GEMM_SP2, 1024>(F.lds + RING_OFF, g, S, E);
            PH_END(false) }
            for (int rep = 0; rep < REP_M4; ++rep) { if (rep) --ph;
            PH_BEGIN
                lru_chunk_phase<false>(F, WSP(unsigned char, WS_GT), WSP(bf16, WS_XC), WSP(bf16, WS_P), A->in[11] + l * 1024, A->in[13] + l * 1024, A->in[14] + l * 1024, WSP(float, WS_CA), WSP(float, WS_CH), WSP(float, WS_HIN), WSP(bf16, WS_YA), F.bx < 128 ? LRUA_G * F.bx : 128 * LRUA_G + (8 - LRUA_G) * (F.bx - 128), F.bx < 128 ? LRUA_G * F.bx + LRUA_G : 128 * LRUA_G + (8 - LRUA_G) * (F.bx - 127));
                if (F.bx < 128) la_segment<0, false>(F, F.bx, WSP(bf16, WS_P), WSP(float, WS_GG), WSP(float, WS_LB) + l * 1024, A->in[17] + l * 256, WSP(float, WS_SLOC), WSP(float, WS_LDT), WSP(float, WS_SIN), WSP(bf16, WS_YB));
                else la_segment<1, false>(F, F.bx - 128, WSP(bf16, WS_P), WSP(float, WS_GG), WSP(float, WS_LB) + l * 1024, A->in[19] + l * 128, WSP(float, WS_SLOC), WSP(float, WS_LDT), WSP(float, WS_SIN), WSP(bf16, WS_YC));
            PH_END(false) }
            for (int rep = 0; rep < REP_M5; ++rep) { if (rep) --ph;
            PH_BEGIN
                lru_carry_phase(F, WSP(float, WS_CA), WSP(float, WS_CH), WSP(float, WS_HIN));
                if (F.bx < 128) la_prefix<0>(F, F.bx * 512 + F.tid, WSP(float, WS_SLOC), WSP(float, WS_LDT), WSP(float, WS_SIN));
                else la_prefix<1>(F, (F.bx - 128) * 512 + F.tid, WSP(float, WS_SLOC), WSP(float, WS_LDT), WSP(float, WS_SIN));
            PH_END(false) }
            for (int rep = 0; rep < REP_M6; ++rep) { if (rep) --ph;
            PH_BEGIN
                if (rep == 0) lru_chunk_phase<true>(F, WSP(unsigned char, WS_GT), WSP(bf16, WS_XC), WSP(bf16, WS_P), A->in[11] + l * 1024, A->in[13] + l * 1024, A->in[14] + l * 1024, WSP(float, WS_CA), WSP(float, WS_CH), WSP(float, WS_HIN), WSP(bf16, WS_YA), F.bx < 128 ? LRUC_G * F.bx : 128 * LRUC_G + (8 - LRUC_G) * (F.bx - 128), F.bx < 128 ? LRUC_G * F.bx + LRUC_G : 128 * LRUC_G + (8 - LRUC_G) * (F.bx - 127));
                if (F.bx < 128) { if (rep == 0 || PROBE_SECOND != 2) la_segment<0, true>(F, F.bx, WSP(bf16, WS_P), WSP(float, WS_GG), WSP(float, WS_LB) + l * 1024, A->in[17] + l * 256, WSP(float, WS_SLOC), WSP(float, WS_LDT), WSP(float, WS_SIN), WSP(bf16, WS_YB)); }
                else if (rep == 0 || PROBE_SECOND != 1) la_segment<1, true>(F, F.bx - 128, WSP(bf16, WS_P), WSP(float, WS_GG), WSP(float, WS_LB) + l * 1024, A->in[19] + l * 128, WSP(float, WS_SLOC), WSP(float, WS_LDT), WSP(float, WS_SIN), WSP(bf16, WS_YC));
            PH_END(false) }
            for (int rep = 0; rep < REP_M7; ++rep) { if (rep) --ph;
        PH_BEGIN
                pg8::Gemm g{WSP(bf16, WS_YA), (const bf16*)(wl + WL_BR), M, D, 1024, 1024}; pg8::BranchOrder S; S.init(M, D, F.G, F.bx);
                S.astride = (size_t)M * 1024 * 2; S.bstride = (size_t)D * 1024 * 2;
                pg8::EpiBranchFused E{WSP(unsigned char, WS_MGQ), WSP(bf16, WS_MG), D};
                pg8::gemm_phase<pg8::EpiBranchFused, pg8::BranchOrder, GEMM_ALIGN, GEMM_SP2>(F.lds + RING_OFF, g, S, E);
            PH_END(false) }
            for (int rep = 0; rep < REP_M8; ++rep) { if (rep) --ph;
        PH_BEGIN
                pg8::Gemm g{WSP(bf16, WS_MG), (const bf16*)(wl + WL_OUT), M, D, D, D}; pg8::StaticOrder S; S.init(M, D, F.G, F.bx);
                pg8::EpiRawBf16 E{WSP(bf16, WS_Y), D};
                pg8::gemm_phase<pg8::EpiRawBf16, pg8::StaticOrder, GEMM_ALIGN, GEMM_SP2>(F.lds + RING_OFF, g, S, E);
            PH_END(false) }
            for (int rep = 0; rep < REP_RP; ++rep) { if (rep) --ph;
            PH_BEGIN
                rowpass(F, nullptr, WSP(unsigned short, WS_XH), WSP(unsigned char, WS_XL), WSP(bf16, WS_Y), nullptr, WSP(unsigned short, WS_XH), WSP(unsigned char, WS_XL), A->in[24] + (size_t)l * D, 1.0f, A->in[25] + (size_t)l * D, 2 * l + 1 >= FP8_S0 ? nullptr : WSP(bf16, WS_H), 2 * l + 1 >= FP8_S0 ? WSP(unsigned char, WS_H8) : nullptr);
            PH_END(false) }
        }
    }
}

static int gridDimOk() { return 1; }
extern "C" void kernel_launch(void* const* d_in, const int* in_sizes, int n_in, void* d_out, int out_size, void* d_ws, size_t ws_size, hipStream_t stream) {
    static int grid = 0;
    if (grid == 0) {
        if (n_in != 30 || in_sizes[0] != M * D || out_size != M * D || ws_size < WS_END || gridDimOk() == 0) { fprintf(stderr, "kernel_launch: unexpected shapes (n_in %d, in0 %d, out %d, ws %zu < %zu)\n", n_in, n_in > 0 ? in_sizes[0] : -1, out_size, ws_size, (size_t)WS_END); grid = -1; return; }
        int dev = 0, cus = 0, per_cu = 0;
        if (hipGetDevice(&dev) != hipSuccess || hipDeviceGetAttribute(&cus, hipDeviceAttributeMultiprocessorCount, dev) != hipSuccess) { grid = -1; return; }
        if (hipFuncSetAttribute((const void*)fwd_kernel, hipFuncAttributeMaxDynamicSharedMemorySize, LDS_BYTES) != hipSuccess) { fprintf(stderr, "kernel_launch: hipFuncSetAttribute failed\n"); grid = -1; return; }
        if (hipOccupancyMaxActiveBlocksPerMultiprocessor(&per_cu, (const void*)fwd_kernel, NWAVES * 64, LDS_BYTES) != hipSuccess || per_cu < 1) fprintf(stderr, "kernel_launch: occupancy query says %d\n", per_cu);
        (void)hipGetLastError();
        grid = cus;
    }
    if (grid < 0) return;
    if (hipMemsetAsync((char*)d_ws + WS_CTL, 0, CTL_ZERO_BYTES, stream) != hipSuccess) return;
    Args a{};
    for (int i = 0; i < 30; ++i) a.in[i] = (const float*)d_in[i];
    a.out = (float*)d_out; a.ws = (unsigned char*)d_ws; a.ph_lo = 0; a.ph_hi = 1 << 20;
    hipLaunchKernelGGL(fwd_kernel, dim3(grid), dim3(NWAVES * 64), LDS_BYTES, stream, a);
}
```

```cpp
#include <hip/hip_runtime.h>
#include <cstdio>
#include <cstdint>
#ifndef FP8_S0
#define FP8_S0 5
#endif
#ifndef FP8_F2_S0
#define FP8_F2_S0 5
#endif
#ifndef G8_L0
#define G8_L0 1
#endif
#ifndef LRUA_G
#define LRUA_G 5
#endif
#ifndef LRUC_G
#define LRUC_G 6
#endif
#ifndef REP_M2
#define REP_M2 1
#endif
#ifndef REP_M4
#define REP_M4 1
#endif
#ifndef REP_M5
#define REP_M5 1
#endif
#ifndef REP_M6
#define REP_M6 1
#endif
#ifndef REP_F1
#define REP_F1 1
#endif
#ifndef REP_F2
#define REP_F2 1
#endif
#ifndef REP_M1
#define REP_M1 1
#endif
#ifndef REP_M3
#define REP_M3 1
#endif
#ifndef REP_M7
#define REP_M7 1
#endif
#ifndef REP_M8
#define REP_M8 1
#endif
#ifndef REP_P0
#define REP_P0 1
#endif
#ifndef REP_LAG
#define REP_LAG 1
#endif
#ifndef REP_LAH
#define REP_LAH 1
#endif
#ifndef GEMM_SP2
#define GEMM_SP2 true
#endif
#ifndef GEMM_ALIGN
#define GEMM_ALIGN true
#endif
#ifndef PROBE_SECOND
#define PROBE_SECOND 0
#endif
#ifndef REP_RP
#define REP_RP 1
#endif
namespace pg8 {
#define PG8_LAS __attribute__((address_space(3)))
typedef unsigned short bf16_t;
typedef short bf16x8 __attribute__((ext_vector_type(8)));
typedef float f32x4 __attribute__((ext_vector_type(4)));
typedef unsigned u32x4 __attribute__((ext_vector_type(4)));
constexpr int BM = 256, BK = 64, HALF = 128, HTB = HALF * BK * 2  , STAGE_BYTES = 8 * HTB, NXCD = 8, WGM = 8;

__host__ __device__ __forceinline__ int lds_byte(int r, int c) { const int st = (r >> 4) * 2 + (c >> 5), rr = r & 15, cc = c & 31, ob = rr * 64 + cc * 2; return st * 1024 + (ob ^ (((ob >> 9) & 1) << 5)); }
__host__ __device__ __forceinline__ void stage_rc(int b, int& R, int& C) { const int st = b / 1024, sb = b % 1024, swz = sb ^ (((sb >> 9) & 1) << 5); R = (st >> 1) * 16 + swz / 64; C = (st & 1) * 32 + (swz % 64) / 2; }
__host__ __device__ __forceinline__ int perm32(int rho) { const int n = rho >> 4, i = rho & 15; return 8 * (i >> 2) + 4 * n + (i & 3); }

struct Unit { int pm, pn, seg; };
struct Gemm { const bf16_t* A; const bf16_t* Bt; int M, N, K, lda; };

struct StaticOrder {
    int nM, nN, nwg, G, c;
    __host__ __device__ void init(int M, int N, int G_, int c_) { nM = M / BM; nN = N / BM; nwg = nM * nN; G = G_; c = c_; }
    __host__ __device__ __forceinline__ bool next(int i, Unit& u) const {
        const long L = (long)i * G + c; if (L >= nwg) return false;
        int wgid = (int)L; { const int q = nwg / NXCD, r = nwg % NXCD, xcd = wgid % NXCD, off = wgid / NXCD; wgid = (xcd < r ? xcd * (q + 1) : r * (q + 1) + (xcd - r) * q) + off; }
        const int nig = WGM * nN, gid = wgid / nig, fm = gid * WGM, gsz = (nM - fm) < WGM ? (nM - fm) : WGM;
        u.pm = fm + ((wgid % nig) % gsz); u.pn = (wgid % nig) / gsz; u.seg = 0; return true;
    }
    __device__ __forceinline__ const char* pa(const Gemm& g, const Unit& u, size_t tstep) const { return (const char*)g.A + (size_t)u.pm * tstep; }
    __device__ __forceinline__ const char* pb(const Gemm& g, const Unit& u, size_t tstep) const { return (const char*)g.Bt + (size_t)u.pn * tstep; }
    __device__ __forceinline__ void a_ready(const Unit&) const {}
    __device__ __forceinline__ void done(const Unit&) const {}
};

typedef float f32x2c __attribute__((ext_vector_type(2))); typedef __bf16 bf16x2c __attribute__((ext_vector_type(2)));
__device__ __forceinline__ unsigned cvt_pk_bf16(float lo, float hi) { f32x2c v = {lo, hi}; bf16x2c b = __builtin_convertvector(v, bf16x2c); return __builtin_bit_cast(unsigned, b); }
typedef float f32x2 __attribute__((ext_vector_type(2)));
__device__ __forceinline__ float bf_lo(unsigned w) { return __uint_as_float(w << 16); }
__device__ __forceinline__ float bf_hi(unsigned w) { return __uint_as_float(w & 0xffff0000u); }
__device__ __forceinline__ float sigmoidf_fast(float x) { return __builtin_amdgcn_rcpf(1.0f + __builtin_amdgcn_exp2f(-1.44269504089f * x)); }
typedef unsigned u32x2 __attribute__((ext_vector_type(2)));

struct EpiF32 {
    static constexpr bool PERM = false, AFTER_DRAIN = false, SEGMENTED = false;
    float* C; int ldc;
    __device__ __forceinline__ void operator()(const f32x4 (&acc)[2][2][4][2], const Unit& u, int wr, int wc, int fr, int fq) const {
        const int row0 = u.pm * BM + wr * 64 + fr, col0 = u.pn * BM + wc * 32 + 4 * fq;
#pragma unroll
        for (int ai = 0; ai < 2; ++ai)
#pragma unroll
            for (int m = 0; m < 4; ++m) { float* rowp = C + (size_t)(row0 + ai * HALF + m * 16) * ldc + col0;
#pragma unroll
                for (int bj = 0; bj < 2; ++bj)
#pragma unroll
                    for (int n = 0; n < 2; ++n) *(f32x4*)(rowp + bj * HALF + n * 16) = acc[ai][bj][m][n]; }
    }
};
struct EpiRawBf16 {
    static constexpr bool PERM = true, AFTER_DRAIN = false, SEGMENTED = false;
    bf16_t* O; int ldc;
    __device__ __forceinline__ void operator()(const f32x4 (&acc)[2][2][4][2], const Unit& u, int wr, int wc, int fr, int fq) const {
        const int row0 = u.pm * BM + wr * 64 + fr, col0 = u.pn * BM + wc * 32 + 8 * fq;
#pragma unroll
        for (int ai = 0; ai < 2; ++ai)
#pragma unroll
            for (int m = 0; m < 4; ++m) { bf16_t* rowp = O + (size_t)(row0 + ai * HALF + m * 16) * ldc + col0;
#pragma unroll
                for (int bj = 0; bj < 2; ++bj) { const f32x4 v0 = acc[ai][bj][m][0], v1 = acc[ai][bj][m][1];
                    u32x4 w; w.x = cvt_pk_bf16(v0[0], v0[1]); w.y = cvt_pk_bf16(v0[2], v0[3]); w.z = cvt_pk_bf16(v1[0], v1[1]); w.w = cvt_pk_bf16(v1[2], v1[3]);
                    *(u32x4*)(rowp + bj * HALF) = w; } }
    }
};
struct EpiWin {
    static constexpr bool PERM = true, AFTER_DRAIN = false, SEGMENTED = false;
    bf16_t* O; int ldc; const float* lb;
    __device__ __forceinline__ void operator()(const f32x4 (&acc)[2][2][4][2], const Unit& u, int wr, int wc, int fr, int fq) const {
        const int row0 = u.pm * BM + wr * 64 + fr, colt = wc * 32 + 8 * fq;
        const int kind = (u.pn == 8 || u.pn == 9) ? 1 : ((u.pn >= 20 && u.pn < 24) ? 2 : ((u.pn >= 24 && u.pn < 28) ? 3 : 0));
        float lbv[2][8];
#pragma unroll
        for (int bj = 0; bj < 2; ++bj)
#pragma unroll
            for (int k = 0; k < 8; ++k) lbv[bj][k] = kind == 3 ? lb[(u.pn - 24) * BM + bj * HALF + colt + k] : 0.f;
#pragma unroll
        for (int ai = 0; ai < 2; ++ai)
#pragma unroll
            for (int m = 0; m < 4; ++m) { const size_t row = (size_t)(row0 + ai * HALF + m * 16);
#pragma unroll
                for (int bj = 0; bj < 2; ++bj) { const f32x4 v0 = acc[ai][bj][m][0], v1 = acc[ai][bj][m][1];
                    f32x4 x0 = v0, x1 = v1;
                    if (kind == 1) { x0 = x0 * 0.08838834764831845f; x1 = x1 * 0.08838834764831845f; }
                    else if (kind == 2) {
#pragma unroll
                        for (int j = 0; j < 4; ++j) { x0[j] = x0[j] * sigmoidf_fast(x0[j]); x1[j] = x1[j] * sigmoidf_fast(x1[j]); } }
                    else if (kind == 3) {
#pragma unroll
                        for (int j = 0; j < 4; ++j) { const float la = lbv[bj][j], lc = lbv[bj][4 + j];
                            x0[j] = 0.69314718056f * __builtin_amdgcn_logf(la + (1.0f - la) * sigmoidf_fast(x0[j])); x1[j] = 0.69314718056f * __builtin_amdgcn_logf(lc + (1.0f - lc) * sigmoidf_fast(x1[j])); } }
                    u32x4 w; w.x = cvt_pk_bf16(x0[0], x0[1]); w.y = cvt_pk_bf16(x0[2], x0[3]); w.z = cvt_pk_bf16(x1[0], x1[1]); w.w = cvt_pk_bf16(x1[2], x1[3]);
                    *(u32x4*)(O + row * ldc + u.pn * BM + colt + bj * HALF) = w; } }
    }
};
struct EpiWinGate {
    static constexpr bool PERM = true, AFTER_DRAIN = false, SEGMENTED = false;
    unsigned char* Q; float sc;
    __device__ __forceinline__ void operator()(const f32x4 (&acc)[2][2][4][2], const Unit& u, int wr, int wc, int fr, int fq) const {
        const int row0 = u.pm * BM + wr * 64 + fr, colt = wc * 32 + 8 * fq;
#pragma unroll
        for (int ai = 0; ai < 2; ++ai)
#pragma unroll
            for (int m = 0; m < 4; ++m) { const size_t row = (size_t)(row0 + ai * HALF + m * 16);
#pragma unroll
                for (int bj = 0; bj < 2; ++bj) { const f32x4 v0 = acc[ai][bj][m][0] * sc, v1 = acc[ai][bj][m][1] * sc; unsigned q[8];
#pragma unroll
                    for (int j = 0; j < 4; ++j) { const float s0 = 255.0f * __builtin_amdgcn_rcpf(1.0f + __builtin_amdgcn_exp2f(-1.44269504089f * __builtin_amdgcn_fmed3f(v0[j], -30.f, 30.f))) + 0.5f,
                                                              s1 = 255.0f * __builtin_amdgcn_rcpf(1.0f + __builtin_amdgcn_exp2f(-1.44269504089f * __builtin_amdgcn_fmed3f(v1[j], -30.f, 30.f))) + 0.5f;
                        q[j] = (unsigned)__builtin_amdgcn_fmed3f(s0, 1.0f, 255.0f); q[4 + j] = (unsigned)__builtin_amdgcn_fmed3f(s1, 1.0f, 255.0f); }
                    u32x2 w; w.x = q[0] | (q[1] << 8) | (q[2] << 16) | (q[3] << 24); w.y = q[4] | (q[5] << 8) | (q[6] << 16) | (q[7] << 24);
                    *(u32x2*)(Q + row * 6144 + u.pn * BM + colt + bj * HALF) = w; } }
    }
};
struct EpiWinFull {
    static constexpr bool PERM = true, AFTER_DRAIN = false, SEGMENTED = false;
    bf16_t* O; int ldc; unsigned char* Q; const float* lb;
    __device__ __forceinline__ void operator()(const f32x4 (&acc)[2][2][4][2], const Unit& u, int wr, int wc, int fr, int fq) const {
        const int row0 = u.pm * BM + wr * 64 + fr, colt = wc * 32 + 8 * fq; const bool gate = u.pn >= 36;
        const int kind = (u.pn == 8 || u.pn == 9) ? 1 : ((u.pn >= 20 && u.pn < 24) ? 2 : ((u.pn >= 24 && u.pn < 28) ? 3 : 0));
        float lbv[2][8];
#pragma unroll
        for (int bj = 0; bj < 2; ++bj)
#pragma unroll
            for (int k = 0; k < 8; ++k) lbv[bj][k] = kind == 3 ? lb[(u.pn - 24) * BM + bj * HALF + colt + k] : 0.f;
#pragma unroll
        for (int ai = 0; ai < 2; ++ai)
#pragma unroll
            for (int m = 0; m < 4; ++m) { const size_t row = (size_t)(row0 + ai * HALF + m * 16);
#pragma unroll
                for (int bj = 0; bj < 2; ++bj) { const f32x4 v0 = acc[ai][bj][m][0], v1 = acc[ai][bj][m][1];
                    if (gate) { unsigned q[8];
#pragma unroll
                        for (int j = 0; j < 4; ++j) { const float s0 = 255.0f * __builtin_amdgcn_rcpf(1.0f + __builtin_amdgcn_exp2f(-1.44269504089f * __builtin_amdgcn_fmed3f(v0[j], -30.f, 30.f))) + 0.5f,
                                                                  s1 = 255.0f * __builtin_amdgcn_rcpf(1.0f + __builtin_amdgcn_exp2f(-1.44269504089f * __builtin_amdgcn_fmed3f(v1[j], -30.f, 30.f))) + 0.5f;
                            q[j] = (unsigned)__builtin_amdgcn_fmed3f(s0, 1.0f, 255.0f); q[4 + j] = (unsigned)__builtin_amdgcn_fmed3f(s1, 1.0f, 255.0f); }
                        u32x2 w; w.x = q[0] | (q[1] << 8) | (q[2] << 16) | (q[3] << 24); w.y = q[4] | (q[5] << 8) | (q[6] << 16) | (q[7] << 24);
                        *(u32x2*)(Q + row * 6144 + (u.pn - 36) * BM + colt + bj * HALF) = w; }
                    else { f32x4 x0 = v0, x1 = v1;
                        if (kind == 1) { x0 = x0 * 0.08838834764831845f; x1 = x1 * 0.08838834764831845f; }
                        else if (kind == 2) {
#pragma unroll
                            for (int j = 0; j < 4; ++j) { x0[j] = x0[j] * sigmoidf_fast(x0[j]); x1[j] = x1[j] * sigmoidf_fast(x1[j]); } }
                        else if (kind == 3) {
#pragma unroll
                            for (int j = 0; j < 4; ++j) { const float la = lbv[bj][j], lc = lbv[bj][4 + j];
                                x0[j] = 0.69314718056f * __builtin_amdgcn_logf(la + (1.0f - la) * sigmoidf_fast(x0[j])); x1[j] = 0.69314718056f * __builtin_amdgcn_logf(lc + (1.0f - lc) * sigmoidf_fast(x1[j])); } }
                        u32x4 w; w.x = cvt_pk_bf16(x0[0], x0[1]); w.y = cvt_pk_bf16(x0[2], x0[3]); w.z = cvt_pk_bf16(x1[0], x1[1]); w.w = cvt_pk_bf16(x1[2], x1[3]);
                        *(u32x4*)(O + row * ldc + u.pn * BM + colt + bj * HALF) = w; } } }
    }
};
struct EpiGate8 {
    static constexpr bool PERM = true, AFTER_DRAIN = false, SEGMENTED = false;
    unsigned char* Q; const float* ba; const float* bx;
    __device__ __forceinline__ void operator()(const f32x4 (&acc)[2][2][4][2], const Unit& u, int wr, int wc, int fr, int fq) const {
        const int row0 = u.pm * BM + wr * 64 + fr, colt = wc * 32 + 8 * fq, ch = u.pn * HALF + colt;
        float b[2][8];
#pragma unroll
        for (int k = 0; k < 8; ++k) { b[0][k] = ba[ch + k]; b[1][k] = bx[ch + k]; }
#pragma unroll
        for (int ai = 0; ai < 2; ++ai)
#pragma unroll
            for (int m = 0; m < 4; ++m) { unsigned char* rowp = Q + (size_t)(row0 + ai * HALF + m * 16) * 2048 + u.pn * BM + colt;
#pragma unroll
                for (int bj = 0; bj < 2; ++bj) { const f32x4 v0 = acc[ai][bj][m][0], v1 = acc[ai][bj][m][1]; unsigned q[8];
#pragma unroll
                    for (int j = 0; j < 4; ++j) { q[j] = (unsigned)(255.0f * sigmoidf_fast(v0[j] + b[bj][j]) + 0.5f); q[4 + j] = (unsigned)(255.0f * sigmoidf_fast(v1[j] + b[bj][4 + j]) + 0.5f); }
                    u32x2 w; w.x = q[0] | (q[1] << 8) | (q[2] << 16) | (q[3] << 24); w.y = q[4] | (q[5] << 8) | (q[6] << 16) | (q[7] << 24);
                    *(u32x2*)(rowp + bj * HALF) = w; } }
    }
};
struct EpiSwiGLU {
    static constexpr bool PERM = true, AFTER_DRAIN = false, SEGMENTED = false;
    bf16_t* O; int ldc; PG8_LAS unsigned* mx;
    __device__ __forceinline__ void operator()(const f32x4 (&acc)[2][2][4][2], const Unit& u, int wr, int wc, int fr, int fq) const {
        const int row0 = u.pm * BM + wr * 64 + fr, col0 = u.pn * HALF + wc * 32 + 8 * fq;
        float lm = 0.f;
#pragma unroll
        for (int ai = 0; ai < 2; ++ai)
#pragma unroll
            for (int m = 0; m < 4; ++m) { bf16_t* rowp = O + (size_t)(row0 + ai * HALF + m * 16) * ldc + col0;
                float r[8];
#pragma unroll
                for (int n = 0; n < 2; ++n)
#pragma unroll
                    for (int j = 0; j < 4; ++j) { const float g = acc[ai][0][m][n][j], up = acc[ai][1][m][n][j]; r[n * 4 + j] = g * sigmoidf_fast(g) * up; }
                if (mx) {
#pragma unroll
                    for (int k = 0; k < 8; ++k) lm = fmaxf(lm, fabsf(r[k])); }
                u32x4 w; w.x = cvt_pk_bf16(r[0], r[1]); w.y = cvt_pk_bf16(r[2], r[3]); w.z = cvt_pk_bf16(r[4], r[5]); w.w = cvt_pk_bf16(r[6], r[7]);
                *(u32x4*)rowp = w; }
        if (mx) {
#pragma unroll
            for (int o = 1; o < 64; o <<= 1) lm = fmaxf(lm, __shfl_xor(lm, o));
            if ((fr | fq) == 0) __hip_atomic_fetch_max(mx, __float_as_uint(lm), __ATOMIC_RELAXED, __HIP_MEMORY_SCOPE_WORKGROUP);
            asm volatile("s_waitcnt lgkmcnt(0)" ::: "memory"); }
    }
};
__device__ __forceinline__ unsigned cvt_pk4_fp8(float a, float b, float c, float d) { int w = 0; w = __builtin_amdgcn_cvt_pk_fp8_f32(a, b, w, false); w = __builtin_amdgcn_cvt_pk_fp8_f32(c, d, w, true); return (unsigned)w; }
struct EpiSwiGLU8 {
    static constexpr bool PERM = true, AFTER_DRAIN = false, SEGMENTED = false;
    bf16_t* O; int ldc; float sc; unsigned char* O8; float s8; PG8_LAS unsigned* mx;
    __device__ __forceinline__ void operator()(const f32x4 (&acc)[2][2][4][2], const Unit& u, int wr, int wc, int fr, int fq) const {
        const int row0 = u.pm * BM + wr * 64 + fr, col0 = u.pn * HALF + wc * 32 + 8 * fq;
        float lm = 0.f;
#pragma unroll
        for (int ai = 0; ai < 2; ++ai)
#pragma unroll
            for (int m = 0; m < 4; ++m) { const size_t ro = (size_t)(row0 + ai * HALF + m * 16) * ldc + col0;
                float r[8];
#pragma unroll
                for (int n = 0; n < 2; ++n)
#pragma unroll
                    for (int j = 0; j < 4; ++j) { const float g = acc[ai][0][m][n][j] * sc, up = acc[ai][1][m][n][j] * sc; r[n * 4 + j] = g * sigmoidf_fast(g) * up; }
#pragma unroll
                for (int k = 0; k < 8; ++k) lm = fmaxf(lm, fabsf(r[k]));
                if (O8) {
#pragma unroll
                    for (int k = 0; k < 8; ++k) r[k] = __builtin_amdgcn_fmed3f(r[k] * s8, -448.0f, 448.0f);
                    u32x2 w; w.x = cvt_pk4_fp8(r[0], r[1], r[2], r[3]); w.y = cvt_pk4_fp8(r[4], r[5], r[6], r[7]); *(u32x2*)(O8 + ro) = w; }
                else {
                    u32x4 w; w.x = cvt_pk_bf16(r[0], r[1]); w.y = cvt_pk_bf16(r[2], r[3]); w.z = cvt_pk_bf16(r[4], r[5]); w.w = cvt_pk_bf16(r[6], r[7]);
                    *(u32x4*)(O + ro) = w; } }
        if (mx) {
#pragma unroll
            for (int o = 1; o < 64; o <<= 1) lm = fmaxf(lm, __shfl_xor(lm, o));
            if ((fr | fq) == 0) __hip_atomic_fetch_max(mx, __float_as_uint(lm), __ATOMIC_RELAXED, __HIP_MEMORY_SCOPE_WORKGROUP);
            asm volatile("s_waitcnt lgkmcnt(0)" ::: "memory"); }
    }
};
struct EpiRaw8 {
    static constexpr bool PERM = true, AFTER_DRAIN = false, SEGMENTED = false;
    bf16_t* O; int ldc; float sc;
    __device__ __forceinline__ void operator()(const f32x4 (&acc)[2][2][4][2], const Unit& u, int wr, int wc, int fr, int fq) const {
        const int row0 = u.pm * BM + wr * 64 + fr, col0 = u.pn * BM + wc * 32 + 8 * fq;
#pragma unroll
        for (int ai = 0; ai < 2; ++ai)
#pragma unroll
            for (int m = 0; m < 4; ++m) { bf16_t* rowp = O + (size_t)(row0 + ai * HALF + m * 16) * ldc + col0;
#pragma unroll
                for (int bj = 0; bj < 2; ++bj) { const f32x4 v0 = acc[ai][bj][m][0] * sc, v1 = acc[ai][bj][m][1] * sc;
                    u32x4 w; w.x = cvt_pk_bf16(v0[0], v0[1]); w.y = cvt_pk_bf16(v0[2], v0[3]); w.z = cvt_pk_bf16(v1[0], v1[1]); w.w = cvt_pk_bf16(v1[2], v1[3]);
                    *(u32x4*)(rowp + bj * HALF) = w; } }
    }
};
struct GateOrder : StaticOrder {
    __device__ __forceinline__ const char* pa(const Gemm& g, const Unit& u, size_t tstep) const { return (const char*)g.A + (size_t)(u.pn >> 1) * 512 + (size_t)u.pm * tstep; }
};
struct BranchOrder : StaticOrder {
    size_t astride, bstride;
    __device__ __forceinline__ bool next(int i, Unit& u) const { const int ti = i / 3, sg = i - 3 * ti; if (!StaticOrder::next(ti, u)) return false; u.seg = sg; return true; }
    __device__ __forceinline__ const char* pa(const Gemm& g, const Unit& u, size_t tstep) const { return (const char*)g.A + (size_t)u.seg * astride + (size_t)u.pm * tstep; }
    __device__ __forceinline__ const char* pb(const Gemm& g, const Unit& u, size_t tstep) const { return (const char*)g.Bt + (size_t)u.seg * bstride + (size_t)u.pn * tstep; }
};
__device__ __forceinline__ float ub0(unsigned w) { return (float)(w & 0xFFu); }
__device__ __forceinline__ float ub1(unsigned w) { return (float)((w >> 8) & 0xFFu); }
__device__ __forceinline__ float ub2(unsigned w) { return (float)((w >> 16) & 0xFFu); }
__device__ __forceinline__ float ub3(unsigned w) { return (float)(w >> 24); }
struct EpiBranchFused {
    static constexpr bool PERM = true, AFTER_DRAIN = false, SEGMENTED = true;
    const unsigned char* Q; bf16_t* MO; int ld;
    __device__ __forceinline__ void operator()(f32x4 (&acc)[2][2][4][2], const Unit& u, int wr, int wc, int fr, int fq) const {
        const int row0 = u.pm * BM + wr * 64 + fr, col0 = u.pn * BM + wc * 32 + 8 * fq; const int sg = u.seg; const bool fin = sg == 2;
        const unsigned char* qn = Q + (size_t)row0 * 6144 + sg * 2048 + col0; const unsigned char* qd = fin ? qn : qn + 2048;
        u32x2 gn[2][4][2], gd[2][4][2];
#define BR_LOAD(ai_) do { _Pragma("unroll") for (int m = 0; m < 4; ++m) _Pragma("unroll") for (int bj = 0; bj < 2; ++bj) { const size_t go = (size_t)((ai_) * HALF + m * 16) * 6144 + bj * HALF; \
            gn[ai_][m][bj] = *(const u32x2*)(qn + go); gd[ai_][m][bj] = *(const u32x2*)(qd + go); } } while (0)
        BR_LOAD(0); BR_LOAD(1);
#pragma unroll
        for (int ai = 0; ai < 2; ++ai) {
#pragma unroll
            for (int m = 0; m < 4; ++m)
#pragma unroll
                for (int bj = 0; bj < 2; ++bj) { const u32x2 a = gn[ai][m][bj], d = gd[ai][m][bj];
                    const float an[8] = {ub0(a.x), ub1(a.x), ub2(a.x), ub3(a.x), ub0(a.y), ub1(a.y), ub2(a.y), ub3(a.y)};
                    const float dn[8] = {ub0(d.x), ub1(d.x), ub2(d.x), ub3(d.x), ub0(d.y), ub1(d.y), ub2(d.y), ub3(d.y)};
                    float f[8];
#pragma unroll
                    for (int k = 0; k < 8; ++k) { const float rd = __builtin_amdgcn_rcpf(dn[k]); f[k] = an[k] * (fin ? (1.0f / 255.0f) : rd); }
                    f32x4 v0 = acc[ai][bj][m][0], v1 = acc[ai][bj][m][1];
                    v0[0] *= f[0]; v0[1] *= f[1]; v0[2] *= f[2]; v0[3] *= f[3]; v1[0] *= f[4]; v1[1] *= f[5]; v1[2] *= f[6]; v1[3] *= f[7];
                    acc[ai][bj][m][0] = v0; acc[ai][bj][m][1] = v1;
                    if (fin) { u32x4 w; w.x = cvt_pk_bf16(v0[0], v0[1]); w.y = cvt_pk_bf16(v0[2], v0[3]); w.z = cvt_pk_bf16(v1[0], v1[1]); w.w = cvt_pk_bf16(v1[2], v1[3]);
                        *(u32x4*)(MO + (size_t)(row0 + ai * HALF + m * 16) * ld + col0 + bj * HALF) = w; } }
        }
#undef BR_LOAD
    }
};

typedef int i32x4 __attribute__((ext_vector_type(4))); typedef int i32x8 __attribute__((ext_vector_type(8)));
__device__ __forceinline__ i32x8 cat8(const bf16x8 a, const bf16x8 b) { const i32x4 x = __builtin_bit_cast(i32x4, a), y = __builtin_bit_cast(i32x4, b); return __builtin_shufflevector(x, y, 0, 1, 2, 3, 4, 5, 6, 7); }
__device__ __forceinline__ void mfma_fp8_acc(f32x4& acc, const i32x8 b, const i32x8 a) { asm volatile("v_mfma_f32_16x16x128_f8f6f4 %0, %1, %2, %0" : "+v"(acc) : "v"(b), "v"(a)); }
template <class Epi, class Sched, bool ALIGN_EPI = false, bool SP2 = false, int LDA = 0  , bool FP8 = false>
__device__ __forceinline__ void gemm_phase(PG8_LAS unsigned char* lds, const Gemm g, const Sched& S, const Epi& E) {
    int tid_l = threadIdx.x; asm volatile("" : "+v"(tid_l)); const int tid = tid_l, wid = __builtin_amdgcn_readfirstlane(tid >> 6), lane = tid & 63, wr = wid >> 2, wc = wid & 3, fr = lane & 15, fq = lane >> 4;
    const int K = g.K, nt = K / BK;
    unsigned voffA[2], voffB[2];
#pragma unroll
    for (int i = 0; i < 2; ++i) { int R, C; stage_rc(tid * 16 + i * 8192, R, C); const int Rb = Epi::PERM ? ((R & ~31) + perm32(R & 31)) : R;
        voffA[i] = (unsigned)(R * (LDA ? LDA : K) + C) * 2u; voffB[i] = (unsigned)(Rb * K + C) * 2u; }
    const size_t kstep = (size_t)(BK * 2);
    const size_t hstepB = (size_t)HALF * K * 2, hstepA = LDA ? (size_t)HALF * LDA * 2 : hstepB;
    const size_t tstepA = 2 * hstepA, tstepB = 2 * hstepB;
    const unsigned ldsw = (unsigned)wid * 1024u;
    const int aoff = lds_byte(wr * 64 + fr, fq * 8), boff = lds_byte(wc * 32 + fr, fq * 8);
#define PG8_SA(b, h) (((b) * 2 + (h)) * HTB)
#define PG8_SB(b, h) ((4 + (b) * 2 + (h)) * HTB)
#define PG8_STAGE(bufoff, gbase, voff) do { _Pragma("unroll") for (int _i = 0; _i < 2; ++_i) \
        __builtin_amdgcn_global_load_lds((const unsigned*)((const char*)(gbase) + (voff)[_i]), (PG8_LAS unsigned*)(lds + (bufoff) + ldsw + _i * 8192), 16, 0, 0); } while (0)
#define PG8_LDA(dst, b, h) do { _Pragma("unroll") for (int m = 0; m < 4; ++m) _Pragma("unroll") for (int k = 0; k < 2; ++k) dst[m][k] = *(const PG8_LAS bf16x8*)(lds + PG8_SA(b, h) + aoff + m * 2048 + k * 1024); } while (0)
#define PG8_LDB(dst, b, h) do { _Pragma("unroll") for (int n = 0; n < 2; ++n) _Pragma("unroll") for (int k = 0; k < 2; ++k) dst[n][k] = *(const PG8_LAS bf16x8*)(lds + PG8_SB(b, h) + boff + n * 2048 + k * 1024); } while (0)
#define PG8_MMA(ai, bj, At, Bt) do { __builtin_amdgcn_s_setprio(1); _Pragma("unroll") for (int m = 0; m < 4; ++m) _Pragma("unroll") for (int n = 0; n < 2; ++n) { \
        if constexpr (FP8) mfma_fp8_acc(acc[ai][bj][m][n], cat8(Bt[n][0], Bt[n][1]), cat8(At[m][0], At[m][1])); \
        else { _Pragma("unroll") for (int k = 0; k < 2; ++k) acc[ai][bj][m][n] = __builtin_amdgcn_mfma_f32_16x16x32_bf16(Bt[n][k], At[m][k], acc[ai][bj][m][n], 0, 0, 0); } } __builtin_amdgcn_s_setprio(0); } while (0)
#define PG8_WAIT_V(n) asm volatile("s_waitcnt vmcnt(" #n ")" ::: "memory")
#define PG8_WAIT_L(n) asm volatile("s_waitcnt lgkmcnt(" #n ")" ::: "memory")
#define PG8_BAR __builtin_amdgcn_s_barrier()
#define PG8_SCHED __builtin_amdgcn_sched_barrier(0)
    Unit cur, nxt; int ui = 0;
    if (!S.next(0, cur)) return;
    f32x4 acc[2][2][4][2];
#pragma unroll
    for (int a = 0; a < 2; ++a)
#pragma unroll
        for (int b = 0; b < 2; ++b)
#pragma unroll
            for (int m = 0; m < 4; ++m)
#pragma unroll
                for (int n = 0; n < 2; ++n) acc[a][b][m][n] = (f32x4){0.f, 0.f, 0.f, 0.f};
    bf16x8 At[4][2], B0[2][2], B1[2][2];
    const char* cA = S.pa(g, cur, tstepA); const char* cB = S.pb(g, cur, tstepB);
    S.a_ready(cur);
    if constexpr (SP2) {
        PG8_STAGE(PG8_SB(0, 0), cB, voffB); PG8_STAGE(PG8_SB(0, 1), cB + hstepB, voffB); PG8_STAGE(PG8_SA(0, 0), cA, voffA); PG8_STAGE(PG8_SA(0, 1), cA + hstepA, voffA);
        if (wr == 1) PG8_BAR;
        PG8_WAIT_V(2); PG8_BAR;
        PG8_STAGE(PG8_SB(1, 0), cB + kstep, voffB); PG8_STAGE(PG8_SA(1, 0), cA + kstep, voffA); PG8_STAGE(PG8_SB(1, 1), cB + hstepB + kstep, voffB);
        PG8_WAIT_V(6); PG8_BAR;
    } else {
        PG8_STAGE(PG8_SB(0, 0), cB, voffB); PG8_STAGE(PG8_SA(0, 0), cA, voffA); PG8_STAGE(PG8_SB(0, 1), cB + hstepB, voffB); PG8_STAGE(PG8_SA(0, 1), cA + hstepA, voffA);
        if (wr == 1) PG8_BAR;
        PG8_WAIT_V(4); PG8_BAR;
        PG8_STAGE(PG8_SB(1, 0), cB + kstep, voffB); PG8_STAGE(PG8_SA(1, 0), cA + kstep, voffA); PG8_STAGE(PG8_SB(1, 1), cB + hstepB + kstep, voffB);
        PG8_WAIT_V(6); PG8_BAR;
    }
    for (;;) {
        const bool has_next = S.next(ui + 1, nxt);
        const char* nA = has_next ? S.pa(g, nxt, tstepA) : cA; const char* nB = has_next ? S.pb(g, nxt, tstepB) : cB;
        for (int t = 0; t < nt; t += 2) {
            const bool last = (t == nt - 2);
            const char* a1 = cA + (size_t)(t + 1) * kstep;
            const char* a2 = last ? nA : cA + (size_t)(t + 2) * kstep; const char* b2 = last ? nB : cB + (size_t)(t + 2) * kstep;
            const char* a3 = a2 + kstep; const char* b3 = b2 + kstep;
            if (last && has_next) S.a_ready(nxt);
            if constexpr (SP2) {
            PG8_LDB(B0, 0, 0); PG8_LDB(B1, 0, 1); PG8_SCHED; PG8_LDA(At, 0, 0); PG8_STAGE(PG8_SA(1, 1), a1 + hstepA, voffA);
            PG8_WAIT_V(8); PG8_WAIT_L(0); PG8_BAR; PG8_MMA(0, 0, At, B0); PG8_MMA(0, 1, At, B1); PG8_BAR; PG8_SCHED;
            PG8_LDA(At, 0, 1); PG8_STAGE(PG8_SB(0, 0), b2, voffB); PG8_STAGE(PG8_SB(0, 1), b2 + hstepB, voffB); PG8_STAGE(PG8_SA(0, 0), a2, voffA);
            PG8_WAIT_V(8); PG8_WAIT_L(0); PG8_BAR; PG8_MMA(1, 0, At, B0); PG8_MMA(1, 1, At, B1); PG8_BAR; PG8_SCHED;
            PG8_LDB(B0, 1, 0); PG8_LDB(B1, 1, 1); PG8_SCHED; PG8_LDA(At, 1, 0); PG8_STAGE(PG8_SA(0, 1), a2 + hstepA, voffA);
            PG8_WAIT_V(8); PG8_WAIT_L(0); PG8_BAR; PG8_MMA(0, 0, At, B0); PG8_MMA(0, 1, At, B1); PG8_BAR; PG8_SCHED;
            PG8_LDA(At, 1, 1); PG8_STAGE(PG8_SB(1, 0), b3, voffB); PG8_STAGE(PG8_SB(1, 1), b3 + hstepB, voffB); PG8_STAGE(PG8_SA(1, 0), a3, voffA);
            PG8_WAIT_V(8); PG8_WAIT_L(0); PG8_BAR; PG8_MMA(1, 0, At, B0); PG8_MMA(1, 1, At, B1); PG8_BAR; PG8_SCHED;
            } else {
            PG8_LDB(B0, 0, 0); PG8_SCHED; PG8_LDA(At, 0, 0); PG8_STAGE(PG8_SA(1, 1), a1 + hstepA, voffA);
            PG8_WAIT_L(8); PG8_BAR; PG8_WAIT_L(0); PG8_MMA(0, 0, At, B0); PG8_BAR; PG8_SCHED;
            PG8_LDB(B1, 0, 1); PG8_STAGE(PG8_SB(0, 0), b2, voffB);
            PG8_BAR; PG8_WAIT_L(0); PG8_MMA(0, 1, At, B1); PG8_BAR;
            PG8_LDA(At, 0, 1); PG8_STAGE(PG8_SA(0, 0), a2, voffA);
            PG8_BAR; PG8_WAIT_L(0); PG8_MMA(1, 0, At, B0); PG8_BAR; PG8_SCHED;
            PG8_STAGE(PG8_SB(0, 1), b2 + hstepB, voffB);
            PG8_WAIT_V(6); PG8_BAR; PG8_MMA(1, 1, At, B1); PG8_BAR;
            PG8_LDB(B0, 1, 0); PG8_SCHED; PG8_LDA(At, 1, 0); PG8_STAGE(PG8_SA(0, 1), a2 + hstepA, voffA);
            PG8_WAIT_L(8); PG8_BAR; PG8_WAIT_L(0); PG8_MMA(0, 0, At, B0); PG8_BAR; PG8_SCHED;
            PG8_LDB(B1, 1, 1); PG8_STAGE(PG8_SB(1, 0), b3, voffB);
            PG8_BAR; PG8_WAIT_L(0); PG8_MMA(0, 1, At, B1); PG8_BAR;
            PG8_LDA(At, 1, 1); PG8_STAGE(PG8_SA(1, 0), a3, voffA);
            PG8_BAR; PG8_WAIT_L(0); PG8_MMA(1, 0, At, B0); PG8_BAR; PG8_SCHED;
            PG8_STAGE(PG8_SB(1, 1), b3 + hstepB, voffB);
            PG8_WAIT_V(6); PG8_BAR; PG8_MMA(1, 1, At, B1); PG8_BAR;
            }
        }
        if constexpr (ALIGN_EPI) { if (wr == 0) PG8_BAR; }
        if constexpr (FP8) asm volatile("s_nop 15\n\ts_nop 15" ::: "memory");
        if constexpr (!Epi::AFTER_DRAIN) { E(acc, cur, wr, wc, fr, fq); S.done(cur); }
        if (!has_next) break;
        if (!Epi::SEGMENTED || cur.seg == 2)
#pragma unroll
        for (int a = 0; a < 2; ++a)
#pragma unroll
            for (int b = 0; b < 2; ++b)
#pragma unroll
                for (int m = 0; m < 4; ++m)
#pragma unroll
                    for (int n = 0; n < 2; ++n) acc[a][b][m][n] = (f32x4){0.f, 0.f, 0.f, 0.f};
        cur = nxt; cA = nA; cB = nB; ++ui;
        if constexpr (ALIGN_EPI) { if (wr == 1) PG8_BAR; }
    }
    PG8_WAIT_V(0);
    if constexpr (!ALIGN_EPI) { if (wr == 0) PG8_BAR; }
    PG8_BAR;
    if constexpr (Epi::AFTER_DRAIN) { E.fused(acc, cur, wr, wc, fr, fq, lds, wid, lane); S.done(cur); }
#undef PG8_SA
#undef PG8_SB
#undef PG8_STAGE
#undef PG8_LDA
#undef PG8_LDB
#undef PG8_MMA
#undef PG8_WAIT_V
#undef PG8_WAIT_L
#undef PG8_BAR
#undef PG8_SCHED
}
}

constexpr int NWAVES = 8;
constexpr int M = 16384, D = 2048, FF = 5632, SEQ = 8192, NL = 4;
constexpr int IN_W = 15376, NIN = 15360, PW = 9216;
constexpr int P_AX = 0, P_AG = 1024, P_BQ = 2048, P_BK = 2560, P_BV = 3072, P_BG = 4096, P_CQ = 5120, P_CF = 6144, P_CI = 7168, P_CG = 8192, P_MG = 9216;
#ifndef H_PITCH
#define H_PITCH 2048
#endif
constexpr int HP = H_PITCH;
constexpr float EPS = 1e-6f;
constexpr size_t MiB = 1u << 20;
constexpr size_t WS_CTL = 0, CTL_ZERO_BYTES = 1 * MiB;
constexpr size_t WS_LB = 1 * MiB;
constexpr size_t WS_CA = 2 * MiB, WS_CH = 3 * MiB, WS_HIN = 4 * MiB, WS_LDT = 5 * MiB;
constexpr size_t WS_W = 8 * MiB, WL_STRIDE = 217 * MiB;
constexpr size_t WL_GU1 = 0, WL_D1 = 44 * MiB, WL_IN = 66 * MiB, WL_GT = 127 * MiB, WL_BR = 131 * MiB, WL_OUT = 143 * MiB, WL_GU2 = 151 * MiB, WL_D2 = 195 * MiB;
constexpr size_t WS_MGQ = (1068 + 288) * MiB;
constexpr size_t WS_XH = 940 * MiB, WS_XL = 1004 * MiB;
constexpr size_t WS_H = 876 * MiB, WS_Y = (1068 + 256) * MiB  , WS_P = 1068 * MiB, WS_YA = 1556 * MiB, WS_YB = 1588 * MiB, WS_YC = 1620 * MiB, WS_XC = 1652 * MiB, WS_GT = 1684 * MiB, WS_MG = 1748 * MiB, WS_SLOC = 1812 * MiB, WS_GG = 1844 * MiB, WS_SIN = 1876 * MiB, WS_END = 1908 * MiB;
static_assert(WS_W + 4 * WL_STRIDE <= WS_H && WS_P + (size_t)M * PW * 2 <= WS_YA, "ws map");
constexpr int CW_TMO = 0, CW_CODE = 1, CW_WMAX = 64  , CW_SMAX = CW_WMAX + 16  , CW_BAR = 4096;
constexpr size_t WS_H8 = 1036 * MiB;
constexpr int RING_OFF = 0, RING_BYTES = 131072;
constexpr int LDSCTL_OFF = 149504, MISC_OFF = LDSCTL_OFF + 320;
constexpr int LDS_BYTES = 155648;

#define GAS __attribute__((address_space(1)))
#define LAS __attribute__((address_space(3)))
typedef unsigned short bf16;
typedef unsigned v4u __attribute__((ext_vector_type(4)));
typedef unsigned v2u __attribute__((ext_vector_type(2)));
typedef float f32x4 __attribute__((ext_vector_type(4)));
typedef float f32x2 __attribute__((ext_vector_type(2)));
typedef GAS unsigned gu32;
static_assert(FP8_F2_S0 >= FP8_S0 && FP8_F2_S0 >= 1 && FP8_S0 <= 2 * NL, "fp8 down GEMM: its input comes from an fp8 gate|up step; the half-step before it collects max |ACT|");
__host__ __device__ constexpr int SL_GU(int s) { return 4 + s - FP8_S0; }
__host__ __device__ constexpr int SL_DN(int s) { return 4 + (2 * NL - FP8_S0) + (s - FP8_F2_S0); }
__host__ __device__ constexpr int SL_ACT(int s) { return 4 + (2 * NL - FP8_S0) + (2 * NL - FP8_F2_S0) + (s - FP8_F2_S0); }
static_assert(SL_ACT(2 * NL) <= 16, "control-word slots");
#define RLX_AGENT __ATOMIC_RELAXED, __HIP_MEMORY_SCOPE_AGENT
#define LDS_WAIT() asm volatile("s_waitcnt lgkmcnt(0)" ::: "memory")
#define VM_WAIT() asm volatile("s_waitcnt vmcnt(0)" ::: "memory")
typedef float f32x2_t __attribute__((ext_vector_type(2))); typedef __bf16 bf16x2_t __attribute__((ext_vector_type(2)));
__device__ __forceinline__ unsigned pk2(float lo, float hi) { f32x2_t v = {lo, hi}; bf16x2_t b = __builtin_convertvector(v, bf16x2_t); return __builtin_bit_cast(unsigned, b); }
__device__ __forceinline__ unsigned f2bf(float f) { return pk2(f, 0.f) & 0xffffu; }
__device__ __forceinline__ float bf2f(unsigned short b) { return __uint_as_float(((unsigned)b) << 16); }
__device__ __forceinline__ float blo(unsigned w) { return __uint_as_float(w << 16); }
__device__ __forceinline__ float bhi(unsigned w) { return __uint_as_float(w & 0xffff0000u); }
__device__ __forceinline__ float fexp(float x) { return __builtin_amdgcn_exp2f(1.44269504089f * x); }
__device__ __forceinline__ float flog(float x) { return 0.69314718056f * __builtin_amdgcn_logf(x); }
__device__ __forceinline__ float frcp(float x) { return __builtin_amdgcn_rcpf(x); }
__device__ __forceinline__ float sigm(float x) { return frcp(1.0f + __builtin_amdgcn_exp2f(-1.44269504089f * x)); }
__device__ __forceinline__ float log_sigm(float x) { return fminf(x, 0.f) - flog(1.0f + fexp(-fabsf(x))); }
__device__ __forceinline__ float gelu_tanh(float x) { const float u = 0.7978845608028654f * (x + 0.044715f * x * x * x); const float t = 1.0f - 2.0f * frcp(fexp(2.0f * u) + 1.0f); return 0.5f * x * (1.0f + t); }
__device__ __forceinline__ float neg_expm1(float x, float ex) { const float ser = -x * (1.0f + x * (0.5f + x * (0.16666667f + x * (0.041666668f + x * 0.0083333338f)))); return x > -0.1f ? ser : 1.0f - ex; }

#define XB_TMO      128
#define XB_XCNT(j)  (256  + 64 * (j))
#define XB_XSUB(j)  (1280 + 64 * (j))
#define XB_XGEN(j)  (2304 + 64 * (j))
#define XB_TOP      3328
#define XB_TOPGEN   3392
#define XCD_BAR_WORDS 3456
#define XB_SPIN_CAP (1u << 18)

__device__ __forceinline__ unsigned xb_ld(unsigned* p)              { return __hip_atomic_load(p, __ATOMIC_RELAXED, __HIP_MEMORY_SCOPE_AGENT); }
__device__ __forceinline__ unsigned xb_add(unsigned* p, unsigned v) { return __hip_atomic_fetch_add(p, v, __ATOMIC_RELAXED, __HIP_MEMORY_SCOPE_AGENT); }
__device__ __forceinline__ unsigned xb_xcc_id() { return (unsigned)__builtin_amdgcn_s_getreg((3 << 11) | 20) & 0xFu; }
#define XB_SPIN(cond, bar) do { unsigned _sp = 0; while (cond) { __builtin_amdgcn_s_sleep(1); \
    if ((++_sp & 255u) == 0u) { if (xb_ld(&(bar)[XB_TMO])) break; if (_sp > XB_SPIN_CAP) { atomicAdd(&(bar)[XB_TMO], 1u); break; } } } } while (0)

struct XcdBarrier {
    unsigned* bar; unsigned x;
    volatile LAS unsigned* st;
};

__device__ __forceinline__ XcdBarrier xcd_barrier_post(unsigned* bar, volatile LAS unsigned* st) {
    XcdBarrier b; b.bar = bar; b.x = xb_xcc_id(); b.st = st;
    if (threadIdx.x == 0) (void)xb_add(&bar[XB_XCNT(b.x)], 1u);
    return b;
}
__device__ __forceinline__ void xcd_barrier_complete(unsigned* bar, unsigned x, unsigned& nloc, unsigned& nx) {
    const unsigned G = gridDim.x * gridDim.y * gridDim.z;
    unsigned sum, cnt, mine, sp = 0u;
    for (;;) {
        sum = 0u; cnt = 0u; mine = 0u;
#pragma unroll
        for (unsigned j = 0; j < 16; ++j) { const unsigned c = xb_ld(&bar[XB_XCNT(j)]); sum += c; cnt += (c > 0u) ? 1u : 0u; mine = (j == x) ? c : mine; }
        if (sum == G) break;
        __builtin_amdgcn_s_sleep(1);
        if ((++sp & 255u) == 0u) { if (xb_ld(&bar[XB_TMO])) break; if (sp > XB_SPIN_CAP) { atomicAdd(&bar[XB_TMO], 1u); break; } }
    }
    nloc = mine > 0u ? mine : 1u; nx = cnt > 0u ? cnt : 1u;
}

__device__ __forceinline__ void xcd_barrier(const XcdBarrier& b) {
    asm volatile("s_waitcnt vmcnt(0)" ::: "memory");
    __syncthreads();
    if (threadIdx.x == 0) {
        unsigned* bar = b.bar;
        __builtin_amdgcn_s_waitcnt(0);
        unsigned nloc = b.st[0], nx = b.st[1];
        if (nloc == 0u) { xcd_barrier_complete(bar, b.x, nloc, nx); b.st[0] = nloc; b.st[1] = nx; }
        const unsigned old = xb_add(&bar[XB_XSUB(b.x)], 1u);
        const unsigned gen = old / nloc;
        if (old + 1u == (gen + 1u) * nloc) {
            __builtin_amdgcn_fence(__ATOMIC_RELEASE, "agent");
            asm volatile("s_waitcnt vmcnt(0)" ::: "memory");
            const unsigned og = xb_add(&bar[XB_TOP], 1u);
            const unsigned tg = og / nx;
            if (og + 1u == (tg + 1u) * nx) xb_add(&bar[XB_TOPGEN], 1u);
            else XB_SPIN(xb_ld(&bar[XB_TOPGEN]) == tg, bar);
            __builtin_amdgcn_fence(__ATOMIC_ACQUIRE, "agent");
            xb_add(&bar[XB_XGEN(b.x)], 1u);
            asm volatile("s_waitcnt vmcnt(0)" ::: "memory");
        } else {
            XB_SPIN(xb_ld(&bar[XB_XGEN(b.x)]) == gen, bar);
            __builtin_amdgcn_fence(__ATOMIC_ACQUIRE, "agent");
            asm volatile("s_waitcnt vmcnt(0)" ::: "memory");
        }
    }
    __syncthreads();
}

struct Args { const float* in[30]; float* out; unsigned char* ws; int ph_lo, ph_hi; };
struct Frame {
    LAS unsigned char* lds;
    volatile LAS unsigned* MISC;
    gu32* ctl;
    int tid, lane, wave, vcu, G, bx;
};
__device__ __forceinline__ float wave_sum(float v) {
#pragma unroll
    for (int o = 1; o < 64; o <<= 1) v += __shfl_xor(v, o);
    return v;
}
__device__ __forceinline__ unsigned pk4_fp8(float a, float b, float c, float d) { int w = 0; w = __builtin_amdgcn_cvt_pk_fp8_f32(a, b, w, false); w = __builtin_amdgcn_cvt_pk_fp8_f32(c, d, w, true); return (unsigned)w; }
__device__ __forceinline__ float pow2_floor(float t) { return __uint_as_float(__float_as_uint(t) & 0x7F800000u); }
__device__ __forceinline__ float fp8_scale(float amax) { return pow2_floor(fminf(440.0f / fmaxf(amax, 1e-30f), 1.0e12f)); }
#ifndef FP8_HEAD
#define FP8_HEAD 8.0f
#endif
__device__ __forceinline__ bool wscale_ok(const unsigned char* ws, int slot) { const gu32* c = (const gu32*)(ws + WS_CTL);
    return __uint_as_float(c[CW_WMAX + slot]) * fp8_scale(FP8_HEAD * __uint_as_float(c[CW_SMAX + slot])) <= 448.0f; }
__device__ __forceinline__ float wscale(const unsigned char* ws, int slot) { const gu32* c = (const gu32*)(ws + WS_CTL);
    const float amax = __uint_as_float(c[CW_WMAX + slot]), s0 = fp8_scale(FP8_HEAD * __uint_as_float(c[CW_SMAX + slot])); return amax * s0 <= 448.0f ? s0 : fp8_scale(amax); }
__device__ __forceinline__ float h8_scale(const float* g, int ln) {
    float gm = 0.f;
#pragma unroll
    for (int j = 0; j < 4; ++j) { const f32x4 a = ((const GAS f32x4*)g)[2 * (64 * j + ln)], b = ((const GAS f32x4*)g)[2 * (64 * j + ln) + 1];
        gm = fmaxf(gm, fmaxf(fmaxf(fmaxf(fabsf(a.x), fabsf(a.y)), fmaxf(fabsf(a.z), fabsf(a.w))), fmaxf(fmaxf(fabsf(b.x), fabsf(b.y)), fmaxf(fabsf(b.z), fabsf(b.w))))); }
#pragma unroll
    for (int o = 1; o < 64; o <<= 1) gm = fmaxf(gm, __shfl_xor(gm, o));
    return fp8_scale(45.2548339959f * gm);
}
template <int MAP> __device__ __forceinline__ int dest_row(int n) {
    if (MAP == 1) return 256 * (n >> 7) + (n & 127);
    if (MAP == 2) return 256 * (n >> 7) + 128 + (n & 127);
    if (MAP == 3) return n < 5120 ? n : (n < 5136 ? 15360 + (n - 5120) : n - 16);
    if (MAP == 5) return n < 5120 ? n : (n < 5136 ? 15360 + (n - 5120) : n - 16);
    if (MAP == 4) return n - 9232;
    return n;
}
template <int MAP> __device__ __forceinline__ void p0_item(const float* W, int K, int N, bf16* WT, LAS float* scr, int item, int lane) {
    const int nblk = (N + 31) / 32, kb = item / nblk, nb = item % nblk, k0 = 64 * kb, n0 = 32 * nb;
    const int nn = n0 + (lane & 31); const bool okr = nn < N;
#pragma unroll
    for (int i = 0; i < 32; ++i) { const int kk = 2 * i + (lane >> 5); scr[kk * 33 + (lane & 31)] = okr ? W[(size_t)(k0 + kk) * N + nn] : 0.f; }
    LDS_WAIT(); asm volatile("" ::: "memory");
    const int c = lane & 7;
#pragma unroll
    for (int j = 0; j < 4; ++j) { const int n = (lane >> 3) + 8 * j; const LAS float* s = scr + (8 * c) * 33 + n;
        v4u o; o.x = pk2(s[0 * 33], s[1 * 33]); o.y = pk2(s[2 * 33], s[3 * 33]); o.z = pk2(s[4 * 33], s[5 * 33]); o.w = pk2(s[6 * 33], s[7 * 33]);
        if (n0 + n < N && !(MAP == 3 && n0 + n >= 9232)) __builtin_nontemporal_store(o, (GAS v4u*)(WT + (size_t)dest_row<MAP>(n0 + n) * K + k0 + 8 * c)); }
    LDS_WAIT(); asm volatile("" ::: "memory");
}
__device__ __forceinline__ float p0_absmax_item(const float* W, int K, int N, int item, int lane, int nmin) {
    (void)K; const int nblk = (N + 31) / 32, kb = item / nblk, nb = item % nblk, k0 = 64 * kb, n0 = 32 * nb;
    const int nn = n0 + (lane & 31); const bool okr = nn < N && nn >= nmin;
    float m = 0.f;
#pragma unroll
    for (int i = 0; i < 32; ++i) { const int kk = 2 * i + (lane >> 5); m = fmaxf(m, fabsf(okr ? W[(size_t)(k0 + kk) * N + nn] : 0.f)); }
    return m;
}
template <int MAP> __device__ __forceinline__ float p0_item8(const float* W, int K, int N, unsigned char* W8, LAS float* scr, int item, int lane, float sW) {
    const int nblk = (N + 31) / 32, kb = item / nblk, nb = item % nblk, k0 = 64 * kb, n0 = 32 * nb;
    const int nn = n0 + (lane & 31); const bool okr = nn < N;
    float mx = 0.f; const bool cnt = !(MAP == 4 && nn < 9232);
#pragma unroll
    for (int i = 0; i < 32; ++i) { const int kk = 2 * i + (lane >> 5); const float v = okr ? W[(size_t)(k0 + kk) * N + nn] : 0.f; scr[kk * 33 + (lane & 31)] = v; mx = fmaxf(mx, cnt ? fabsf(v) : 0.f); }
    LDS_WAIT(); asm volatile("" ::: "memory");
    const int c = lane & 7;
#pragma unroll
    for (int j = 0; j < 4; ++j) { const int n = (lane >> 3) + 8 * j; const LAS float* s = scr + (8 * c) * 33 + n;
        v2u o; o.x = pk4_fp8(s[0 * 33] * sW, s[1 * 33] * sW, s[2 * 33] * sW, s[3 * 33] * sW); o.y = pk4_fp8(s[4 * 33] * sW, s[5 * 33] * sW, s[6 * 33] * sW, s[7 * 33] * sW);
        if (n0 + n < N && !(MAP == 4 && n0 + n < 9232)) __builtin_nontemporal_store(o, (GAS v2u*)(W8 + (size_t)dest_row<MAP>(n0 + n) * K + k0 + 8 * c)); }
    LDS_WAIT(); asm volatile("" ::: "memory");
    return mx;
}
constexpr int NBLK_IN = (IN_W + 31) / 32, MG_N0 = IN_W - 6144  , MG_NB0 = MG_N0 / 32, I_MG = (D / 64) * (NBLK_IN - MG_NB0);
constexpr size_t WL_IN8 = 40 * MiB;
constexpr int I_GATE = (D / 64) * (FF / 32), I_DOWN = (FF / 64) * (D / 32), I_IN = (D / 64) * ((IN_W + 31) / 32), I_BR = (1024 / 64) * (D / 32), I_OUT = (D / 64) * (D / 32);
constexpr int I_LAYER = 2 * (2 * I_GATE + I_DOWN) + I_IN + 3 * I_BR + I_OUT;

__device__ __forceinline__ void x_pack8(const f32x4 va, const f32x4 vb, v4u& hi, v2u& lo) {
    unsigned r[8];
#pragma unroll
    for (int k = 0; k < 4; ++k) { const float fa = va[k], fb = vb[k]; const unsigned ua = __float_as_uint(fa), ub = __float_as_uint(fb);
        r[k] = (ua + 0x7Fu + ((ua >> 8) & 1u)) >> 8; r[4 + k] = (ub + 0x7Fu + ((ub >> 8) & 1u)) >> 8; }
    hi.x = (r[0] >> 8) | ((r[1] >> 8) << 16); hi.y = (r[2] >> 8) | ((r[3] >> 8) << 16); hi.z = (r[4] >> 8) | ((r[5] >> 8) << 16); hi.w = (r[6] >> 8) | ((r[7] >> 8) << 16);
    lo.x = (r[0] & 0xFFu) | ((r[1] & 0xFFu) << 8) | ((r[2] & 0xFFu) << 16) | (r[3] << 24); lo.y = (r[4] & 0xFFu) | ((r[5] & 0xFFu) << 8) | ((r[6] & 0xFFu) << 16) | (r[7] << 24);
}
__device__ __forceinline__ f32x4 x_unpack4(const unsigned h0, const unsigned h1, const unsigned lo) {
    f32x4 v; v.x = __uint_as_float((h0 << 16) | ((lo & 0xFFu) << 8)); v.y = __uint_as_float((h0 & 0xFFFF0000u) | (lo & 0xFF00u));
    v.z = __uint_as_float((h1 << 16) | ((lo >> 8) & 0xFF00u)); v.w = __uint_as_float((h1 & 0xFFFF0000u) | ((lo >> 16) & 0xFF00u)); return v;
}
__device__ __forceinline__ f32x4 bf4(const unsigned a, const unsigned b) { return (f32x4){blo(a), bhi(a), blo(b), bhi(b)}; }
__device__ __forceinline__ void rowpass(const Frame& F, const float* xin32, const unsigned short* xih, const unsigned char* xil, const bf16* Y, float* xo32, unsigned short* xoh, unsigned char* xol,
                                        const float* gpost, float scale, const float* gpre, bf16* H, unsigned char* H8 = nullptr) {
    const int gw = F.vcu * NWAVES + F.wave, NGW = F.G * NWAVES, ln = F.lane;
    const float s8 = H8 ? h8_scale(gpre, ln) : 0.f;
    f32x4 gq[8];
#pragma unroll
    for (int j = 0; j < 4; ++j) { gq[2 * j] = Y ? ((const GAS f32x4*)gpost)[2 * (64 * j + ln)] : (f32x4){0.f, 0.f, 0.f, 0.f}; gq[2 * j + 1] = Y ? ((const GAS f32x4*)gpost)[2 * (64 * j + ln) + 1] : (f32x4){0.f, 0.f, 0.f, 0.f}; }
    for (int m = gw; m < M; m += 2 * NGW) {
        const int m1 = m + NGW;
        f32x4 x0[8], x1[8];
        if (xin32) { const GAS f32x4* xr0 = (const GAS f32x4*)(xin32 + (size_t)m * D) + 2 * ln; const GAS f32x4* xr1 = (const GAS f32x4*)(xin32 + (size_t)m1 * D) + 2 * ln;
#pragma unroll
            for (int j = 0; j < 4; ++j) { x0[2 * j] = xr0[128 * j]; x0[2 * j + 1] = xr0[128 * j + 1]; x1[2 * j] = xr1[128 * j]; x1[2 * j + 1] = xr1[128 * j + 1]; } }
        else { const GAS v4u* h0 = (const GAS v4u*)(xih + (size_t)m * D) + ln; const GAS v4u* h1 = (const GAS v4u*)(xih + (size_t)m1 * D) + ln;
            const GAS v2u* l0 = (const GAS v2u*)(xil + (size_t)m * D) + ln; const GAS v2u* l1 = (const GAS v2u*)(xil + (size_t)m1 * D) + ln;
            v4u a0[4], a1[4]; v2u b0[4], b1[4];
#pragma unroll
            for (int j = 0; j < 4; ++j) { a0[j] = __builtin_nontemporal_load(h0 + 64 * j); a1[j] = __builtin_nontemporal_load(h1 + 64 * j); b0[j] = __builtin_nontemporal_load(l0 + 64 * j); b1[j] = __builtin_nontemporal_load(l1 + 64 * j); }
#pragma unroll
            for (int j = 0; j < 4; ++j) { x0[2 * j] = x_unpack4(a0[j].x, a0[j].y, b0[j].x); x0[2 * j + 1] = x_unpack4(a0[j].z, a0[j].w, b0[j].y); x1[2 * j] = x_unpack4(a1[j].x, a1[j].y, b1[j].x); x1[2 * j + 1] = x_unpack4(a1[j].z, a1[j].w, b1[j].y); } }
        if (Y) {
            const GAS v4u* yr0 = (const GAS v4u*)(Y + (size_t)m * D) + ln; const GAS v4u* yr1 = (const GAS v4u*)(Y + (size_t)m1 * D) + ln;
            v4u y0[4], y1[4]; float s0 = 0.f, s1 = 0.f;
#pragma unroll
            for (int j = 0; j < 4; ++j) { y0[j] = __builtin_nontemporal_load(yr0 + 64 * j); y1[j] = __builtin_nontemporal_load(yr1 + 64 * j); }
#pragma unroll
            for (int j = 0; j < 4; ++j) { const f32x4 a = bf4(y0[j].x, y0[j].y), b = bf4(y0[j].z, y0[j].w), c = bf4(y1[j].x, y1[j].y), d = bf4(y1[j].z, y1[j].w);
                s0 += ((a.x * a.x + a.y * a.y) + (a.z * a.z + a.w * a.w)) + ((b.x * b.x + b.y * b.y) + (b.z * b.z + b.w * b.w));
                s1 += ((c.x * c.x + c.y * c.y) + (c.z * c.z + c.w * c.w)) + ((d.x * d.x + d.y * d.y) + (d.z * d.z + d.w * d.w)); }
#pragma unroll
            for (int o = 1; o < 64; o <<= 1) { s0 += __shfl_xor(s0, o); s1 += __shfl_xor(s1, o); }
            const float r0 = scale * rsqrtf(s0 * (1.f / D) + EPS), r1 = scale * rsqrtf(s1 * (1.f / D) + EPS);
#pragma unroll
            for (int j = 0; j < 4; ++j) { x0[2 * j] = x0[2 * j] + bf4(y0[j].x, y0[j].y) * gq[2 * j] * r0; x0[2 * j + 1] = x0[2 * j + 1] + bf4(y0[j].z, y0[j].w) * gq[2 * j + 1] * r0;
                x1[2 * j] = x1[2 * j] + bf4(y1[j].x, y1[j].y) * gq[2 * j] * r1; x1[2 * j + 1] = x1[2 * j + 1] + bf4(y1[j].z, y1[j].w) * gq[2 * j + 1] * r1; }
            if (xo32) { GAS f32x4* xo0 = (GAS f32x4*)(xo32 + (size_t)m * D) + 2 * ln; GAS f32x4* xo1 = (GAS f32x4*)(xo32 + (size_t)m1 * D) + 2 * ln;
#pragma unroll
                for (int j = 0; j < 4; ++j) { xo0[128 * j] = x0[2 * j]; xo0[128 * j + 1] = x0[2 * j + 1]; xo1[128 * j] = x1[2 * j]; xo1[128 * j + 1] = x1[2 * j + 1]; } }
            else { GAS v4u* h0 = (GAS v4u*)(xoh + (size_t)m * D) + ln; GAS v4u* h1 = (GAS v4u*)(xoh + (size_t)m1 * D) + ln;
                GAS v2u* l0 = (GAS v2u*)(xol + (size_t)m * D) + ln; GAS v2u* l1 = (GAS v2u*)(xol + (size_t)m1 * D) + ln;
#pragma unroll
                for (int j = 0; j < 4; ++j) { v4u a; v2u b; x_pack8(x0[2 * j], x0[2 * j + 1], a, b); __builtin_nontemporal_store(a, h0 + 64 * j); __builtin_nontemporal_store(b, l0 + 64 * j); x_pack8(x1[2 * j], x1[2 * j + 1], a, b); __builtin_nontemporal_store(a, h1 + 64 * j); __builtin_nontemporal_store(b, l1 + 64 * j); } }
        }
        if (H || H8) {
            float s0 = 0.f, s1 = 0.f;
#pragma unroll
            for (int j = 0; j < 8; ++j) { s0 += (x0[j].x * x0[j].x + x0[j].y * x0[j].y) + (x0[j].z * x0[j].z + x0[j].w * x0[j].w); s1 += (x1[j].x * x1[j].x + x1[j].y * x1[j].y) + (x1[j].z * x1[j].z + x1[j].w * x1[j].w); }
#pragma unroll
            for (int o = 1; o < 64; o <<= 1) { s0 += __shfl_xor(s0, o); s1 += __shfl_xor(s1, o); }
            const float r0 = rsqrtf(s0 * (1.f / D) + EPS), r1 = rsqrtf(s1 * (1.f / D) + EPS);
            GAS v4u* ho0 = (GAS v4u*)(H + (size_t)m * HP) + ln; GAS v4u* ho1 = (GAS v4u*)(H + (size_t)m1 * HP) + ln;
#pragma unroll
            for (int j = 0; j < 4; ++j) { const f32x4 ga = ((const GAS f32x4*)gpre)[2 * (64 * j + ln)], gb = ((const GAS f32x4*)gpre)[2 * (64 * j + ln) + 1];
                const f32x4 a = x0[2 * j] * ga * r0, b = x0[2 * j + 1] * gb * r0, c = x1[2 * j] * ga * r1, d = x1[2 * j + 1] * gb * r1;
                if (H) { ho0[64 * j] = (v4u){pk2(a.x, a.y), pk2(a.z, a.w), pk2(b.x, b.y), pk2(b.z, b.w)}; ho1[64 * j] = (v4u){pk2(c.x, c.y), pk2(c.z, c.w), pk2(d.x, d.y), pk2(d.z, d.w)}; }
                if (H8) { const f32x4 a8 = a * s8, b8 = b * s8, c8 = c * s8, d8 = d * s8;
                    ((GAS v2u*)(H8 + (size_t)m * D) + ln)[64 * j] = (v2u){pk4_fp8(a8.x, a8.y, a8.z, a8.w), pk4_fp8(b8.x, b8.y, b8.z, b8.w)}; ((GAS v2u*)(H8 + (size_t)m1 * D) + ln)[64 * j] = (v2u){pk4_fp8(c8.x, c8.y, c8.z, c8.w), pk4_fp8(d8.x, d8.y, d8.z, d8.w)}; } }
        }
    }
}

__device__ __forceinline__ void conv_item(const bf16* P, const float* cw, const float* cb, bf16* XC, int c8, int m0) {
    const int t0 = m0 & (SEQ - 1);
    float w[4][8], bb[8];
#pragma unroll
    for (int k = 0; k < 4; ++k) { const f32x4 a = *(const GAS f32x4*)(cw + k * 1024 + c8), b = *(const GAS f32x4*)(cw + k * 1024 + c8 + 4); w[k][0] = a.x; w[k][1] = a.y; w[k][2] = a.z; w[k][3] = a.w; w[k][4] = b.x; w[k][5] = b.y; w[k][6] = b.z; w[k][7] = b.w; }
    { const f32x4 a = *(const GAS f32x4*)(cb + c8), b = *(const GAS f32x4*)(cb + c8 + 4); bb[0] = a.x; bb[1] = a.y; bb[2] = a.z; bb[3] = a.w; bb[4] = b.x; bb[5] = b.y; bb[6] = b.z; bb[7] = b.w; }
    v4u r[19];
#pragma unroll
    for (int i = 0; i < 19; ++i) r[i] = (t0 + i - 3 >= 0) ? *(const GAS v4u*)(P + (size_t)(m0 + i - 3) * PW + P_AX + c8) : (v4u){0u, 0u, 0u, 0u};
#pragma unroll
    for (int t = 0; t < 16; ++t) { float acc[8];
#pragma unroll
        for (int e = 0; e < 8; ++e) acc[e] = bb[e];
#pragma unroll
        for (int k = 0; k < 4; ++k) { const v4u q = r[t + k];
            acc[0] += w[k][0] * blo(q.x); acc[1] += w[k][1] * bhi(q.x); acc[2] += w[k][2] * blo(q.y); acc[3] += w[k][3] * bhi(q.y); acc[4] += w[k][4] * blo(q.z); acc[5] += w[k][5] * bhi(q.z); acc[6] += w[k][6] * blo(q.w); acc[7] += w[k][7] * bhi(q.w); }
        *(GAS v4u*)(XC + (size_t)(m0 + t) * 1024 + c8) = (v4u){pk2(acc[0], acc[1]), pk2(acc[2], acc[3]), pk2(acc[4], acc[5]), pk2(acc[6], acc[7])}; }
}

constexpr int LRU_LDS = 0;
template <bool FINAL> __device__ __forceinline__ void lru_chunk_phase(const Frame& F, const unsigned char* GT, const bf16* XC, const bf16* P, const float* ba, const float* bx, const float* lam,
                                                                    float* CA, float* CH, const float* HIN, bf16* YA, int u0, int u1) {
    LAS float* XA = (LAS float*)(F.lds + LRU_LDS); LAS float* XH = XA + 2048;
    const int c4l = F.lane, part = F.wave;
    {
#pragma unroll 1
        for (int uu = u0; uu < u1; ++uu) { const int c = uu >> 2, r = uu & 3;
            const int ch = 256 * r + 4 * c4l, gc = 256 * (ch >> 7) + (ch & 127); const size_t m0 = (size_t)c * 64 + 8 * part;
            const f32x4 lm = *(const GAS f32x4*)(lam + ch);
            float sp8[4];
#pragma unroll
            for (int e = 0; e < 4; ++e) sp8[e] = (-8.0f / 255.0f) * (flog(1.0f + fexp(-fabsf(lm[e]))) + fmaxf(-lm[e], 0.f));
            float av[8][4], uv[8][4]; float A[4] = {1.f, 1.f, 1.f, 1.f}, Hs[4] = {0.f, 0.f, 0.f, 0.f};
            v2u gwv[8];
#pragma unroll
            for (int t = 0; t < 8; ++t) {
                const unsigned rw = *(const GAS unsigned*)(GT + (m0 + t) * 2048 + gc), iw = *(const GAS unsigned*)(GT + (m0 + t) * 2048 + 128 + gc); const v2u xw = *(const GAS v2u*)(XC + (m0 + t) * 1024 + ch);
                gwv[t] = FINAL ? *(const GAS v2u*)(P + (m0 + t) * PW + P_AG + ch) : (v2u){0u, 0u};
                const float rp[4] = {(float)(rw & 0xFFu), (float)((rw >> 8) & 0xFFu), (float)((rw >> 16) & 0xFFu), (float)(rw >> 24)}, ip[4] = {(float)(iw & 0xFFu), (float)((iw >> 8) & 0xFFu), (float)((iw >> 16) & 0xFFu), (float)(iw >> 24)}, xc[4] = {blo(xw.x), bhi(xw.x), blo(xw.y), bhi(xw.y)};
#pragma unroll
                for (int e = 0; e < 4; ++e) { const float la = rp[e] * sp8[e], a = fexp(la);
                    const float u = __builtin_amdgcn_sqrtf(fmaxf(neg_expm1(2.0f * la, a * a), 0.f)) * (ip[e] * xc[e] * (1.0f / 255.0f));
                    av[t][e] = a; uv[t][e] = u; A[e] *= a; Hs[e] = a * Hs[e] + u; }
            }
            *(LAS f32x4*)(XA + part * 256 + 4 * c4l) = (f32x4){A[0], A[1], A[2], A[3]}; *(LAS f32x4*)(XH + part * 256 + 4 * c4l) = (f32x4){Hs[0], Hs[1], Hs[2], Hs[3]};
            __syncthreads();
            if (!FINAL) {
                if (part == 0) { f32x4 At = (f32x4){1.f, 1.f, 1.f, 1.f}, Ht = (f32x4){0.f, 0.f, 0.f, 0.f};
#pragma unroll
                    for (int qq = 0; qq < 8; ++qq) { const f32x4 a = *(const LAS f32x4*)(XA + qq * 256 + 4 * c4l), hh = *(const LAS f32x4*)(XH + qq * 256 + 4 * c4l); Ht = a * Ht + hh; At = At * a; }
                    *(GAS f32x4*)(CA + (size_t)c * 1024 + ch) = At; *(GAS f32x4*)(CH + (size_t)c * 1024 + ch) = Ht; }
            } else {
                f32x4 h = *(const GAS f32x4*)(HIN + (size_t)c * 1024 + ch);
#pragma unroll
                for (int qq = 0; qq < 7; ++qq) if (qq < part) { const f32x4 a = *(const LAS f32x4*)(XA + qq * 256 + 4 * c4l), hh = *(const LAS f32x4*)(XH + qq * 256 + 4 * c4l); h = a * h + hh; }
#pragma unroll
                for (int t = 0; t < 8; ++t) { const v2u gw = gwv[t]; const float g[4] = {blo(gw.x), bhi(gw.x), blo(gw.y), bhi(gw.y)}; float y[4];
#pragma unroll
                    for (int e = 0; e < 4; ++e) { h[e] = av[t][e] * h[e] + uv[t][e]; y[e] = gelu_tanh(g[e]) * h[e]; }
                    *(GAS v2u*)(YA + (m0 + t) * 1024 + ch) = (v2u){pk2(y[0], y[1]), pk2(y[2], y[3])}; }
            }
            __syncthreads();
        }
    }
}
__device__ __forceinline__ void lru_carry_phase(const Frame& F, const float* CA, const float* CH, float* HIN) {
    if (F.bx < 32) {
        LAS float* XA = (LAS float*)(F.lds + LRU_LDS); LAS float* XH = XA + 512;
        const int b = F.bx >> 4, ch = (F.bx & 15) * 64 + F.lane, part = F.wave;
        float a[16], hh[16]; float At = 1.f, Ht = 0.f;
#pragma unroll
        for (int k = 0; k < 16; ++k) { const size_t i = (size_t)(b * 128 + part * 16 + k) * 1024 + ch; a[k] = CA[i]; hh[k] = CH[i]; }
#pragma unroll
        for (int k = 0; k < 16; ++k) { Ht = a[k] * Ht + hh[k]; At *= a[k]; }
        XA[part * 64 + F.lane] = At; XH[part * 64 + F.lane] = Ht;
        __syncthreads();
        float h = 0.f;
#pragma unroll
        for (int pp = 0; pp < 7; ++pp) if (pp < part) h = XA[pp * 64 + F.lane] * h + XH[pp * 64 + F.lane];
#pragma unroll
        for (int k = 0; k < 16; ++k) { const size_t i = (size_t)(b * 128 + part * 16 + k) * 1024 + ch; HIN[i] = h; h = a[k] * h + hh[k]; }
        __syncthreads();
    }
}

typedef short bf16x8 __attribute__((ext_vector_type(8)));
__device__ __forceinline__ void lrgg_phase(const Frame& F, const bf16* H, const bf16* WlrT, const float* w2, const float* b2, float* GG) {
    LAS float* PART = (LAS float*)(F.lds); LAS float* LR = (LAS float*)(F.lds + 32768);
    const int w = F.wave, lane = F.lane, l15 = lane & 15, g4 = lane >> 4;
    for (int tb = F.vcu; tb < M / 64; tb += F.G) {
        bf16x8 bw[8];
#pragma unroll
        for (int ks = 0; ks < 8; ++ks) bw[ks] = *(const GAS bf16x8*)(WlrT + (size_t)l15 * 2048 + 256 * w + 32 * ks + 8 * g4);
#pragma unroll
        for (int mt = 0; mt < 4; ++mt) { f32x4 acc = (f32x4){0.f, 0.f, 0.f, 0.f}; const bf16* hr = H + (size_t)(64 * tb + 16 * mt + l15) * HP + 256 * w + 8 * g4;
            bf16x8 af[8];
#pragma unroll
            for (int ks = 0; ks < 8; ++ks) af[ks] = *(const GAS bf16x8*)(hr + 32 * ks);
#pragma unroll
            for (int ks = 0; ks < 8; ++ks) acc = __builtin_amdgcn_mfma_f32_16x16x32_bf16(af[ks], bw[ks], acc, 0, 0, 0);
            *(LAS f32x4*)(PART + ((w * 4 + mt) * 64 + lane) * 4) = acc; }
        __syncthreads();
#pragma unroll
        for (int o = F.tid; o < 1024; o += 512) { const int t = o >> 4, n = o & 15, mt = t >> 4, tl = t & 15, ln = n + 16 * (tl >> 2), r = tl & 3; float sum = 0.f;
#pragma unroll
            for (int ww = 0; ww < 8; ++ww) sum += PART[((ww * 4 + mt) * 64 + ln) * 4 + r];
            LR[t * 16 + n] = sum; }
        __syncthreads();
        { const int d = F.tid; float wc[16];
#pragma unroll
          for (int r = 0; r < 16; ++r) wc[r] = w2[r * 512 + d];
          const float bb = b2[d];
#pragma unroll 4
          for (int t = 0; t < 64; ++t) { const f32x4 a0 = *(const LAS f32x4*)(LR + t * 16), a1 = *(const LAS f32x4*)(LR + t * 16 + 4), a2 = *(const LAS f32x4*)(LR + t * 16 + 8), a3 = *(const LAS f32x4*)(LR + t * 16 + 12);
              float x = bb + a0.x * wc[0] + a0.y * wc[1] + a0.z * wc[2] + a0.w * wc[3] + a1.x * wc[4] + a1.y * wc[5] + a1.z * wc[6] + a1.w * wc[7] + a2.x * wc[8] + a2.y * wc[9] + a2.z * wc[10] + a2.w * wc[11] + a3.x * wc[12] + a3.y * wc[13] + a3.z * wc[14] + a3.w * wc[15];
              GG[(size_t)(64 * tb + t) * 512 + d] = log_sigm(x) * 0.0625f; } }
        __syncthreads();
    }
}

constexpr int LA_QT = 0, LA_QP = 17408, LA_KP = 34816, LA_KHT = 78336, LA_VT = 96768, LA_PS = 133632, LA_DEC = 142848, LA_T8 = 143360, LA_NRM = 147456, LA_END = 149504;
constexpr int QS = 272, TS = 144, OBS = 528;
constexpr size_t SLOC_HGRN_OFF = (size_t)128 * 128 * 256;
__device__ __forceinline__ bf16x8 mk8(v2u lo, v2u hi) { v4u t; t.x = lo.x; t.y = lo.y; t.z = hi.x; t.w = hi.y; return __builtin_bit_cast(bf16x8, t); }
template <int TYPE, bool FULL>
__device__ __forceinline__ void la_segment(const Frame& F, int item, const bf16* P, const float* GG, const float* LBl, const float* gn, float* SLOC, float* LDT, const float* SIN, bf16* Y) {
    constexpr int DV = TYPE == 0 ? 256 : 128, NVT = DV / 128, NSEG = TYPE == 0 ? 16 : 8, NCH = 128 / NSEG;
    const int lane = F.lane, w = F.wave, g4 = lane >> 4, l15 = lane & 15, p = lane;
    int bh, seg, b, h;
    if (TYPE == 0) { bh = item >> 4; seg = item & 15; b = bh >> 2; h = bh & 3; } else { bh = item >> 3; seg = item & 7; b = bh >> 3; h = bh & 7; }
    const int qoff = (TYPE == 0 ? P_BQ : P_CQ) + h * 128, koff = (TYPE == 0 ? P_BK : P_CF) + h * 128, voff = TYPE == 0 ? P_BV + h * 256 : P_CI + h * 128, goff = TYPE == 0 ? P_BG + h * 256 : P_CG + h * 128;
    LAS unsigned char* L = F.lds;
    float* slb = SLOC + (TYPE == 0 ? (size_t)0 : SLOC_HGRN_OFF); float* ldb = LDT + (TYPE == 0 ? 0 : 128 * 128);
    f32x4 S[NVT][8];
#pragma unroll
    for (int vt = 0; vt < NVT; ++vt)
#pragma unroll
        for (int dt = 0; dt < 8; ++dt) S[vt][dt] = (f32x4){0.f, 0.f, 0.f, 0.f};
    float ldsa = 0.f, ldsb = 0.f;
    if (FULL) {
        for (int i = F.tid; i < (64 * TS) / 4; i += 512) ((LAS unsigned*)(L + LA_PS))[i] = 0u;
        if (seg > 0) { const float* si = SIN + (TYPE == 0 ? (size_t)0 : SLOC_HGRN_OFF) + (size_t)item * (128 * DV);
#pragma unroll
            for (int vt = 0; vt < NVT; ++vt)
#pragma unroll
                for (int dt = 0; dt < 8; ++dt) S[vt][dt] = *(const GAS f32x4*)(si + ((size_t)(((w * NVT + vt) * 8 + dt) * 64 + lane)) * 4); }
        __syncthreads();
    }
    unsigned qr[8], kr[8]; f32x2 gr[8]; v2u vr[8];
#define LA_BAR() do { asm volatile("s_waitcnt lgkmcnt(0)" ::: "memory"); __builtin_amdgcn_s_barrier(); asm volatile("" ::: "memory"); } while (0)
#define LA_LOAD_RAW(chn) do { const bf16* Pr = P + (size_t)(b * SEQ + (seg * NCH + (chn)) * 64 + 8 * w) * PW; const float* Gr = GG + (size_t)(b * SEQ + (seg * NCH + (chn)) * 64 + 8 * w) * 512 + h * 128 + 2 * p; \
        _Pragma("unroll") for (int j = 0; j < 8; ++j) { const bf16* Pj = Pr + (size_t)j * PW; \
            qr[j] = FULL ? *(const GAS unsigned*)(Pj + qoff + 2 * p) : 0u; kr[j] = *(const GAS unsigned*)(Pj + koff + 2 * p); \
            if (TYPE == 0) gr[j] = *(const GAS f32x2*)(Gr + (size_t)j * 512); else gr[j] = (f32x2){0.f, 0.f}; \
            if (DV == 256) vr[j] = *(const GAS v2u*)(Pj + voff + 4 * p); else { vr[j].x = *(const GAS unsigned*)(Pj + voff + 2 * p); vr[j].y = 0u; } } } while (0)
    LA_LOAD_RAW(0);
    f32x4 gnv[NVT];
#pragma unroll
    for (int vt = 0; vt < NVT; ++vt) gnv[vt] = FULL ? *(const GAS f32x4*)(gn + (w * NVT + vt) * 16 + 4 * g4) : (f32x4){0.f, 0.f, 0.f, 0.f};
#pragma unroll 1
    for (int ch = 0; ch < NCH; ++ch) {
        const int m0 = b * SEQ + (seg * NCH + ch) * 64, sb = w, t0 = 8 * sb, I = sb >> 1;
        float ca[8], cb[8], ka[8], kb[8], qa[8], qb[8]; float ra = 0.f, rb = 0.f;
#pragma unroll
        for (int j = 0; j < 8; ++j) { float ga, gb;
            if (TYPE == 0) { ga = gr[j].x; gb = gr[j].y; ka[j] = blo(kr[j]); kb[j] = bhi(kr[j]); qa[j] = blo(qr[j]); qb[j] = bhi(qr[j]); }
            else { ga = blo(kr[j]); gb = bhi(kr[j]); ka[j] = 1.f - fexp(ga); kb[j] = 1.f - fexp(gb); qa[j] = blo(qr[j]); qb[j] = bhi(qr[j]); }
            ra += ga; rb += gb; ca[j] = ra; cb[j] = rb; }
        *(LAS f32x2*)(L + LA_T8 + (sb * 128 + 2 * p) * 4) = (f32x2){ra, rb};
        LA_BAR();
        float brefa[5], brefb[5]; brefa[0] = 0.f; brefb[0] = 0.f; float cba = 0.f, cbb = 0.f;
#pragma unroll
        for (int J = 0; J < 4; ++J) { const f32x2 u0 = *(const LAS f32x2*)(L + LA_T8 + ((2 * J) * 128 + 2 * p) * 4), u1 = *(const LAS f32x2*)(L + LA_T8 + ((2 * J + 1) * 128 + 2 * p) * 4);
            brefa[J + 1] = brefa[J] + (u0.x + u1.x); brefb[J + 1] = brefb[J] + (u0.y + u1.y);
            if (sb == 2 * J + 1) { cba = u0.x; cbb = u0.y; } }
        const float bIa = I == 0 ? brefa[0] : (I == 1 ? brefa[1] : (I == 2 ? brefa[2] : brefa[3])), bIb = I == 0 ? brefb[0] : (I == 1 ? brefb[1] : (I == 2 ? brefb[2] : brefb[3]));
        const float bla = brefa[4], blb = brefb[4];
        ldsa += bla; ldsb += blb;
        const float eha = fexp(bla - bIa), ehb = fexp(blb - bIb);
        const float eqa = fexp(bIa), eqb = fexp(bIb);
        unsigned kh_a[4], kh_b[4], vlo[4], vhi[4], v2lo[4], v2hi[4];
        float kfa[4], kfb[4];
#pragma unroll
        for (int Ip = 0; Ip < 4; ++Ip) { kfa[Ip] = fexp(fminf(brefa[Ip] - bIa, 0.f)); kfb[Ip] = fexp(fminf(brefb[Ip] - bIb, 0.f)); }
#pragma unroll
        for (int j = 0; j < 8; ++j) { const int t = t0 + j;
            const float cca = fmaxf(cba + ca[j], -60.f), ccb = fmaxf(cbb + cb[j], -60.f); const float e1a = fexp(cca), e1b = fexp(ccb), e2a = fexp(-cca), e2b = fexp(-ccb);
            const float kka = ka[j] * e2a, kkb = kb[j] * e2b;
            const float kha = kka * eha, khb = kkb * ehb;
            if (j & 1) { kh_a[j >> 1] |= f2bf(kha) << 16; kh_b[j >> 1] |= f2bf(khb) << 16; } else { kh_a[j >> 1] = f2bf(kha); kh_b[j >> 1] = f2bf(khb); }
            if (FULL) { const float qpa = qa[j] * e1a, qpb = qb[j] * e1b;
                *(LAS unsigned*)(L + LA_QP + t * QS + 4 * p) = pk2(qpa, qpb); *(LAS unsigned*)(L + LA_QT + t * QS + 4 * p) = pk2(qpa * eqa, qpb * eqb);
#pragma unroll
                for (int Ip = 0; Ip < 4; ++Ip) if (Ip >= I) { const int base = Ip == 0 ? 0 : (Ip == 1 ? 16 : (Ip == 2 ? 48 : 96));
                    *(LAS unsigned*)(L + LA_KP + (base + t) * QS + 4 * p) = pk2(kka * kfa[Ip], kkb * kfb[Ip]); } }
            const unsigned x = vr[j].x, y = vr[j].y;
            if (j & 1) { vlo[j >> 1] |= x << 16; vhi[j >> 1] |= x & 0xffff0000u; v2lo[j >> 1] |= y << 16; v2hi[j >> 1] |= y & 0xffff0000u; }
            else { vlo[j >> 1] = x & 0xffffu; vhi[j >> 1] = x >> 16; v2lo[j >> 1] = y & 0xffffu; v2hi[j >> 1] = y >> 16; } }
        *(LAS v4u*)(L + LA_KHT + (2 * p) * TS + 2 * t0) = (v4u){kh_a[0], kh_a[1], kh_a[2], kh_a[3]}; *(LAS v4u*)(L + LA_KHT + (2 * p + 1) * TS + 2 * t0) = (v4u){kh_b[0], kh_b[1], kh_b[2], kh_b[3]};
        if (DV == 256) { *(LAS v4u*)(L + LA_VT + (4 * p) * TS + 2 * t0) = (v4u){vlo[0], vlo[1], vlo[2], vlo[3]}; *(LAS v4u*)(L + LA_VT + (4 * p + 1) * TS + 2 * t0) = (v4u){vhi[0], vhi[1], vhi[2], vhi[3]};
                         *(LAS v4u*)(L + LA_VT + (4 * p + 2) * TS + 2 * t0) = (v4u){v2lo[0], v2lo[1], v2lo[2], v2lo[3]}; *(LAS v4u*)(L + LA_VT + (4 * p + 3) * TS + 2 * t0) = (v4u){v2hi[0], v2hi[1], v2hi[2], v2hi[3]}; }
        else { *(LAS v4u*)(L + LA_VT + (2 * p) * TS + 2 * t0) = (v4u){vlo[0], vlo[1], vlo[2], vlo[3]}; *(LAS v4u*)(L + LA_VT + (2 * p + 1) * TS + 2 * t0) = (v4u){vhi[0], vhi[1], vhi[2], vhi[3]}; }
        if (sb == 0) *(LAS f32x2*)(L + LA_DEC + 8 * p) = (f32x2){fexp(bla), fexp(blb)};
        if (ch + 1 < NCH) LA_LOAD_RAW(ch + 1);
        LA_BAR();
        v2u gwv[NVT][4];
        f32x4 oacc[TYPE == 0 ? 1 : NVT][4];
        if (FULL) {
            for (int blk = w; blk < 10; blk += 8) { const int I2 = blk >= 6 ? 3 : (blk >= 3 ? 2 : (blk >= 1 ? 1 : 0)), J2 = blk - (I2 * (I2 + 1)) / 2; const int base = I2 == 0 ? 0 : (I2 == 1 ? 16 : (I2 == 2 ? 48 : 96));
                const LAS unsigned char* kp = L + LA_KP + (base + 16 * J2 + l15) * QS + 16 * g4; const LAS unsigned char* qp = L + LA_QP + (16 * I2 + l15) * QS + 16 * g4;
                f32x4 acc = (f32x4){0.f, 0.f, 0.f, 0.f};
#pragma unroll
                for (int ks = 0; ks < 4; ++ks) acc = __builtin_amdgcn_mfma_f32_16x16x32_bf16(*(const LAS bf16x8*)(kp + 64 * ks), *(const LAS bf16x8*)(qp + 64 * ks), acc, 0, 0, 0);
                if (I2 == J2) {
#pragma unroll
                    for (int r = 0; r < 4; ++r) if (4 * g4 + r > l15) acc[r] = 0.f; }
                *(LAS v2u*)(L + LA_PS + (16 * I2 + l15) * TS + (16 * J2 + 4 * g4) * 2) = (v2u){pk2(acc[0], acc[1]), pk2(acc[2], acc[3])}; }
            LA_BAR();
            float ssq[4] = {0.f, 0.f, 0.f, 0.f};
#pragma unroll
            for (int vt = 0; vt < NVT; ++vt) {
                bf16x8 sf[4];
#pragma unroll
                for (int ks = 0; ks < 4; ++ks) { const f32x4 a = S[vt][2 * ks], c = S[vt][2 * ks + 1]; sf[ks] = mk8((v2u){pk2(a.x, a.y), pk2(a.z, a.w)}, (v2u){pk2(c.x, c.y), pk2(c.z, c.w)}); }
#pragma unroll
                for (int I2 = 0; I2 < 4; ++I2) {
                    f32x4 o = (f32x4){0.f, 0.f, 0.f, 0.f};
                    const LAS unsigned char* qt = L + LA_QT + (16 * I2 + l15) * QS + 8 * g4;
#pragma unroll
                    for (int ks = 0; ks < 4; ++ks) o = __builtin_amdgcn_mfma_f32_16x16x32_bf16(sf[ks], mk8(*(const LAS v2u*)(qt + 64 * ks), *(const LAS v2u*)(qt + 64 * ks + 32)), o, 0, 0, 0);
#pragma unroll
                    for (int ks = 0; ks < 2; ++ks) if (ks == 0 || I2 >= 2)
                        o = __builtin_amdgcn_mfma_f32_16x16x32_bf16(*(const LAS bf16x8*)(L + LA_VT + ((w * NVT + vt) * 16 + l15) * TS + (32 * ks + 8 * g4) * 2), *(const LAS bf16x8*)(L + LA_PS + (16 * I2 + l15) * TS + (32 * ks + 8 * g4) * 2), o, 0, 0, 0);
                    ssq[I2] += (o.x * o.x + o.y * o.y) + (o.z * o.z + o.w * o.w);
                    if (TYPE == 0) *(LAS v2u*)(L + LA_KP + (16 * I2 + l15) * OBS + ((w * NVT + vt) * 16 + 4 * g4) * 2) = (v2u){pk2(o.x, o.y), pk2(o.z, o.w)};
                    else oacc[vt][I2] = o;
                }
            }
#pragma unroll
            for (int I2 = 0; I2 < 4; ++I2) { float ss = ssq[I2]; ss += __shfl_xor(ss, 16); ss += __shfl_xor(ss, 32);
                if (g4 == 0) *(LAS float*)(L + LA_NRM + (w * 64 + 16 * I2 + l15) * 4) = ss; }
#pragma unroll
            for (int I2 = 0; I2 < 4; ++I2)
#pragma unroll
                for (int vt = 0; vt < NVT; ++vt) gwv[vt][I2] = *(const GAS v2u*)(P + (size_t)(m0 + 16 * I2 + l15) * PW + goff + (w * NVT + vt) * 16 + 4 * g4);
        }
        { bf16x8 bv[NVT][2];
#pragma unroll
          for (int vt = 0; vt < NVT; ++vt)
#pragma unroll
              for (int ks = 0; ks < 2; ++ks) bv[vt][ks] = *(const LAS bf16x8*)(L + LA_VT + ((w * NVT + vt) * 16 + l15) * TS + (32 * ks + 8 * g4) * 2);
#pragma unroll
          for (int dt = 0; dt < 8; ++dt) { const f32x4 dec = *(const LAS f32x4*)(L + LA_DEC + (dt * 16 + 4 * g4) * 4);
              const bf16x8 a0 = *(const LAS bf16x8*)(L + LA_KHT + (dt * 16 + l15) * TS + (8 * g4) * 2), a1 = *(const LAS bf16x8*)(L + LA_KHT + (dt * 16 + l15) * TS + (32 + 8 * g4) * 2);
#pragma unroll
              for (int vt = 0; vt < NVT; ++vt) { f32x4 sv = S[vt][dt] * dec; sv = __builtin_amdgcn_mfma_f32_16x16x32_bf16(a0, bv[vt][0], sv, 0, 0, 0); S[vt][dt] = __builtin_amdgcn_mfma_f32_16x16x32_bf16(a1, bv[vt][1], sv, 0, 0, 0); } } }
        if (FULL) {
            LA_BAR();
#pragma unroll
            for (int I2 = 0; I2 < 4; ++I2) { float tot = 0.f;
#pragma unroll
                for (int ww = 0; ww < 8; ++ww) tot += *(const LAS float*)(L + LA_NRM + (ww * 64 + 16 * I2 + l15) * 4);
                const float rstd = rsqrtf(tot * (1.f / DV) + EPS); const size_t m = (size_t)(m0 + 16 * I2 + l15);
#pragma unroll
                for (int vt = 0; vt < NVT; ++vt) { const int col = (w * NVT + vt) * 16 + 4 * g4; const v2u gw = gwv[vt][I2]; const f32x4 gg = gnv[vt]; f32x4 o; if (TYPE == 0) { const v2u ob = *(const LAS v2u*)(L + LA_KP + (16 * I2 + l15) * OBS + col * 2); o = (f32x4){blo(ob.x), bhi(ob.x), blo(ob.y), bhi(ob.y)}; } else o = oacc[vt][I2];
                    const float g0 = blo(gw.x), g1 = bhi(gw.x), g2 = blo(gw.y), g3 = bhi(gw.y);
                    float a0, a1, a2, a3; if (TYPE == 0) { a0 = g0 * sigm(g0); a1 = g1 * sigm(g1); a2 = g2 * sigm(g2); a3 = g3 * sigm(g3); } else { a0 = sigm(g0); a1 = sigm(g1); a2 = sigm(g2); a3 = sigm(g3); }
                    *(GAS v2u*)(Y + m * 1024 + h * DV + col) = (v2u){pk2(o.x * rstd * gg.x * a0, o.y * rstd * gg.y * a1), pk2(o.z * rstd * gg.z * a2, o.w * rstd * gg.w * a3)}; } }
        }
    }
    if (!FULL) {
        float* sl = slb + (size_t)item * (128 * DV);
#pragma unroll
        for (int vt = 0; vt < NVT; ++vt)
#pragma unroll
            for (int dt = 0; dt < 8; ++dt) *(GAS f32x4*)(sl + ((size_t)(((w * NVT + vt) * 8 + dt) * 64 + lane)) * 4) = S[vt][dt];
        if (w == 0) { ldb[(size_t)item * 128 + 2 * p] = ldsa; ldb[(size_t)item * 128 + 2 * p + 1] = ldsb; }
    }
    __syncthreads();
}

template <int TYPE> __device__ __forceinline__ void la_prefix(const Frame& F, int gtid, const float* SLOC, const float* LDT, float* SIN) {
    constexpr int DV = TYPE == 0 ? 256 : 128, NSEG = TYPE == 0 ? 16 : 8, NV4 = 128 * DV / 4;
    const int seq = gtid / NV4, e4 = gtid % NV4, dt = (e4 >> 6) & 7, ln = e4 & 63, d0 = dt * 16 + 4 * (ln >> 4);
    const float* slb = SLOC + (TYPE == 0 ? (size_t)0 : SLOC_HGRN_OFF) + (size_t)seq * NSEG * (128 * DV) + (size_t)e4 * 4;
    float* sib = SIN + (TYPE == 0 ? (size_t)0 : SLOC_HGRN_OFF) + (size_t)seq * NSEG * (128 * DV) + (size_t)e4 * 4;
    const float* ldb = LDT + (TYPE == 0 ? 0 : 128 * 128) + (size_t)seq * NSEG * 128 + d0;
    f32x4 sv[NSEG - 1], lv[NSEG - 1];
#pragma unroll
    for (int sg = 0; sg < NSEG - 1; ++sg) { sv[sg] = *(const GAS f32x4*)(slb + (size_t)sg * (128 * DV)); lv[sg] = *(const GAS f32x4*)(ldb + (size_t)sg * 128); }
    f32x4 S = (f32x4){0.f, 0.f, 0.f, 0.f};
#pragma unroll
    for (int sg = 0; sg < NSEG - 1; ++sg) { const f32x4 e = (f32x4){fexp(lv[sg].x), fexp(lv[sg].y), fexp(lv[sg].z), fexp(lv[sg].w)}; S = S * e + sv[sg]; *(GAS f32x4*)(sib + (size_t)(sg + 1) * (128 * DV)) = S; }
}

typedef const __attribute__((address_space(4))) Args* KArgs;
__device__ __forceinline__ KArgs kargs() { unsigned long long p = (unsigned long long)__builtin_amdgcn_kernarg_segment_ptr(); asm volatile("" : "+s"(p)); return (KArgs)p; }
__device__ __forceinline__ Frame mkframe(LAS unsigned char* lds, gu32* ctl) {
    Frame F; int tid = threadIdx.x; asm volatile("" : "+v"(tid)); int bx = blockIdx.x, G = gridDim.x; asm volatile("" : "+s"(bx), "+s"(G));
    F.lds = lds; F.MISC = (volatile LAS unsigned*)(lds + MISC_OFF); F.ctl = ctl;
    F.tid = tid; F.lane = tid & 63; F.wave = __builtin_amdgcn_readfirstlane(tid >> 6); F.G = G; F.bx = bx;
    F.vcu = (G % 8 == 0) ? (bx % 8) * (G / 8) + bx / 8 : bx;
    return F;
}
__global__ void __launch_bounds__(NWAVES * 64, 2) fwd_kernel(Args args_unused) {
    extern __shared__ __attribute__((aligned(16))) unsigned char lds_raw[];
    LAS unsigned char* lds = (LAS unsigned char*)lds_raw;
    XcdBarrier bar;
    int lo, hi;
    {
        KArgs A = kargs();
        gu32* ctl = (gu32*)(A->ws + WS_CTL);
        for (int u = threadIdx.x; u < (LDS_BYTES - LDSCTL_OFF) / 4; u += NWAVES * 64) ((LAS unsigned*)(lds + LDSCTL_OFF))[u] = 0u;
        __syncthreads();
        bar = xcd_barrier_post((unsigned*)(ctl + CW_BAR), (volatile LAS unsigned*)(lds + MISC_OFF) + 8);
        lo = A->ph_lo; hi = A->ph_hi;
    }
#define GRID_BAR() xcd_barrier(bar)
#define PH_SETUP KArgs A = kargs(); unsigned char* ws = A->ws; Frame F = mkframe(lds, (gu32*)(ws + WS_CTL)); (void)F;
#define WSP(T, off) ((T*)(ws + (off)))

    for (int rep = 0; rep < REP_P0; ++rep)
    if (lo <= 0 && 0 < hi) {
        PH_SETUP
        LAS float* scr = (LAS float*)(F.lds + RING_OFF + F.wave * 16384);
        const int gw = F.vcu * NWAVES + F.wave, NGW = F.G * NWAVES;
        int wslot = -1; float wmax = 0.f, s0c = 0.f;
#define WMAX_FLUSH() do { if (wslot >= 0) { for (int o = 1; o < 64; o <<= 1) wmax = fmaxf(wmax, __shfl_xor(wmax, o)); if (F.lane == 0) __hip_atomic_fetch_max((unsigned*)(ws + WS_CTL) + CW_WMAX + wslot, __float_as_uint(wmax), RLX_AGENT); } } while (0)
#define SLOT_ENTER(sl, SAMPLE) do { if (wslot != (sl)) { WMAX_FLUSH(); wslot = (sl); wmax = 0.f; float sm = (SAMPLE); for (int o = 1; o < 64; o <<= 1) sm = fmaxf(sm, __shfl_xor(sm, o)); s0c = fp8_scale(FP8_HEAD * sm); \
            if (F.lane == 0) __hip_atomic_fetch_max((unsigned*)(ws + WS_CTL) + CW_SMAX + wslot, __float_as_uint(sm), RLX_AGENT); } } while (0)
        for (int it = gw; it < NL * I_LAYER; it += NGW) {
            const int l = it / I_LAYER; int r = it % I_LAYER;
            unsigned char* wl = ws + WS_W + (size_t)l * WL_STRIDE;
            const size_t oGU = (size_t)l * D * FF, oD = (size_t)l * FF * D;
            if (r < 2 * I_GATE) { const bool up = r >= I_GATE; const int ri = up ? r - I_GATE : r;
                if (2 * l >= FP8_S0) { SLOT_ENTER(SL_GU(2 * l), p0_absmax_item(A->in[2] + oGU, D, FF, 0, F.lane, 0));
                    wmax = fmaxf(wmax, up ? p0_item8<2>(A->in[3] + oGU, D, FF, wl + WL_GU1, scr, ri, F.lane, s0c) : p0_item8<1>(A->in[2] + oGU, D, FF, wl + WL_GU1, scr, ri, F.lane, s0c)); }
                else if (up) p0_item<2>(A->in[3] + oGU, D, FF, (bf16*)(wl + WL_GU1), scr, ri, F.lane); else p0_item<1>(A->in[2] + oGU, D, FF, (bf16*)(wl + WL_GU1), scr, ri, F.lane);
                continue; } r -= 2 * I_GATE;
            if (r < I_DOWN) { if (2 * l >= FP8_F2_S0) { SLOT_ENTER(SL_DN(2 * l), p0_absmax_item(A->in[4] + oD, FF, D, 0, F.lane, 0)); wmax = fmaxf(wmax, p0_item8<0>(A->in[4] + oD, FF, D, wl + WL_D1, scr, r, F.lane, s0c)); }
                else p0_item<0>(A->in[4] + oD, FF, D, (bf16*)(wl + WL_D1), scr, r, F.lane);
                continue; } r -= I_DOWN;
            if (r < 2 * I_GATE) { const bool up = r >= I_GATE; const int ri = up ? r - I_GATE : r;
                if (2 * l + 1 >= FP8_S0) { SLOT_ENTER(SL_GU(2 * l + 1), p0_absmax_item(A->in[26] + oGU, D, FF, 0, F.lane, 0));
                    wmax = fmaxf(wmax, up ? p0_item8<2>(A->in[27] + oGU, D, FF, wl + WL_GU2, scr, ri, F.lane, s0c) : p0_item8<1>(A->in[26] + oGU, D, FF, wl + WL_GU2, scr, ri, F.lane, s0c)); }
                else if (up) p0_item<2>(A->in[27] + oGU, D, FF, (bf16*)(wl + WL_GU2), scr, ri, F.lane); else p0_item<1>(A->in[26] + oGU, D, FF, (bf16*)(wl + WL_GU2), scr, ri, F.lane);
                continue; } r -= 2 * I_GATE;
            if (r < I_DOWN) { if (2 * l + 1 >= FP8_F2_S0) { SLOT_ENTER(SL_DN(2 * l + 1), p0_absmax_item(A->in[28] + oD, FF, D, 0, F.lane, 0)); wmax = fmaxf(wmax, p0_item8<0>(A->in[28] + oD, FF, D, wl + WL_D2, scr, r, F.lane, s0c)); }
                else p0_item<0>(A->in[28] + oD, FF, D, (bf16*)(wl + WL_D2), scr, r, F.lane);
                continue; } r -= I_DOWN;
            if (r < I_IN) { const float* wi = A->in[7] + (size_t)l * D * IN_W;
                if (l < G8_L0) { p0_item<5>(wi, D, IN_W, (bf16*)(wl + WL_IN), scr, r, F.lane); continue; }
                if (r % NBLK_IN <= MG_NB0) p0_item<3>(wi, D, IN_W, (bf16*)(wl + WL_IN), scr, r, F.lane);
                if (r % NBLK_IN >= MG_NB0) { SLOT_ENTER(l, p0_absmax_item(wi, D, IN_W, MG_NB0 + 1, F.lane, MG_N0)); wmax = fmaxf(wmax, p0_item8<4>(wi, D, IN_W, wl + WL_IN + WL_IN8, scr, r, F.lane, s0c)); }
                continue; } r -= I_IN;
            if (r < 3 * I_BR) { const int br = r / I_BR; p0_item<0>(A->in[20 + br] + (size_t)l * 1024 * D, 1024, D, (bf16*)(wl + WL_BR) + (size_t)br * D * 1024, scr, r % I_BR, F.lane); continue; } r -= 3 * I_BR;
            p0_item<0>(A->in[23] + (size_t)l * D * D, D, D, (bf16*)(wl + WL_OUT), scr, r, F.lane);
        }
        WMAX_FLUSH();
#undef WMAX_FLUSH
#undef SLOT_ENTER
        const int gt = F.vcu * 512 + F.tid, NT = F.G * 512;
        for (int i = gt; i < NL * 2048 * 32; i += NT) { const int l = i / (2048 * 32), r = i % (2048 * 32), n = r >> 5, k8 = (r & 31) * 8;
            const int h = n >> 8, g = (n >> 7) & 1, j = n & 127, hp = 2 * (h >> 1) + (k8 >> 7), i0 = k8 & 127;
            v4u o = (v4u){0u, 0u, 0u, 0u};
            if (hp == h) { const float* w = (g ? A->in[12] : A->in[10]) + (size_t)l * 8 * 128 * 128 + (size_t)h * 128 * 128 + (size_t)i0 * 128 + j;
                o.x = pk2(w[0], w[128]); o.y = pk2(w[256], w[384]); o.z = pk2(w[512], w[640]); o.w = pk2(w[768], w[896]); }
            *(GAS v4u*)((bf16*)(ws + WS_W + (size_t)l * WL_STRIDE + WL_GT) + (size_t)n * 256 + k8) = o; }
        if (gt < 1024) { float* LB = WSP(float, WS_LB); const float* lg = A->in[18]; float v0 = lg[gt], v1 = lg[1024 + gt], v2 = lg[2048 + gt], v3 = lg[3072 + gt];
            const float mx = fmaxf(fmaxf(v0, v1), fmaxf(v2, v3)); v0 = expf(v0 - mx); v1 = expf(v1 - mx); v2 = expf(v2 - mx); v3 = expf(v3 - mx);
            const float inv = 1.f / (v0 + v1 + v2 + v3);
            LB[gt] = 0.f; LB[1024 + gt] = v1 * inv; LB[2048 + gt] = (v1 + v2) * inv; LB[3072 + gt] = (v1 + v2 + v3) * inv; }
        rowpass(F, A->in[0], nullptr, nullptr, nullptr, nullptr, nullptr, nullptr, nullptr, 0.f, A->in[1], WSP(bf16, WS_H));
        GRID_BAR();
    }
    if (lo <= 0 && 0 < hi) {
        PH_SETUP
        LAS float* scr = (LAS float*)(F.lds + RING_OFF + F.wave * 16384);
        const int gw = F.vcu * NWAVES + F.wave, NGW = F.G * NWAVES;
        bool redo = false;
        for (int l = G8_L0; l < NL; ++l) { if (wscale_ok(ws, l)) continue; redo = true; const float sW = wscale(ws, l);
            for (int it = gw; it < I_MG; it += NGW) { const int kb = it / (NBLK_IN - MG_NB0), nb = MG_NB0 + it % (NBLK_IN - MG_NB0);
                (void)p0_item8<4>(A->in[7] + (size_t)l * D * IN_W, D, IN_W, ws + WS_W + (size_t)l * WL_STRIDE + WL_IN + WL_IN8, scr, kb * NBLK_IN + nb, F.lane, sW); } }
        for (int hs = FP8_S0; hs < 2 * NL; ++hs) { if (wscale_ok(ws, SL_GU(hs))) continue; redo = true; const float sW = wscale(ws, SL_GU(hs)); const int l = hs >> 1, f = hs & 1;
            unsigned char* w8 = ws + WS_W + (size_t)l * WL_STRIDE + (f ? WL_GU2 : WL_GU1);
            for (int it = gw; it < 2 * I_GATE; it += NGW) {
                if (it < I_GATE) (void)p0_item8<1>((f ? A->in[26] : A->in[2]) + (size_t)l * D * FF, D, FF, w8, scr, it, F.lane, sW);
                else (void)p0_item8<2>((f ? A->in[27] : A->in[3]) + (size_t)l * D * FF, D, FF, w8, scr, it - I_GATE, F.lane, sW); } }
        for (int hs = FP8_F2_S0; hs < 2 * NL; ++hs) { if (wscale_ok(ws, SL_DN(hs))) continue; redo = true; const float sW = wscale(ws, SL_DN(hs)); const int l = hs >> 1, f = hs & 1;
            for (int it = gw; it < I_DOWN; it += NGW) (void)p0_item8<0>((f ? A->in[28] : A->in[4]) + (size_t)l * FF * D, FF, D, ws + WS_W + (size_t)l * WL_STRIDE + (f ? WL_D2 : WL_D1), scr, it, F.lane, sW); }
        if (redo && hi > 1) GRID_BAR();
    }

    int ph = 1;
#define PH_BEGIN if (lo <= ph && ph < hi) { PH_SETUP unsigned char* wl = ws + WS_W + (size_t)l * WL_STRIDE; (void)wl;
#define PH_END(last) if (!(last) && ph + 1 < hi) GRID_BAR(); } ++ph;
#pragma unroll 1
    for (int s = 0; s < 2 * NL; ++s) {
        const int l = s >> 1, f = s & 1;
        for (int rep = 0; rep < REP_F1; ++rep) { if (rep) --ph;
        PH_BEGIN
            if (s >= FP8_S0) {
                pg8::Gemm g{WSP(bf16, WS_H8), (const bf16*)(wl + (f ? WL_GU2 : WL_GU1)), M, 2 * FF, D / 2, D / 2}; pg8::StaticOrder S; S.init(M, 2 * FF, F.G, F.bx);
                const float sc = 1.0f / (h8_scale((f ? A->in[25] : A->in[1]) + (size_t)l * D, F.lane) * wscale(ws, SL_GU(s)));
                const bool track = (s + 1 >= FP8_F2_S0 && s + 1 < 2 * NL), out8 = (s >= FP8_F2_S0);
                LAS unsigned* mxw = (LAS unsigned*)(F.lds + MISC_OFF + 1024);
                if (F.tid == 0) *mxw = 0u;
                const float s8 = out8 ? fp8_scale(4.0f * __uint_as_float(((const gu32*)(ws + WS_CTL))[CW_WMAX + SL_ACT(s)])) : 0.f;
                pg8::EpiSwiGLU8 E{WSP(bf16, WS_P), FF, sc, out8 ? WSP(unsigned char, WS_P) : nullptr, s8, track ? mxw : nullptr};
                pg8::gemm_phase<pg8::EpiSwiGLU8, pg8::StaticOrder, GEMM_ALIGN, GEMM_SP2, 0, true>(F.lds + RING_OFF, g, S, E);
                if (track && F.tid == 0) __hip_atomic_fetch_max((unsigned*)(ws + WS_CTL) + CW_WMAX + SL_ACT(s + 1), *mxw, RLX_AGENT);
            } else {
            pg8::Gemm g{WSP(bf16, WS_H), (const bf16*)(wl + (f ? WL_GU2 : WL_GU1)), M, 2 * FF, D, HP}; pg8::StaticOrder S; S.init(M, 2 * FF, F.G, F.bx);
            const bool track = (s + 1 >= FP8_F2_S0 && s + 1 < 2 * NL);
            LAS unsigned* mxw = (LAS unsigned*)(F.lds + MISC_OFF + 1024);
            if (F.tid == 0) *mxw = 0u;
            pg8::EpiSwiGLU E{WSP(bf16, WS_P), FF, track ? mxw : nullptr};
            pg8::gemm_phase<pg8::EpiSwiGLU, pg8::StaticOrder, GEMM_ALIGN, GEMM_SP2, HP == D ? 0 : HP>(F.lds + RING_OFF, g, S, E);
            if (track && F.tid == 0) __hip_atomic_fetch_max((unsigned*)(ws + WS_CTL) + CW_WMAX + SL_ACT(s + 1), *mxw, RLX_AGENT);
            }
        PH_END(false) }
        for (int rep = 0; rep < REP_F2; ++rep) { if (rep) --ph;
        PH_BEGIN
            if (s >= FP8_F2_S0) {
                pg8::Gemm g{WSP(bf16, WS_P), (const bf16*)(wl + (f ? WL_D2 : WL_D1)), M, D, FF / 2, FF / 2}; pg8::StaticOrder S; S.init(M, D, F.G, F.bx);
                const float sc = 1.0f / (fp8_scale(4.0f * __uint_as_float(((const gu32*)(ws + WS_CTL))[CW_WMAX + SL_ACT(s)])) * wscale(ws, SL_DN(s)));
                pg8::EpiRaw8 E{WSP(bf16, WS_Y), D, sc};
                pg8::gemm_phase<pg8::EpiRaw8, pg8::StaticOrder, GEMM_ALIGN, GEMM_SP2, 0, true>(F.lds + RING_OFF, g, S, E);
            } else {
            pg8::Gemm g{WSP(bf16, WS_P), (const bf16*)(wl + (f ? WL_D2 : WL_D1)), M, D, FF, FF}; pg8::StaticOrder S; S.init(M, D, F.G, F.bx);
            pg8::EpiRawBf16 E{WSP(bf16, WS_Y), D};
            pg8::gemm_phase<pg8::EpiRawBf16, pg8::StaticOrder, GEMM_ALIGN, GEMM_SP2>(F.lds + RING_OFF, g, S, E);
            }
        PH_END(false) }
        for (int rep = 0; rep < REP_RP; ++rep) { if (rep) --ph;
        PH_BEGIN
            const float* gpost = A->in[f ? 29 : 5] + (size_t)l * D;
            const float* gpre = f ? (l + 1 < NL ? A->in[1] + (size_t)(l + 1) * D : nullptr) : A->in[6] + (size_t)l * D;
            const bool lastp = (s == 2 * NL - 1);
            rowpass(F, (s == 0) ? A->in[0] : nullptr, WSP(unsigned short, WS_XH), WSP(unsigned char, WS_XL), WSP(bf16, WS_Y), lastp ? A->out : nullptr, WSP(unsigned short, WS_XH), WSP(unsigned char, WS_XL), gpost, 0.5f, gpre, (gpre && !(f == 1 && s + 1 >= FP8_S0)) ? WSP(bf16, WS_H) : nullptr, ((f == 0 && l >= G8_L0) || (f == 1 && gpre && s + 1 >= FP8_S0)) ? WSP(unsigned char, WS_H8) : nullptr);
        PH_END(s == 2 * NL - 1 && rep == REP_RP - 1) }
        if (f == 0) {
            for (int rep = 0; rep < REP_M1; ++rep) { if (rep) --ph;
        PH_BEGIN
                if (l < G8_L0) {
                  pg8::Gemm g{WSP(bf16, WS_H), (const bf16*)(wl + WL_IN), M, NIN, D, HP}; pg8::StaticOrder S; S.init(M, NIN, F.G, F.bx);
                  pg8::EpiWinFull E{WSP(bf16, WS_P), PW, WSP(unsigned char, WS_MGQ), WSP(float, WS_LB) + l * 1024};
                  pg8::gemm_phase<pg8::EpiWinFull, pg8::StaticOrder, GEMM_ALIGN, GEMM_SP2, HP == D ? 0 : HP>(F.lds + RING_OFF, g, S, E);
                } else {
                { pg8::Gemm g{WSP(bf16, WS_H), (const bf16*)(wl + WL_IN), M, PW, D, HP}; pg8::StaticOrder S; S.init(M, PW, F.G, F.bx);
                  pg8::EpiWin E{WSP(bf16, WS_P), PW, WSP(float, WS_LB) + l * 1024};
                  pg8::gemm_phase<pg8::EpiWin, pg8::StaticOrder, GEMM_ALIGN, GEMM_SP2, HP == D ? 0 : HP>(F.lds + RING_OFF, g, S, E); }
                { Frame F2 = mkframe(lds, (gu32*)(ws + WS_CTL));
                  pg8::Gemm g{WSP(bf16, WS_H8), (const bf16*)(wl + WL_IN + WL_IN8), M, 6144, D / 2, D / 2}; pg8::StaticOrder S; S.init(M, 6144, F2.G, F2.bx);
                  const float sc = 1.0f / (h8_scale(A->in[6] + (size_t)l * D, F2.lane) * wscale(ws, l));
                  pg8::EpiWinGate E{WSP(unsigned char, WS_MGQ), sc};
                  pg8::gemm_phase<pg8::EpiWinGate, pg8::StaticOrder, GEMM_ALIGN, GEMM_SP2, 0, true>(F2.lds + RING_OFF, g, S, E); }
                }
            PH_END(false) }
            for (int rep = 0; rep < REP_M3; ++rep) { if (rep) --ph;
            PH_BEGIN
                { Frame F2 = mkframe(lds, (gu32*)(ws + WS_CTL));
                  lrgg_phase(F2, WSP(bf16, WS_H), (const bf16*)(wl + WL_IN) + (size_t)NIN * D, A->in[15] + (size_t)l * 16 * 512, A->in[16] + l * 512, WSP(float, WS_GG));
                  pg8::GateOrder S2; S2.init(M, 2048, F2.G, F2.bx); pg8::Unit u;
#pragma unroll 1
                  for (int i = 0; S2.next(i, u); ++i) conv_item(WSP(bf16, WS_P), A->in[8] + (size_t)l * 4 * 1024, A->in[9] + (size_t)l * 1024, WSP(bf16, WS_XC), 256 * (u.pn >> 1) + 8 * (F2.tid & 31), 256 * u.pm + 16 * (F2.tid >> 5));
                  VM_WAIT(); __syncthreads(); }
                int kgate = 256; asm volatile("" : "+s"(kgate));
                pg8::Gemm g{WSP(bf16, WS_XC), (const bf16*)(wl + WL_GT), M, 2048, kgate, 1024}; pg8::GateOrder S; S.init(M, 2048, F.G, F.bx);
                pg8::EpiGate8 E{WSP(unsigned char, WS_GT), A->in[11] + l * 1024, A->in[13] + l * 1024};
                pg8::gemm_phase<pg8::EpiGate8, pg8::GateOrder, GEMM_ALIGN, GEMM_SP2, 1024>(F.lds + RING_OFF, g, S, E);
            PH_END(false) }
            for (int rep = 0; rep < REP_M4; ++rep) { if (rep) --ph;
            PH_BEGIN
                lru_chunk_phase<false>(F, WSP(unsigned char, WS_GT), WSP(bf16, WS_XC), WSP(bf16, WS_P), A->in[11] + l * 1024, A->in[13] + l * 1024, A->in[14] + l * 1024, WSP(float, WS_CA), WSP(float, WS_CH), WSP(float, WS_HIN), WSP(bf16, WS_YA), F.bx < 128 ? LRUA_G * F.bx : 128 * LRUA_G + (8 - LRUA_G) * (F.bx - 128), F.bx < 128 ? LRUA_G * F.bx + LRUA_G : 128 * LRUA_G + (8 - LRUA_G) * (F.bx - 127));
                if (F.bx < 128) la_segment<0, false>(F, F.bx, WSP(bf16, WS_P), WSP(float, WS_GG), WSP(float, WS_LB) + l * 1024, A->in[17] + l * 256, WSP(float, WS_SLOC), WSP(float, WS_LDT), WSP(float, WS_SIN), WSP(bf16, WS_YB));
                else la_segment<1, false>(F, F.bx - 128, WSP(bf16, WS_P), WSP(float, WS_GG), WSP(float, WS_LB) + l * 1024, A->in[19] + l * 128, WSP(float, WS_SLOC), WSP(float, WS_LDT), WSP(float, WS_SIN), WSP(bf16, WS_YC));
            PH_END(false) }
            for (int rep = 0; rep < REP_M5; ++rep) { if (rep) --ph;
            PH_BEGIN
                lru_carry_phase(F, WSP(float, WS_CA), WSP(float, WS_CH), WSP(float, WS_HIN));
                if (F.bx < 128) la_prefix<0>(F, F.bx * 512 + F.tid, WSP(float, WS_SLOC), WSP(float, WS_LDT), WSP(float, WS_SIN));
                else la_prefix<1>(F, (F.bx - 128) * 512 + F.tid, WSP(float, WS_SLOC), WSP(float, WS_LDT), WSP(float, WS_SIN));
            PH_END(false) }
            for (int rep = 0; rep < REP_M6; ++rep) { if (rep) --ph;
            PH_BEGIN
                if (rep == 0) lru_chunk_phase<true>(F, WSP(unsigned char, WS_GT), WSP(bf16, WS_XC), WSP(bf16, WS_P), A->in[11] + l * 1024, A->in[13] + l * 1024, A->in[14] + l * 1024, WSP(float, WS_CA), WSP(float, WS_CH), WSP(float, WS_HIN), WSP(bf16, WS_YA), F.bx < 128 ? LRUC_G * F.bx : 128 * LRUC_G + (8 - LRUC_G) * (F.bx - 128), F.bx < 128 ? LRUC_G * F.bx + LRUC_G : 128 * LRUC_G + (8 - LRUC_G) * (F.bx - 127));
                if (F.bx < 128) { if (rep == 0 || PROBE_SECOND != 2) la_segment<0, true>(F, F.bx, WSP(bf16, WS_P), WSP(float, WS_GG), WSP(float, WS_LB) + l * 1024, A->in[17] + l * 256, WSP(float, WS_SLOC), WSP(float, WS_LDT), WSP(float, WS_SIN), WSP(bf16, WS_YB)); }
                else if (rep == 0 || PROBE_SECOND != 1) la_segment<1, true>(F, F.bx - 128, WSP(bf16, WS_P), WSP(float, WS_GG), WSP(float, WS_LB) + l * 1024, A->in[19] + l * 128, WSP(float, WS_SLOC), WSP(float, WS_LDT), WSP(float, WS_SIN), WSP(bf16, WS_YC));
            PH_END(false) }
            for (int rep = 0; rep < REP_M7; ++rep) { if (rep) --ph;
        PH_BEGIN
                pg8::Gemm g{WSP(bf16, WS_YA), (const bf16*)(wl + WL_BR), M, D, 1024, 1024}; pg8::BranchOrder S; S.init(M, D, F.G, F.bx);
                S.astride = (size_t)M * 1024 * 2; S.bstride = (size_t)D * 1024 * 2;
                pg8::EpiBranchFused E{WSP(unsigned char, WS_MGQ), WSP(bf16, WS_MG), D};
                pg8::gemm_phase<pg8::EpiBranchFused, pg8::BranchOrder, GEMM_ALIGN, GEMM_SP2>(F.lds + RING_OFF, g, S, E);
            PH_END(false) }
            for (int rep = 0; rep < REP_M8; ++rep) { if (rep) --ph;
        PH_BEGIN
                pg8::Gemm g{WSP(bf16, WS_MG), (const bf16*)(wl + WL_OUT), M, D, D, D}; pg8::StaticOrder S; S.init(M, D, F.G, F.bx);
                pg8::EpiRawBf16 E{WSP(bf16, WS_Y), D};
                pg8::gemm_phase<pg8::EpiRawBf16, pg8::StaticOrder, GEMM_ALIGN, GEMM_SP2>(F.lds + RING_OFF, g, S, E);
            PH_END(false) }
            for (int rep = 0; rep < REP_RP; ++rep) { if (rep) --ph;
            PH_BEGIN
                rowpass(F, nullptr, WSP(unsigned short, WS_XH), WSP(unsigned char, WS_XL), WSP(bf16, WS_Y), nullptr, WSP(unsigned short, WS_XH), WSP(unsigned char, WS_XL), A->in[24] + (size_t)l * D, 1.0f, A->in[25] + (size_t)l * D, 2 * l + 1 >= FP8_S0 ? nullptr : WSP(bf16, WS_H), 2 * l + 1 >= FP8_S0 ? WSP(unsigned char, WS_H8) : nullptr);
            PH_END(false) }
        }
    }
}

static int gridDimOk() { return 1; }
extern "C" void kernel_launch(void* const* d_in, const int* in_sizes, int n_in, void* d_out, int out_size, void* d_ws, size_t ws_size, hipStream_t stream) {
    static int grid = 0;
    if (grid == 0) {
        if (n_in != 30 || in_sizes[0] != M * D || out_size != M * D || ws_size < WS_END || gridDimOk() == 0) { fprintf(stderr, "kernel_launch: unexpected shapes (n_in %d, in0 %d, out %d, ws %zu < %zu)\n", n_in, n_in > 0 ? in_sizes[0] : -1, out_size, ws_size, (size_t)WS_END); grid = -1; return; }
        int dev = 0, cus = 0, per_cu = 0;
        if (hipGetDevice(&dev) != hipSuccess || hipDeviceGetAttribute(&cus, hipDeviceAttributeMultiprocessorCount, dev) != hipSuccess) { grid = -1; return; }
        if (hipFuncSetAttribute((const void*)fwd_kernel, hipFuncAttributeMaxDynamicSharedMemorySize, LDS_BYTES) != hipSuccess) { fprintf(stderr, "kernel_launch: hipFuncSetAttribute failed\n"); grid = -1; return; }
        if (hipOccupancyMaxActiveBlocksPerMultiprocessor(&per_cu, (const void*)fwd_kernel, NWAVES * 64, LDS_BYTES) != hipSuccess || per_cu < 1) fprintf(stderr, "kernel_launch: occupancy query says %d\n", per_cu);
        (void)hipGetLastError();
        grid = cus;
    }
    if (grid < 0) return;
    if (hipMemsetAsync((char*)d_ws + WS_CTL, 0, CTL_ZERO_BYTES, stream) != hipSuccess) return;
    Args a{};
    for (int i = 0; i < 30; ++i) a.in[i] = (const float*)d_in[i];
    a.out = (float*)d_out; a.ws = (unsigned char*)d_ws; a.ph_lo = 0; a.ph_hi = 1 << 20;
    hipLaunchKernelGGL(fwd_kernel, dim3(grid), dim3(NWAVES * 64), LDS_BYTES, stream, a);
}
```

```cpp
#include <hip/hip_runtime.h>
#include <cstdio>
#include <cstdint>
#ifndef FP8_S0
#define FP8_S0 1
#endif
#ifndef FP8_F2_S0
#define FP8_F2_S0 5
#endif
#ifndef G8_L0
#define G8_L0 1
#endif
#ifndef I8_F1
#define I8_F1 1
#endif
#ifndef LRUA_G
#define LRUA_G 5
#endif
#ifndef LRUC_G
#define LRUC_G 6
#endif
#ifndef REP_M2
#define REP_M2 1
#endif
#ifndef REP_M4
#define REP_M4 1
#endif
#ifndef REP_M5
#define REP_M5 1
#endif
#ifndef REP_M6
#define REP_M6 1
#endif
#ifndef REP_F1
#define REP_F1 1
#endif
#ifndef REP_F2
#define REP_F2 1
#endif
#ifndef REP_M1
#define REP_M1 1
#endif
#ifndef REP_M3
#define REP_M3 1
#endif
#ifndef REP_M7
#define REP_M7 1
#endif
#ifndef REP_M8
#define REP_M8 1
#endif
#ifndef REP_P0
#define REP_P0 1
#endif
#ifndef REP_LAG
#define REP_LAG 1
#endif
#ifndef REP_LAH
#define REP_LAH 1
#endif
#ifndef GEMM_SP2
#define GEMM_SP2 true
#endif
#ifndef GEMM_ALIGN
#define GEMM_ALIGN true
#endif
#ifndef PROBE_SECOND
#define PROBE_SECOND 0
#endif
#ifndef REP_RP
#define REP_RP 1
#endif
namespace pg8 {
#define PG8_LAS __attribute__((address_space(3)))
typedef unsigned short bf16_t;
typedef short bf16x8 __attribute__((ext_vector_type(8)));
typedef float f32x4 __attribute__((ext_vector_type(4)));
typedef unsigned u32x4 __attribute__((ext_vector_type(4)));
constexpr int BM = 256, BK = 64, HALF = 128, HTB = HALF * BK * 2  , STAGE_BYTES = 8 * HTB, NXCD = 8, WGM = 8;

__host__ __device__ __forceinline__ int lds_byte(int r, int c) { const int st = (r >> 4) * 2 + (c >> 5), rr = r & 15, cc = c & 31, ob = rr * 64 + cc * 2; return st * 1024 + (ob ^ (((ob >> 9) & 1) << 5)); }
__host__ __device__ __forceinline__ void stage_rc(int b, int& R, int& C) { const int st = b / 1024, sb = b % 1024, swz = sb ^ (((sb >> 9) & 1) << 5); R = (st >> 1) * 16 + swz / 64; C = (st & 1) * 32 + (swz % 64) / 2; }
__host__ __device__ __forceinline__ int perm32(int rho) { const int n = rho >> 4, i = rho & 15; return 8 * (i >> 2) + 4 * n + (i & 3); }

struct Unit { int pm, pn, seg; };
struct Gemm { const bf16_t* A; const bf16_t* Bt; int M, N, K, lda; };

struct StaticOrder {
    int nM, nN, nwg, G, c;
    __host__ __device__ void init(int M, int N, int G_, int c_) { nM = M / BM; nN = N / BM; nwg = nM * nN; G = G_; c = c_; }
    __host__ __device__ __forceinline__ bool next(int i, Unit& u) const {
        const long L = (long)i * G + c; if (L >= nwg) return false;
        int wgid = (int)L; { const int q = nwg / NXCD, r = nwg % NXCD, xcd = wgid % NXCD, off = wgid / NXCD; wgid = (xcd < r ? xcd * (q + 1) : r * (q + 1) + (xcd - r) * q) + off; }
        const int nig = WGM * nN, gid = wgid / nig, fm = gid * WGM, gsz = (nM - fm) < WGM ? (nM - fm) : WGM;
        u.pm = fm + ((wgid % nig) % gsz); u.pn = (wgid % nig) / gsz; u.seg = 0; return true;
    }
    __device__ __forceinline__ const char* pa(const Gemm& g, const Unit& u, size_t tstep) const { return (const char*)g.A + (size_t)u.pm * tstep; }
    __device__ __forceinline__ const char* pb(const Gemm& g, const Unit& u, size_t tstep) const { return (const char*)g.Bt + (size_t)u.pn * tstep; }
    __device__ __forceinline__ void a_ready(const Unit&) const {}
    __device__ __forceinline__ void done(const Unit&) const {}
};

typedef float f32x2c __attribute__((ext_vector_type(2))); typedef __bf16 bf16x2c __attribute__((ext_vector_type(2)));
__device__ __forceinline__ unsigned cvt_pk_bf16(float lo, float hi) { f32x2c v = {lo, hi}; bf16x2c b = __builtin_convertvector(v, bf16x2c); return __builtin_bit_cast(unsigned, b); }
typedef float f32x2 __attribute__((ext_vector_type(2)));
__device__ __forceinline__ float bf_lo(unsigned w) { return __uint_as_float(w << 16); }
__device__ __forceinline__ float bf_hi(unsigned w) { return __uint_as_float(w & 0xffff0000u); }
__device__ __forceinline__ float sigmoidf_fast(float x) { return __builtin_amdgcn_rcpf(1.0f + __builtin_amdgcn_exp2f(-1.44269504089f * x)); }
typedef unsigned u32x2 __attribute__((ext_vector_type(2)));

struct EpiF32 {
    static constexpr bool PERM = false, AFTER_DRAIN = false, SEGMENTED = false;
    float* C; int ldc;
    __device__ __forceinline__ void operator()(const f32x4 (&acc)[2][2][4][2], const Unit& u, int wr, int wc, int fr, int fq) const {
        const int row0 = u.pm * BM + wr * 64 + fr, col0 = u.pn * BM + wc * 32 + 4 * fq;
#pragma unroll
        for (int ai = 0; ai < 2; ++ai)
#pragma unroll
            for (int m = 0; m < 4; ++m) { float* rowp = C + (size_t)(row0 + ai * HALF + m * 16) * ldc + col0;
#pragma unroll
                for (int bj = 0; bj < 2; ++bj)
#pragma unroll
                    for (int n = 0; n < 2; ++n) *(f32x4*)(rowp + bj * HALF + n * 16) = acc[ai][bj][m][n]; }
    }
};
struct EpiRawBf16 {
    static constexpr bool PERM = true, AFTER_DRAIN = false, SEGMENTED = false;
    bf16_t* O; int ldc;
    __device__ __forceinline__ void operator()(const f32x4 (&acc)[2][2][4][2], const Unit& u, int wr, int wc, int fr, int fq) const {
        const int row0 = u.pm * BM + wr * 64 + fr, col0 = u.pn * BM + wc * 32 + 8 * fq;
#pragma unroll
        for (int ai = 0; ai < 2; ++ai)
#pragma unroll
            for (int m = 0; m < 4; ++m) { bf16_t* rowp = O + (size_t)(row0 + ai * HALF + m * 16) * ldc + col0;
#pragma unroll
                for (int bj = 0; bj < 2; ++bj) { const f32x4 v0 = acc[ai][bj][m][0], v1 = acc[ai][bj][m][1];
                    u32x4 w; w.x = cvt_pk_bf16(v0[0], v0[1]); w.y = cvt_pk_bf16(v0[2], v0[3]); w.z = cvt_pk_bf16(v1[0], v1[1]); w.w = cvt_pk_bf16(v1[2], v1[3]);
                    *(u32x4*)(rowp + bj * HALF) = w; } }
    }
};
struct EpiWin {
    static constexpr bool PERM = true, AFTER_DRAIN = false, SEGMENTED = false;
    bf16_t* O; int ldc; const float* lb;
    __device__ __forceinline__ void operator()(const f32x4 (&acc)[2][2][4][2], const Unit& u, int wr, int wc, int fr, int fq) const {
        const int row0 = u.pm * BM + wr * 64 + fr, colt = wc * 32 + 8 * fq;
        const int kind = (u.pn == 8 || u.pn == 9) ? 1 : ((u.pn >= 20 && u.pn < 24) ? 2 : ((u.pn >= 24 && u.pn < 28) ? 3 : 0));
        float lbv[2][8];
#pragma unroll
        for (int bj = 0; bj < 2; ++bj)
#pragma unroll
            for (int k = 0; k < 8; ++k) lbv[bj][k] = kind == 3 ? lb[(u.pn - 24) * BM + bj * HALF + colt + k] : 0.f;
#pragma unroll
        for (int ai = 0; ai < 2; ++ai)
#pragma unroll
            for (int m = 0; m < 4; ++m) { const size_t row = (size_t)(row0 + ai * HALF + m * 16);
#pragma unroll
                for (int bj = 0; bj < 2; ++bj) { const f32x4 v0 = acc[ai][bj][m][0], v1 = acc[ai][bj][m][1];
                    f32x4 x0 = v0, x1 = v1;
                    if (kind == 1) { x0 = x0 * 0.08838834764831845f; x1 = x1 * 0.08838834764831845f; }
                    else if (kind == 2) {
#pragma unroll
                        for (int j = 0; j < 4; ++j) { x0[j] = x0[j] * sigmoidf_fast(x0[j]); x1[j] = x1[j] * sigmoidf_fast(x1[j]); } }
                    else if (kind == 3) {
#pragma unroll
                        for (int j = 0; j < 4; ++j) { const float la = lbv[bj][j], lc = lbv[bj][4 + j];
                            x0[j] = 0.69314718056f * __builtin_amdgcn_logf(la + (1.0f - la) * sigmoidf_fast(x0[j])); x1[j] = 0.69314718056f * __builtin_amdgcn_logf(lc + (1.0f - lc) * sigmoidf_fast(x1[j])); } }
                    u32x4 w; w.x = cvt_pk_bf16(x0[0], x0[1]); w.y = cvt_pk_bf16(x0[2], x0[3]); w.z = cvt_pk_bf16(x1[0], x1[1]); w.w = cvt_pk_bf16(x1[2], x1[3]);
                    *(u32x4*)(O + row * ldc + u.pn * BM + colt + bj * HALF) = w; } }
    }
};
struct EpiWinGate {
    static constexpr bool PERM = true, AFTER_DRAIN = false, SEGMENTED = false;
    unsigned char* Q; float sc;
    __device__ __forceinline__ void operator()(const f32x4 (&acc)[2][2][4][2], const Unit& u, int wr, int wc, int fr, int fq) const {
        const int row0 = u.pm * BM + wr * 64 + fr, colt = wc * 32 + 8 * fq;
#pragma unroll
        for (int ai = 0; ai < 2; ++ai)
#pragma unroll
            for (int m = 0; m < 4; ++m) { const size_t row = (size_t)(row0 + ai * HALF + m * 16);
#pragma unroll
                for (int bj = 0; bj < 2; ++bj) { const f32x4 v0 = acc[ai][bj][m][0] * sc, v1 = acc[ai][bj][m][1] * sc; unsigned q[8];
#pragma unroll
                    for (int j = 0; j < 4; ++j) { const float s0 = 255.0f * __builtin_amdgcn_rcpf(1.0f + __builtin_amdgcn_exp2f(-1.44269504089f * __builtin_amdgcn_fmed3f(v0[j], -30.f, 30.f))) + 0.5f,
                                                              s1 = 255.0f * __builtin_amdgcn_rcpf(1.0f + __builtin_amdgcn_exp2f(-1.44269504089f * __builtin_amdgcn_fmed3f(v1[j], -30.f, 30.f))) + 0.5f;
                        q[j] = (unsigned)__builtin_amdgcn_fmed3f(s0, 1.0f, 255.0f); q[4 + j] = (unsigned)__builtin_amdgcn_fmed3f(s1, 1.0f, 255.0f); }
                    u32x2 w; w.x = q[0] | (q[1] << 8) | (q[2] << 16) | (q[3] << 24); w.y = q[4] | (q[5] << 8) | (q[6] << 16) | (q[7] << 24);
                    *(u32x2*)(Q + row * 6144 + u.pn * BM + colt + bj * HALF) = w; } }
    }
};
struct EpiWinFull {
    static constexpr bool PERM = true, AFTER_DRAIN = false, SEGMENTED = false;
    bf16_t* O; int ldc; unsigned char* Q; const float* lb;
    __device__ __forceinline__ void operator()(const f32x4 (&acc)[2][2][4][2], const Unit& u, int wr, int wc, int fr, int fq) const {
        const int row0 = u.pm * BM + wr * 64 + fr, colt = wc * 32 + 8 * fq; const bool gate = u.pn >= 36;
        const int kind = (u.pn == 8 || u.pn == 9) ? 1 : ((u.pn >= 20 && u.pn < 24) ? 2 : ((u.pn >= 24 && u.pn < 28) ? 3 : 0));
        float lbv[2][8];
#pragma unroll
        for (int bj = 0; bj < 2; ++bj)
#pragma unroll
            for (int k = 0; k < 8; ++k) lbv[bj][k] = kind == 3 ? lb[(u.pn - 24) * BM + bj * HALF + colt + k] : 0.f;
#pragma unroll
        for (int ai = 0; ai < 2; ++ai)
#pragma unroll
            for (int m = 0; m < 4; ++m) { const size_t row = (size_t)(row0 + ai * HALF + m * 16);
#pragma unroll
                for (int bj = 0; bj < 2; ++bj) { const f32x4 v0 = acc[ai][bj][m][0], v1 = acc[ai][bj][m][1];
                    if (gate) { unsigned q[8];
#pragma unroll
                        for (int j = 0; j < 4; ++j) { const float s0 = 255.0f * __builtin_amdgcn_rcpf(1.0f + __builtin_amdgcn_exp2f(-1.44269504089f * __builtin_amdgcn_fmed3f(v0[j], -30.f, 30.f))) + 0.5f,
                                                                  s1 = 255.0f * __builtin_amdgcn_rcpf(1.0f + __builtin_amdgcn_exp2f(-1.44269504089f * __builtin_amdgcn_fmed3f(v1[j], -30.f, 30.f))) + 0.5f;
                            q[j] = (unsigned)__builtin_amdgcn_fmed3f(s0, 1.0f, 255.0f); q[4 + j] = (unsigned)__builtin_amdgcn_fmed3f(s1, 1.0f, 255.0f); }
                        u32x2 w; w.x = q[0] | (q[1] << 8) | (q[2] << 16) | (q[3] << 24); w.y = q[4] | (q[5] << 8) | (q[6] << 16) | (q[7] << 24);
                        *(u32x2*)(Q + row * 6144 + (u.pn - 36) * BM + colt + bj * HALF) = w; }
                    else { f32x4 x0 = v0, x1 = v1;
                        if (kind == 1) { x0 = x0 * 0.08838834764831845f; x1 = x1 * 0.08838834764831845f; }
                        else if (kind == 2) {
#pragma unroll
                            for (int j = 0; j < 4; ++j) { x0[j] = x0[j] * sigmoidf_fast(x0[j]); x1[j] = x1[j] * sigmoidf_fast(x1[j]); } }
                        else if (kind == 3) {
#pragma unroll
                            for (int j = 0; j < 4; ++j) { const float la = lbv[bj][j], lc = lbv[bj][4 + j];
                                x0[j] = 0.69314718056f * __builtin_amdgcn_logf(la + (1.0f - la) * sigmoidf_fast(x0[j])); x1[j] = 0.69314718056f * __builtin_amdgcn_logf(lc + (1.0f - lc) * sigmoidf_fast(x1[j])); } }
                        u32x4 w; w.x = cvt_pk_bf16(x0[0], x0[1]); w.y = cvt_pk_bf16(x0[2], x0[3]); w.z = cvt_pk_bf16(x1[0], x1[1]); w.w = cvt_pk_bf16(x1[2], x1[3]);
                        *(u32x4*)(O + row * ldc + u.pn * BM + colt + bj * HALF) = w; } } }
    }
};
struct EpiGate8 {
    static constexpr bool PERM = true, AFTER_DRAIN = false, SEGMENTED = false;
    unsigned char* Q; const float* ba; const float* bx;
    __device__ __forceinline__ void operator()(const f32x4 (&acc)[2][2][4][2], const Unit& u, int wr, int wc, int fr, int fq) const {
        const int row0 = u.pm * BM + wr * 64 + fr, colt = wc * 32 + 8 * fq, ch = u.pn * HALF + colt;
        float b[2][8];
#pragma unroll
        for (int k = 0; k < 8; ++k) { b[0][k] = ba[ch + k]; b[1][k] = bx[ch + k]; }
#pragma unroll
        for (int ai = 0; ai < 2; ++ai)
#pragma unroll
            for (int m = 0; m < 4; ++m) { unsigned char* rowp = Q + (size_t)(row0 + ai * HALF + m * 16) * 2048 + u.pn * BM + colt;
#pragma unroll
                for (int bj = 0; bj < 2; ++bj) { const f32x4 v0 = acc[ai][bj][m][0], v1 = acc[ai][bj][m][1]; unsigned q[8];
#pragma unroll
                    for (int j = 0; j < 4; ++j) { q[j] = (unsigned)(255.0f * sigmoidf_fast(v0[j] + b[bj][j]) + 0.5f); q[4 + j] = (unsigned)(255.0f * sigmoidf_fast(v1[j] + b[bj][4 + j]) + 0.5f); }
                    u32x2 w; w.x = q[0] | (q[1] << 8) | (q[2] << 16) | (q[3] << 24); w.y = q[4] | (q[5] << 8) | (q[6] << 16) | (q[7] << 24);
                    *(u32x2*)(rowp + bj * HALF) = w; } }
    }
};
struct EpiSwiGLU {
    static constexpr bool PERM = true, AFTER_DRAIN = false, SEGMENTED = false;
    bf16_t* O; int ldc; PG8_LAS unsigned* mx;
    __device__ __forceinline__ void operator()(const f32x4 (&acc)[2][2][4][2], const Unit& u, int wr, int wc, int fr, int fq) const {
        const int row0 = u.pm * BM + wr * 64 + fr, col0 = u.pn * HALF + wc * 32 + 8 * fq;
        float lm = 0.f;
#pragma unroll
        for (int ai = 0; ai < 2; ++ai)
#pragma unroll
            for (int m = 0; m < 4; ++m) { bf16_t* rowp = O + (size_t)(row0 + ai * HALF + m * 16) * ldc + col0;
                float r[8];
#pragma unroll
                for (int n = 0; n < 2; ++n)
#pragma unroll
                    for (int j = 0; j < 4; ++j) { const float g = acc[ai][0][m][n][j], up = acc[ai][1][m][n][j]; r[n * 4 + j] = g * sigmoidf_fast(g) * up; }
                if (mx) {
#pragma unroll
                    for (int k = 0; k < 8; ++k) lm = fmaxf(lm, fabsf(r[k])); }
                u32x4 w; w.x = cvt_pk_bf16(r[0], r[1]); w.y = cvt_pk_bf16(r[2], r[3]); w.z = cvt_pk_bf16(r[4], r[5]); w.w = cvt_pk_bf16(r[6], r[7]);
                *(u32x4*)rowp = w; }
        if (mx) {
#pragma unroll
            for (int o = 1; o < 64; o <<= 1) lm = fmaxf(lm, __shfl_xor(lm, o));
            if ((fr | fq) == 0) __hip_atomic_fetch_max(mx, __float_as_uint(lm), __ATOMIC_RELAXED, __HIP_MEMORY_SCOPE_WORKGROUP);
            asm volatile("s_waitcnt lgkmcnt(0)" ::: "memory"); }
    }
};
__device__ __forceinline__ unsigned cvt_pk4_fp8(float a, float b, float c, float d) { int w = 0; w = __builtin_amdgcn_cvt_pk_fp8_f32(a, b, w, false); w = __builtin_amdgcn_cvt_pk_fp8_f32(c, d, w, true); return (unsigned)w; }
struct EpiSwiGLU8 {
    static constexpr bool PERM = true, AFTER_DRAIN = false, SEGMENTED = false;
    bf16_t* O; int ldc; float sc; unsigned char* O8; float s8; PG8_LAS unsigned* mx; const float* rs;
    __device__ __forceinline__ void operator()(const f32x4 (&acc)[2][2][4][2], const Unit& u, int wr, int wc, int fr, int fq) const {
        const int row0 = u.pm * BM + wr * 64 + fr, col0 = u.pn * HALF + wc * 32 + 8 * fq;
        float lm = 0.f;
#pragma unroll
        for (int ai = 0; ai < 2; ++ai)
#pragma unroll
            for (int m = 0; m < 4; ++m) { const size_t ro = (size_t)(row0 + ai * HALF + m * 16) * ldc + col0;
                float r[8]; const float scr_ = rs ? rs[row0 + ai * HALF + m * 16] * sc : sc;
#pragma unroll
                for (int n = 0; n < 2; ++n)
#pragma unroll
                    for (int j = 0; j < 4; ++j) { const float ga = acc[ai][0][m][n][j], ua = acc[ai][1][m][n][j];
                        const float g = (rs ? (float)__float_as_int(ga) : ga) * scr_, up = (rs ? (float)__float_as_int(ua) : ua) * scr_; r[n * 4 + j] = g * sigmoidf_fast(g) * up; }
#pragma unroll
                for (int k = 0; k < 8; ++k) lm = fmaxf(lm, fabsf(r[k]));
                if (O8) {
#pragma unroll
                    for (int k = 0; k < 8; ++k) r[k] = __builtin_amdgcn_fmed3f(r[k] * s8, -448.0f, 448.0f);
                    u32x2 w; w.x = cvt_pk4_fp8(r[0], r[1], r[2], r[3]); w.y = cvt_pk4_fp8(r[4], r[5], r[6], r[7]); *(u32x2*)(O8 + ro) = w; }
                else {
                    u32x4 w; w.x = cvt_pk_bf16(r[0], r[1]); w.y = cvt_pk_bf16(r[2], r[3]); w.z = cvt_pk_bf16(r[4], r[5]); w.w = cvt_pk_bf16(r[6], r[7]);
                    *(u32x4*)(O + ro) = w; } }
        if (mx) {
#pragma unroll
            for (int o = 1; o < 64; o <<= 1) lm = fmaxf(lm, __shfl_xor(lm, o));
            if ((fr | fq) == 0) __hip_atomic_fetch_max(mx, __float_as_uint(lm), __ATOMIC_RELAXED, __HIP_MEMORY_SCOPE_WORKGROUP);
            asm volatile("s_waitcnt lgkmcnt(0)" ::: "memory"); }
    }
};
struct EpiRaw8 {
    static constexpr bool PERM = true, AFTER_DRAIN = false, SEGMENTED = false;
    bf16_t* O; int ldc; float sc;
    __device__ __forceinline__ void operator()(const f32x4 (&acc)[2][2][4][2], const Unit& u, int wr, int wc, int fr, int fq) const {
        const int row0 = u.pm * BM + wr * 64 + fr, col0 = u.pn * BM + wc * 32 + 8 * fq;
#pragma unroll
        for (int ai = 0; ai < 2; ++ai)
#pragma unroll
            for (int m = 0; m < 4; ++m) { bf16_t* rowp = O + (size_t)(row0 + ai * HALF + m * 16) * ldc + col0;
#pragma unroll
                for (int bj = 0; bj < 2; ++bj) { const f32x4 v0 = acc[ai][bj][m][0] * sc, v1 = acc[ai][bj][m][1] * sc;
                    u32x4 w; w.x = cvt_pk_bf16(v0[0], v0[1]); w.y = cvt_pk_bf16(v0[2], v0[3]); w.z = cvt_pk_bf16(v1[0], v1[1]); w.w = cvt_pk_bf16(v1[2], v1[3]);
                    *(u32x4*)(rowp + bj * HALF) = w; } }
    }
};
struct GateOrder : StaticOrder {
    __device__ __forceinline__ const char* pa(const Gemm& g, const Unit& u, size_t tstep) const { return (const char*)g.A + (size_t)(u.pn >> 1) * 512 + (size_t)u.pm * tstep; }
};
struct BranchOrder : StaticOrder {
    size_t astride, bstride;
    __device__ __forceinline__ bool next(int i, Unit& u) const { const int ti = i / 3, sg = i - 3 * ti; if (!StaticOrder::next(ti, u)) return false; u.seg = sg; return true; }
    __device__ __forceinline__ const char* pa(const Gemm& g, const Unit& u, size_t tstep) const { return (const char*)g.A + (size_t)u.seg * astride + (size_t)u.pm * tstep; }
    __device__ __forceinline__ const char* pb(const Gemm& g, const Unit& u, size_t tstep) const { return (const char*)g.Bt + (size_t)u.seg * bstride + (size_t)u.pn * tstep; }
};
__device__ __forceinline__ float ub0(unsigned w) { return (float)(w & 0xFFu); }
__device__ __forceinline__ float ub1(unsigned w) { return (float)((w >> 8) & 0xFFu); }
__device__ __forceinline__ float ub2(unsigned w) { return (float)((w >> 16) & 0xFFu); }
__device__ __forceinline__ float ub3(unsigned w) { return (float)(w >> 24); }
struct EpiBranchFused {
    static constexpr bool PERM = true, AFTER_DRAIN = false, SEGMENTED = true;
    const unsigned char* Q; bf16_t* MO; int ld;
    __device__ __forceinline__ void operator()(f32x4 (&acc)[2][2][4][2], const Unit& u, int wr, int wc, int fr, int fq) const {
        const int row0 = u.pm * BM + wr * 64 + fr, col0 = u.pn * BM + wc * 32 + 8 * fq; const int sg = u.seg; const bool fin = sg == 2;
        const unsigned char* qn = Q + (size_t)row0 * 6144 + sg * 2048 + col0; const unsigned char* qd = fin ? qn : qn + 2048;
        u32x2 gn[2][4][2], gd[2][4][2];
#define BR_LOAD(ai_) do { _Pragma("unroll") for (int m = 0; m < 4; ++m) _Pragma("unroll") for (int bj = 0; bj < 2; ++bj) { const size_t go = (size_t)((ai_) * HALF + m * 16) * 6144 + bj * HALF; \
            gn[ai_][m][bj] = *(const u32x2*)(qn + go); gd[ai_][m][bj] = *(const u32x2*)(qd + go); } } while (0)
        BR_LOAD(0); BR_LOAD(1);
#pragma unroll
        for (int ai = 0; ai < 2; ++ai) {
#pragma unroll
            for (int m = 0; m < 4; ++m)
#pragma unroll
                for (int bj = 0; bj < 2; ++bj) { const u32x2 a = gn[ai][m][bj], d = gd[ai][m][bj];
                    const float an[8] = {ub0(a.x), ub1(a.x), ub2(a.x), ub3(a.x), ub0(a.y), ub1(a.y), ub2(a.y), ub3(a.y)};
                    const float dn[8] = {ub0(d.x), ub1(d.x), ub2(d.x), ub3(d.x), ub0(d.y), ub1(d.y), ub2(d.y), ub3(d.y)};
                    float f[8];
#pragma unroll
                    for (int k = 0; k < 8; ++k) { const float rd = __builtin_amdgcn_rcpf(dn[k]); f[k] = an[k] * (fin ? (1.0f / 255.0f) : rd); }
                    f32x4 v0 = acc[ai][bj][m][0], v1 = acc[ai][bj][m][1];
                    v0[0] *= f[0]; v0[1] *= f[1]; v0[2] *= f[2]; v0[3] *= f[3]; v1[0] *= f[4]; v1[1] *= f[5]; v1[2] *= f[6]; v1[3] *= f[7];
                    acc[ai][bj][m][0] = v0; acc[ai][bj][m][1] = v1;
                    if (fin) { u32x4 w; w.x = cvt_pk_bf16(v0[0], v0[1]); w.y = cvt_pk_bf16(v0[2], v0[3]); w.z = cvt_pk_bf16(v1[0], v1[1]); w.w = cvt_pk_bf16(v1[2], v1[3]);
                        *(u32x4*)(MO + (size_t)(row0 + ai * HALF + m * 16) * ld + col0 + bj * HALF) = w; } }
        }
#undef BR_LOAD
    }
};

typedef int i32x4 __attribute__((ext_vector_type(4))); typedef int i32x8 __attribute__((ext_vector_type(8)));
__device__ __forceinline__ i32x8 cat8(const bf16x8 a, const bf16x8 b) { const i32x4 x = __builtin_bit_cast(i32x4, a), y = __builtin_bit_cast(i32x4, b); return __builtin_shufflevector(x, y, 0, 1, 2, 3, 4, 5, 6, 7); }
__device__ __forceinline__ void mfma_fp8_acc(f32x4& acc, const i32x8 b, const i32x8 a) { asm volatile("v_mfma_f32_16x16x128_f8f6f4 %0, %1, %2, %0" : "+v"(acc) : "v"(b), "v"(a)); }
template <class Epi, class Sched, bool ALIGN_EPI = false, bool SP2 = false, int LDA = 0  , int Q8 = 0  >
__device__ __forceinline__ void gemm_phase(PG8_LAS unsigned char* lds, const Gemm g, const Sched& S, const Epi& E) {
    int tid_l = threadIdx.x; asm volatile("" : "+v"(tid_l)); const int tid = tid_l, wid = __builtin_amdgcn_readfirstlane(tid >> 6), lane = tid & 63, wr = wid >> 2, wc = wid & 3, fr = lane & 15, fq = lane >> 4;
    const int K = g.K, nt = K / BK;
    unsigned voffA[2], voffB[2];
#pragma unroll
    for (int i = 0; i < 2; ++i) { int R, C; stage_rc(tid * 16 + i * 8192, R, C); const int Rb = Epi::PERM ? ((R & ~31) + perm32(R & 31)) : R;
        voffA[i] = (unsigned)(R * (LDA ? LDA : K) + C) * 2u; voffB[i] = (unsigned)(Rb * K + C) * 2u; }
    const size_t kstep = (size_t)(BK * 2);
    const size_t hstepB = (size_t)HALF * K * 2, hstepA = LDA ? (size_t)HALF * LDA * 2 : hstepB;
    const size_t tstepA = 2 * hstepA, tstepB = 2 * hstepB;
    const unsigned ldsw = (unsigned)wid * 1024u;
    const int aoff = lds_byte(wr * 64 + fr, fq * 8), boff = lds_byte(wc * 32 + fr, fq * 8);
#define PG8_SA(b, h) (((b) * 2 + (h)) * HTB)
#define PG8_SB(b, h) ((4 + (b) * 2 + (h)) * HTB)
#define PG8_STAGE(bufoff, gbase, voff) do { _Pragma("unroll") for (int _i = 0; _i < 2; ++_i) \
        __builtin_amdgcn_global_load_lds((const unsigned*)((const char*)(gbase) + (voff)[_i]), (PG8_LAS unsigned*)(lds + (bufoff) + ldsw + _i * 8192), 16, 0, 0); } while (0)
#define PG8_LDA(dst, b, h) do { _Pragma("unroll") for (int m = 0; m < 4; ++m) _Pragma("unroll") for (int k = 0; k < 2; ++k) dst[m][k] = *(const PG8_LAS bf16x8*)(lds + PG8_SA(b, h) + aoff + m * 2048 + k * 1024); } while (0)
#define PG8_LDB(dst, b, h) do { _Pragma("unroll") for (int n = 0; n < 2; ++n) _Pragma("unroll") for (int k = 0; k < 2; ++k) dst[n][k] = *(const PG8_LAS bf16x8*)(lds + PG8_SB(b, h) + boff + n * 2048 + k * 1024); } while (0)
#define PG8_MMA(ai, bj, At, Bt) do { __builtin_amdgcn_s_setprio(1); _Pragma("unroll") for (int m = 0; m < 4; ++m) _Pragma("unroll") for (int n = 0; n < 2; ++n) { \
        if constexpr (Q8 == 1) mfma_fp8_acc(acc[ai][bj][m][n], cat8(Bt[n][0], Bt[n][1]), cat8(At[m][0], At[m][1])); \
        else if constexpr (Q8 == 2) { _Pragma("unroll") for (int k = 0; k < 2; ++k) acc[ai][bj][m][n] = __builtin_bit_cast(f32x4, __builtin_amdgcn_mfma_i32_16x16x64_i8(__builtin_bit_cast(i32x4, Bt[n][k]), __builtin_bit_cast(i32x4, At[m][k]), __builtin_bit_cast(i32x4, acc[ai][bj][m][n]), 0, 0, 0)); } \
        else { _Pragma("unroll") for (int k = 0; k < 2; ++k) acc[ai][bj][m][n] = __builtin_amdgcn_mfma_f32_16x16x32_bf16(Bt[n][k], At[m][k], acc[ai][bj][m][n], 0, 0, 0); } } __builtin_amdgcn_s_setprio(0); } while (0)
#define PG8_WAIT_V(n) asm volatile("s_waitcnt vmcnt(" #n ")" ::: "memory")
#define PG8_WAIT_L(n) asm volatile("s_waitcnt lgkmcnt(" #n ")" ::: "memory")
#define PG8_BAR __builtin_amdgcn_s_barrier()
#define PG8_SCHED __builtin_amdgcn_sched_barrier(0)
    Unit cur, nxt; int ui = 0;
    if (!S.next(0, cur)) return;
    f32x4 acc[2][2][4][2];
#pragma unroll
    for (int a = 0; a < 2; ++a)
#pragma unroll
        for (int b = 0; b < 2; ++b)
#pragma unroll
            for (int m = 0; m < 4; ++m)
#pragma unroll
                for (int n = 0; n < 2; ++n) acc[a][b][m][n] = (f32x4){0.f, 0.f, 0.f, 0.f};
    bf16x8 At[4][2], B0[2][2], B1[2][2];
    const char* cA = S.pa(g, cur, tstepA); const char* cB = S.pb(g, cur, tstepB);
    S.a_ready(cur);
    if constexpr (SP2) {
        PG8_STAGE(PG8_SB(0, 0), cB, voffB); PG8_STAGE(PG8_SB(0, 1), cB + hstepB, voffB); PG8_STAGE(PG8_SA(0, 0), cA, voffA); PG8_STAGE(PG8_SA(0, 1), cA + hstepA, voffA);
        if (wr == 1) PG8_BAR;
        PG8_WAIT_V(2); PG8_BAR;
        PG8_STAGE(PG8_SB(1, 0), cB + kstep, voffB); PG8_STAGE(PG8_SA(1, 0), cA + kstep, voffA); PG8_STAGE(PG8_SB(1, 1), cB + hstepB + kstep, voffB);
        PG8_WAIT_V(6); PG8_BAR;
    } else {
        PG8_STAGE(PG8_SB(0, 0), cB, voffB); PG8_STAGE(PG8_SA(0, 0), cA, voffA); PG8_STAGE(PG8_SB(0, 1), cB + hstepB, voffB); PG8_STAGE(PG8_SA(0, 1), cA + hstepA, voffA);
        if (wr == 1) PG8_BAR;
        PG8_WAIT_V(4); PG8_BAR;
        PG8_STAGE(PG8_SB(1, 0), cB + kstep, voffB); PG8_STAGE(PG8_SA(1, 0), cA + kstep, voffA); PG8_STAGE(PG8_SB(1, 1), cB + hstepB + kstep, voffB);
        PG8_WAIT_V(6); PG8_BAR;
    }
    for (;;) {
        const bool has_next = S.next(ui + 1, nxt);
        const char* nA = has_next ? S.pa(g, nxt, tstepA) : cA; const char* nB = has_next ? S.pb(g, nxt, tstepB) : cB;
        for (int t = 0; t < nt; t += 2) {
            const bool last = (t == nt - 2);
            const char* a1 = cA + (size_t)(t + 1) * kstep;
            const char* a2 = last ? nA : cA + (size_t)(t + 2) * kstep; const char* b2 = last ? nB : cB + (size_t)(t + 2) * kstep;
            const char* a3 = a2 + kstep; const char* b3 = b2 + kstep;
            if (last && has_next) S.a_ready(nxt);
            if constexpr (SP2) {
            PG8_LDB(B0, 0, 0); PG8_LDB(B1, 0, 1); PG8_SCHED; PG8_LDA(At, 0, 0); PG8_STAGE(PG8_SA(1, 1), a1 + hstepA, voffA);
            PG8_WAIT_V(8); PG8_WAIT_L(0); PG8_BAR; PG8_MMA(0, 0, At, B0); PG8_MMA(0, 1, At, B1); PG8_BAR; PG8_SCHED;
            PG8_LDA(At, 0, 1); PG8_STAGE(PG8_SB(0, 0), b2, voffB); PG8_STAGE(PG8_SB(0, 1), b2 + hstepB, voffB); PG8_STAGE(PG8_SA(0, 0), a2, voffA);
            PG8_WAIT_V(8); PG8_WAIT_L(0); PG8_BAR; PG8_MMA(1, 0, At, B0); PG8_MMA(1, 1, At, B1); PG8_BAR; PG8_SCHED;
            PG8_LDB(B0, 1, 0); PG8_LDB(B1, 1, 1); PG8_SCHED; PG8_LDA(At, 1, 0); PG8_STAGE(PG8_SA(0, 1), a2 + hstepA, voffA);
            PG8_WAIT_V(8); PG8_WAIT_L(0); PG8_BAR; PG8_MMA(0, 0, At, B0); PG8_MMA(0, 1, At, B1); PG8_BAR; PG8_SCHED;
            PG8_LDA(At, 1, 1); PG8_STAGE(PG8_SB(1, 0), b3, voffB); PG8_STAGE(PG8_SB(1, 1), b3 + hstepB, voffB); PG8_STAGE(PG8_SA(1, 0), a3, voffA);
            PG8_WAIT_V(8); PG8_WAIT_L(0); PG8_BAR; PG8_MMA(1, 0, At, B0); PG8_MMA(1, 1, At, B1); PG8_BAR; PG8_SCHED;
            } else {
            PG8_LDB(B0, 0, 0); PG8_SCHED; PG8_LDA(At, 0, 0); PG8_STAGE(PG8_SA(1, 1), a1 + hstepA, voffA);
            PG8_WAIT_L(8); PG8_BAR; PG8_WAIT_L(0); PG8_MMA(0, 0, At, B0); PG8_BAR; PG8_SCHED;
            PG8_LDB(B1, 0, 1); PG8_STAGE(PG8_SB(0, 0), b2, voffB);
            PG8_BAR; PG8_WAIT_L(0); PG8_MMA(0, 1, At, B1); PG8_BAR;
            PG8_LDA(At, 0, 1); PG8_STAGE(PG8_SA(0, 0), a2, voffA);
            PG8_BAR; PG8_WAIT_L(0); PG8_MMA(1, 0, At, B0); PG8_BAR; PG8_SCHED;
            PG8_STAGE(PG8_SB(0, 1), b2 + hstepB, voffB);
            PG8_WAIT_V(6); PG8_BAR; PG8_MMA(1, 1, At, B1); PG8_BAR;
            PG8_LDB(B0, 1, 0); PG8_SCHED; PG8_LDA(At, 1, 0); PG8_STAGE(PG8_SA(0, 1), a2 + hstepA, voffA);
            PG8_WAIT_L(8); PG8_BAR; PG8_WAIT_L(0); PG8_MMA(0, 0, At, B0); PG8_BAR; PG8_SCHED;
            PG8_LDB(B1, 1, 1); PG8_STAGE(PG8_SB(1, 0), b3, voffB);
            PG8_BAR; PG8_WAIT_L(0); PG8_MMA(0, 1, At, B1); PG8_BAR;
            PG8_LDA(At, 1, 1); PG8_STAGE(PG8_SA(1, 0), a3, voffA);
            PG8_BAR; PG8_WAIT_L(0); PG8_MMA(1, 0, At, B0); PG8_BAR; PG8_SCHED;
            PG8_STAGE(PG8_SB(1, 1), b3 + hstepB, voffB);
            PG8_WAIT_V(6); PG8_BAR; PG8_MMA(1, 1, At, B1); PG8_BAR;
            }
        }
        if constexpr (ALIGN_EPI) { if (wr == 0) PG8_BAR; }
        if constexpr (Q8 == 1) asm volatile("s_nop 15\n\ts_nop 15" ::: "memory");
        if constexpr (!Epi::AFTER_DRAIN) { E(acc, cur, wr, wc, fr, fq); S.done(cur); }
        if (!has_next) break;
        if (!Epi::SEGMENTED || cur.seg == 2)
#pragma unroll
        for (int a = 0; a < 2; ++a)
#pragma unroll
            for (int b = 0; b < 2; ++b)
#pragma unroll
                for (int m = 0; m < 4; ++m)
#pragma unroll
                    for (int n = 0; n < 2; ++n) acc[a][b][m][n] = (f32x4){0.f, 0.f, 0.f, 0.f};
        cur = nxt; cA = nA; cB = nB; ++ui;
        if constexpr (ALIGN_EPI) { if (wr == 1) PG8_BAR; }
    }
    PG8_WAIT_V(0);
    if constexpr (!ALIGN_EPI) { if (wr == 0) PG8_BAR; }
    PG8_BAR;
    if constexpr (Epi::AFTER_DRAIN) { E.fused(acc, cur, wr, wc, fr, fq, lds, wid, lane); S.done(cur); }
#undef PG8_SA
#undef PG8_SB
#undef PG8_STAGE
#undef PG8_LDA
#undef PG8_LDB
#undef PG8_MMA
#undef PG8_WAIT_V
#undef PG8_WAIT_L
#undef PG8_BAR
#undef PG8_SCHED
}
}

constexpr int NWAVES = 8;
constexpr int M = 16384, D = 2048, FF = 5632, SEQ = 8192, NL = 4;
constexpr int IN_W = 15376, NIN = 15360, PW = 9216;
constexpr int P_AX = 0, P_AG = 1024, P_BQ = 2048, P_BK = 2560, P_BV = 3072, P_BG = 4096, P_CQ = 5120, P_CF = 6144, P_CI = 7168, P_CG = 8192, P_MG = 9216;
#ifndef H_PITCH
#define H_PITCH 2048
#endif
constexpr int HP = H_PITCH;
constexpr float EPS = 1e-6f;
constexpr size_t MiB = 1u << 20;
constexpr size_t WS_CTL = 0, CTL_ZERO_BYTES = 1 * MiB;
constexpr size_t WS_LB = 1 * MiB;
constexpr size_t WS_CA = 2 * MiB, WS_CH = 3 * MiB, WS_HIN = 4 * MiB, WS_LDT = 5 * MiB;
constexpr size_t WS_W = 8 * MiB, WL_STRIDE = 217 * MiB;
constexpr size_t WL_GU1 = 0, WL_D1 = 44 * MiB, WL_IN = 66 * MiB, WL_GT = 127 * MiB, WL_BR = 131 * MiB, WL_OUT = 143 * MiB, WL_GU2 = 151 * MiB, WL_D2 = 195 * MiB;
constexpr size_t WS_MGQ = (1068 + 288) * MiB;
constexpr size_t WS_XH = 940 * MiB, WS_XL = 1004 * MiB;
constexpr size_t WS_H = 876 * MiB, WS_Y = (1068 + 256) * MiB  , WS_P = 1068 * MiB, WS_YA = 1556 * MiB, WS_YB = 1588 * MiB, WS_YC = 1620 * MiB, WS_XC = 1652 * MiB, WS_GT = 1684 * MiB, WS_MG = 1748 * MiB, WS_SLOC = 1812 * MiB, WS_GG = 1844 * MiB, WS_SIN = 1876 * MiB, WS_END = 1908 * MiB;
static_assert(WS_W + 4 * WL_STRIDE <= WS_H && WS_P + (size_t)M * PW * 2 <= WS_YA, "ws map");
constexpr int CW_TMO = 0, CW_CODE = 1, CW_WMAX = 64  , CW_SMAX = CW_WMAX + 32  , CW_BAR = 4096;
constexpr size_t WS_RS = 1 * MiB + 512 * 1024;
constexpr size_t WS_H8 = 1036 * MiB;
constexpr int RING_OFF = 0, RING_BYTES = 131072;
constexpr int LDSCTL_OFF = 149504, MISC_OFF = LDSCTL_OFF + 320;
constexpr int LDS_BYTES = 155648;

#define GAS __attribute__((address_space(1)))
#define LAS __attribute__((address_space(3)))
typedef unsigned short bf16;
typedef unsigned v4u __attribute__((ext_vector_type(4)));
typedef unsigned v2u __attribute__((ext_vector_type(2)));
typedef float f32x4 __attribute__((ext_vector_type(4)));
typedef float f32x2 __attribute__((ext_vector_type(2)));
typedef GAS unsigned gu32;
static_assert(FP8_F2_S0 >= FP8_S0 && FP8_F2_S0 >= 1 && FP8_S0 <= 2 * NL, "fp8 down GEMM: its input comes from an fp8 gate|up step; the half-step before it collects max |ACT|");
__host__ __device__ constexpr int SL_GU(int s) { return 4 + s - FP8_S0; }
__host__ __device__ constexpr int SL_DN(int s) { return 4 + (2 * NL - FP8_S0) + (s - FP8_F2_S0); }
__host__ __device__ constexpr int SL_ACT(int s) { return 4 + (2 * NL - FP8_S0) + (2 * NL - FP8_F2_S0) + (s - FP8_F2_S0); }
static_assert(SL_ACT(2 * NL) <= 32, "control-word slots");
#define RLX_AGENT __ATOMIC_RELAXED, __HIP_MEMORY_SCOPE_AGENT
#define LDS_WAIT() asm volatile("s_waitcnt lgkmcnt(0)" ::: "memory")
#define VM_WAIT() asm volatile("s_waitcnt vmcnt(0)" ::: "memory")
typedef float f32x2_t __attribute__((ext_vector_type(2))); typedef __bf16 bf16x2_t __attribute__((ext_vector_type(2)));
__device__ __forceinline__ unsigned pk2(float lo, float hi) { f32x2_t v = {lo, hi}; bf16x2_t b = __builtin_convertvector(v, bf16x2_t); return __builtin_bit_cast(unsigned, b); }
__device__ __forceinline__ unsigned f2bf(float f) { return pk2(f, 0.f) & 0xffffu; }
__device__ __forceinline__ float bf2f(unsigned short b) { return __uint_as_float(((unsigned)b) << 16); }
__device__ __forceinline__ float blo(unsigned w) { return __uint_as_float(w << 16); }
__device__ __forceinline__ float bhi(unsigned w) { return __uint_as_float(w & 0xffff0000u); }
__device__ __forceinline__ float fexp(float x) { return __builtin_amdgcn_exp2f(1.44269504089f * x); }
__device__ __forceinline__ float flog(float x) { return 0.69314718056f * __builtin_amdgcn_logf(x); }
__device__ __forceinline__ float frcp(float x) { return __builtin_amdgcn_rcpf(x); }
__device__ __forceinline__ float sigm(float x) { return frcp(1.0f + __builtin_amdgcn_exp2f(-1.44269504089f * x)); }
__device__ __forceinline__ float log_sigm(float x) { return fminf(x, 0.f) - flog(1.0f + fexp(-fabsf(x))); }
__device__ __forceinline__ float gelu_tanh(float x) { const float u = 0.7978845608028654f * (x + 0.044715f * x * x * x); const float t = 1.0f - 2.0f * frcp(fexp(2.0f * u) + 1.0f); return 0.5f * x * (1.0f + t); }
__device__ __forceinline__ float neg_expm1(float x, float ex) { const float ser = -x * (1.0f + x * (0.5f + x * (0.16666667f + x * (0.041666668f + x * 0.0083333338f)))); return x > -0.1f ? ser : 1.0f - ex; }

#define XB_TMO      128
#define XB_XCNT(j)  (256  + 64 * (j))
#define XB_XSUB(j)  (1280 + 64 * (j))
#define XB_XGEN(j)  (2304 + 64 * (j))
#define XB_TOP      3328
#define XB_TOPGEN   3392
#define XCD_BAR_WORDS 3456
#define XB_SPIN_CAP (1u << 18)

__device__ __forceinline__ unsigned xb_ld(unsigned* p)              { return __hip_atomic_load(p, __ATOMIC_RELAXED, __HIP_MEMORY_SCOPE_AGENT); }
__device__ __forceinline__ unsigned xb_add(unsigned* p, unsigned v) { return __hip_atomic_fetch_add(p, v, __ATOMIC_RELAXED, __HIP_MEMORY_SCOPE_AGENT); }
__device__ __forceinline__ unsigned xb_xcc_id() { return (unsigned)__builtin_amdgcn_s_getreg((3 << 11) | 20) & 0xFu; }
#define XB_SPIN(cond, bar) do { unsigned _sp = 0; while (cond) { __builtin_amdgcn_s_sleep(1); \
    if ((++_sp & 255u) == 0u) { if (xb_ld(&(bar)[XB_TMO])) break; if (_sp > XB_SPIN_CAP) { atomicAdd(&(bar)[XB_TMO], 1u); break; } } } } while (0)

struct XcdBarrier {
    unsigned* bar; unsigned x;
    volatile LAS unsigned* st;
};

__device__ __forceinline__ XcdBarrier xcd_barrier_post(unsigned* bar, volatile LAS unsigned* st) {
    XcdBarrier b; b.bar = bar; b.x = xb_xcc_id(); b.st = st;
    if (threadIdx.x == 0) (void)xb_add(&bar[XB_XCNT(b.x)], 1u);
    return b;
}
__device__ __forceinline__ void xcd_barrier_complete(unsigned* bar, unsigned x, unsigned& nloc, unsigned& nx) {
    const unsigned G = gridDim.x * gridDim.y * gridDim.z;
    unsigned sum, cnt, mine, sp = 0u;
    for (;;) {
        sum = 0u; cnt = 0u; mine = 0u;
#pragma unroll
        for (unsigned j = 0; j < 16; ++j) { const unsigned c = xb_ld(&bar[XB_XCNT(j)]); sum += c; cnt += (c > 0u) ? 1u : 0u; mine = (j == x) ? c : mine; }
        if (sum == G) break;
        __builtin_amdgcn_s_sleep(1);
        if ((++sp & 255u) == 0u) { if (xb_ld(&bar[XB_TMO])) break; if (sp > XB_SPIN_CAP) { atomicAdd(&bar[XB_TMO], 1u); break; } }
    }
    nloc = mine > 0u ? mine : 1u; nx = cnt > 0u ? cnt : 1u;
}

__device__ __forceinline__ void xcd_barrier(const XcdBarrier& b) {
    asm volatile("s_waitcnt vmcnt(0)" ::: "memory");
    __syncthreads();
    if (threadIdx.x == 0) {
        unsigned* bar = b.bar;
        __builtin_amdgcn_s_waitcnt(0);
        unsigned nloc = b.st[0], nx = b.st[1];
        if (nloc == 0u) { xcd_barrier_complete(bar, b.x, nloc, nx); b.st[0] = nloc; b.st[1] = nx; }
        const unsigned old = xb_add(&bar[XB_XSUB(b.x)], 1u);
        const unsigned gen = old / nloc;
        if (old + 1u == (gen + 1u) * nloc) {
            __builtin_amdgcn_fence(__ATOMIC_RELEASE, "agent");
            asm volatile("s_waitcnt vmcnt(0)" ::: "memory");
            const unsigned og = xb_add(&bar[XB_TOP], 1u);
            const unsigned tg = og / nx;
            if (og + 1u == (tg + 1u) * nx) xb_add(&bar[XB_TOPGEN], 1u);
            else XB_SPIN(xb_ld(&bar[XB_TOPGEN]) == tg, bar);
            __builtin_amdgcn_fence(__ATOMIC_ACQUIRE, "agent");
            xb_add(&bar[XB_XGEN(b.x)], 1u);
            asm volatile("s_waitcnt vmcnt(0)" ::: "memory");
        } else {
            XB_SPIN(xb_ld(&bar[XB_XGEN(b.x)]) == gen, bar);
            __builtin_amdgcn_fence(__ATOMIC_ACQUIRE, "agent");
            asm volatile("s_waitcnt vmcnt(0)" ::: "memory");
        }
    }
    __syncthreads();
}

struct Args { const float* in[30]; float* out; unsigned char* ws; int ph_lo, ph_hi; };
struct Frame {
    LAS unsigned char* lds;
    volatile LAS unsigned* MISC;
    gu32* ctl;
    int tid, lane, wave, vcu, G, bx;
};
__device__ __forceinline__ float wave_sum(float v) {
#pragma unroll
    for (int o = 1; o < 64; o <<= 1) v += __shfl_xor(v, o);
    return v;
}
__device__ __forceinline__ unsigned pk4_fp8(float a, float b, float c, float d) { int w = 0; w = __builtin_amdgcn_cvt_pk_fp8_f32(a, b, w, false); w = __builtin_amdgcn_cvt_pk_fp8_f32(c, d, w, true); return (unsigned)w; }
__device__ __forceinline__ float pow2_floor(float t) { return __uint_as_float(__float_as_uint(t) & 0x7F800000u); }
__device__ __forceinline__ float fp8_scale(float amax) { return pow2_floor(fminf(440.0f / fmaxf(amax, 1e-30f), 1.0e12f)); }
#ifndef FP8_HEAD
#define FP8_HEAD 8.0f
#endif
__device__ __forceinline__ bool wscale_ok(const unsigned char* ws, int slot) { const gu32* c = (const gu32*)(ws + WS_CTL);
    return __uint_as_float(c[CW_WMAX + slot]) * fp8_scale(FP8_HEAD * __uint_as_float(c[CW_SMAX + slot])) <= 448.0f; }
__device__ __forceinline__ float wscale(const unsigned char* ws, int slot) { const gu32* c = (const gu32*)(ws + WS_CTL);
    const float amax = __uint_as_float(c[CW_WMAX + slot]), s0 = fp8_scale(FP8_HEAD * __uint_as_float(c[CW_SMAX + slot])); return amax * s0 <= 448.0f ? s0 : fp8_scale(amax); }
__device__ __forceinline__ unsigned pk4_i8(float a, float b, float c, float d) {
    const unsigned ua = __float_as_uint(a + 12582912.0f), ub = __float_as_uint(b + 12582912.0f), uc = __float_as_uint(c + 12582912.0f), ud = __float_as_uint(d + 12582912.0f);
    return (ua & 0xFFu) | ((ub & 0xFFu) << 8) | ((uc & 0xFFu) << 16) | (ud << 24);
}
__device__ __forceinline__ float clamp127(float v) { return __builtin_amdgcn_fmed3f(v, -127.0f, 127.0f); }
__device__ __forceinline__ float h8_scale(const float* g, int ln) {
    float gm = 0.f;
#pragma unroll
    for (int j = 0; j < 4; ++j) { const f32x4 a = ((const GAS f32x4*)g)[2 * (64 * j + ln)], b = ((const GAS f32x4*)g)[2 * (64 * j + ln) + 1];
        gm = fmaxf(gm, fmaxf(fmaxf(fmaxf(fabsf(a.x), fabsf(a.y)), fmaxf(fabsf(a.z), fabsf(a.w))), fmaxf(fmaxf(fabsf(b.x), fabsf(b.y)), fmaxf(fabsf(b.z), fabsf(b.w))))); }
#pragma unroll
    for (int o = 1; o < 64; o <<= 1) gm = fmaxf(gm, __shfl_xor(gm, o));
    return fp8_scale(45.2548339959f * gm);
}
template <int MAP> __device__ __forceinline__ int dest_row(int n) {
    if (MAP == 1) return 256 * (n >> 7) + (n & 127);
    if (MAP == 2) return 256 * (n >> 7) + 128 + (n & 127);
    if (MAP == 3) return n < 5120 ? n : (n < 5136 ? 15360 + (n - 5120) : n - 16);
    if (MAP == 5) return n < 5120 ? n : (n < 5136 ? 15360 + (n - 5120) : n - 16);
    if (MAP == 4) return n - 9232;
    return n;
}
template <int MAP> __device__ __forceinline__ void p0_item(const float* W, int K, int N, bf16* WT, LAS float* scr, int item, int lane) {
    const int nblk = (N + 31) / 32, kb = item / nblk, nb = item % nblk, k0 = 64 * kb, n0 = 32 * nb;
    const int nn = n0 + (lane & 31); const bool okr = nn < N;
#pragma unroll
    for (int i = 0; i < 32; ++i) { const int kk = 2 * i + (lane >> 5); scr[kk * 33 + (lane & 31)] = okr ? W[(size_t)(k0 + kk) * N + nn] : 0.f; }
    LDS_WAIT(); asm volatile("" ::: "memory");
    const int c = lane & 7;
#pragma unroll
    for (int j = 0; j < 4; ++j) { const int n = (lane >> 3) + 8 * j; const LAS float* s = scr + (8 * c) * 33 + n;
        v4u o; o.x = pk2(s[0 * 33], s[1 * 33]); o.y = pk2(s[2 * 33], s[3 * 33]); o.z = pk2(s[4 * 33], s[5 * 33]); o.w = pk2(s[6 * 33], s[7 * 33]);
        if (n0 + n < N && !(MAP == 3 && n0 + n >= 9232)) __builtin_nontemporal_store(o, (GAS v4u*)(WT + (size_t)dest_row<MAP>(n0 + n) * K + k0 + 8 * c)); }
    LDS_WAIT(); asm volatile("" ::: "memory");
}
__device__ __forceinline__ float p0_absmax_item(const float* W, int K, int N, int item, int lane, int nmin) {
    (void)K; const int nblk = (N + 31) / 32, kb = item / nblk, nb = item % nblk, k0 = 64 * kb, n0 = 32 * nb;
    const int nn = n0 + (lane & 31); const bool okr = nn < N && nn >= nmin;
    float m = 0.f;
#pragma unroll
    for (int i = 0; i < 32; ++i) { const int kk = 2 * i + (lane >> 5); m = fmaxf(m, fabsf(okr ? W[(size_t)(k0 + kk) * N + nn] : 0.f)); }
    return m;
}
__device__ __forceinline__ float p0_sumsq_item(const float* W, int K, int N, int item, int lane) {
    (void)K; const int nblk = (N + 31) / 32, kb = item / nblk, nb = item % nblk, k0 = 64 * kb, n0 = 32 * nb;
    const int nn = n0 + (lane & 31); const bool okr = nn < N;
    float m = 0.f;
#pragma unroll
    for (int i = 0; i < 32; ++i) { const int kk = 2 * i + (lane >> 5); const float v = okr ? W[(size_t)(k0 + kk) * N + nn] : 0.f; m += v * v; }
    return m;
}
template <int MAP> __device__ __forceinline__ float p0_item8(const float* W, int K, int N, unsigned char* W8, LAS float* scr, int item, int lane, float sW, bool i8 = false) {
    const int nblk = (N + 31) / 32, kb = item / nblk, nb = item % nblk, k0 = 64 * kb, n0 = 32 * nb;
    const int nn = n0 + (lane & 31); const bool okr = nn < N;
    float mx = 0.f; const bool cnt = !(MAP == 4 && nn < 9232);
#pragma unroll
    for (int i = 0; i < 32; ++i) { const int kk = 2 * i + (lane >> 5); const float v = okr ? W[(size_t)(k0 + kk) * N + nn] : 0.f; scr[kk * 33 + (lane & 31)] = v; mx = fmaxf(mx, cnt ? fabsf(v) : 0.f); }
    LDS_WAIT(); asm volatile("" ::: "memory");
    const int c = lane & 7;
#pragma unroll
    for (int j = 0; j < 4; ++j) { const int n = (lane >> 3) + 8 * j; const LAS float* s = scr + (8 * c) * 33 + n;
        v2u o; if (i8) { o.x = pk4_i8(clamp127(s[0 * 33] * sW), clamp127(s[1 * 33] * sW), clamp127(s[2 * 33] * sW), clamp127(s[3 * 33] * sW)); o.y = pk4_i8(clamp127(s[4 * 33] * sW), clamp127(s[5 * 33] * sW), clamp127(s[6 * 33] * sW), clamp127(s[7 * 33] * sW)); }
        else { o.x = pk4_fp8(s[0 * 33] * sW, s[1 * 33] * sW, s[2 * 33] * sW, s[3 * 33] * sW); o.y = pk4_fp8(s[4 * 33] * sW, s[5 * 33] * sW, s[6 * 33] * sW, s[7 * 33] * sW); }
        if (n0 + n < N && !(MAP == 4 && n0 + n < 9232)) __builtin_nontemporal_store(o, (GAS v2u*)(W8 + (size_t)dest_row<MAP>(n0 + n) * K + k0 + 8 * c)); }
    LDS_WAIT(); asm volatile("" ::: "memory");
    return mx;
}
constexpr int NBLK_IN = (IN_W + 31) / 32, MG_N0 = IN_W - 6144  , MG_NB0 = MG_N0 / 32, I_MG = (D / 64) * (NBLK_IN - MG_NB0);
constexpr size_t WL_IN8 = 40 * MiB;
constexpr int I_GATE = (D / 64) * (FF / 32), I_DOWN = (FF / 64) * (D / 32), I_IN = (D / 64) * ((IN_W + 31) / 32), I_BR = (1024 / 64) * (D / 32), I_OUT = (D / 64) * (D / 32);
constexpr int I_LAYER = 2 * (2 * I_GATE + I_DOWN) + I_IN + 3 * I_BR + I_OUT;

__device__ __forceinline__ void x_pack8(const f32x4 va, const f32x4 vb, v4u& hi, v2u& lo) {
    unsigned r[8];
#pragma unroll
    for (int k = 0; k < 4; ++k) { const float fa = va[k], fb = vb[k]; const unsigned ua = __float_as_uint(fa), ub = __float_as_uint(fb);
        r[k] = (ua + 0x7Fu + ((ua >> 8) & 1u)) >> 8; r[4 + k] = (ub + 0x7Fu + ((ub >> 8) & 1u)) >> 8; }
    hi.x = (r[0] >> 8) | ((r[1] >> 8) << 16); hi.y = (r[2] >> 8) | ((r[3] >> 8) << 16); hi.z = (r[4] >> 8) | ((r[5] >> 8) << 16); hi.w = (r[6] >> 8) | ((r[7] >> 8) << 16);
    lo.x = (r[0] & 0xFFu) | ((r[1] & 0xFFu) << 8) | ((r[2] & 0xFFu) << 16) | (r[3] << 24); lo.y = (r[4] & 0xFFu) | ((r[5] & 0xFFu) << 8) | ((r[6] & 0xFFu) << 16) | (r[7] << 24);
}
__device__ __forceinline__ f32x4 x_unpack4(const unsigned h0, const unsigned h1, const unsigned lo) {
    f32x4 v; v.x = __uint_as_float((h0 << 16) | ((lo & 0xFFu) << 8)); v.y = __uint_as_float((h0 & 0xFFFF0000u) | (lo & 0xFF00u));
    v.z = __uint_as_float((h1 << 16) | ((lo >> 8) & 0xFF00u)); v.w = __uint_as_float((h1 & 0xFFFF0000u) | ((lo >> 16) & 0xFF00u)); return v;
}
__device__ __forceinline__ f32x4 bf4(const unsigned a, const unsigned b) { return (f32x4){blo(a), bhi(a), blo(b), bhi(b)}; }
__device__ __forceinline__ void rowpass(const Frame& F, const float* xin32, const unsigned short* xih, const unsigned char* xil, const bf16* Y, float* xo32, unsigned short* xoh, unsigned char* xol,
                                        const float* gpost, float scale, const float* gpre, bf16* H, unsigned char* H8 = nullptr, float* RS = nullptr) {
    const int gw = F.vcu * NWAVES + F.wave, NGW = F.G * NWAVES, ln = F.lane;
    const float s8 = (H8 && !RS) ? h8_scale(gpre, ln) : 0.f;
    f32x4 gq[8];
#pragma unroll
    for (int j = 0; j < 4; ++j) { gq[2 * j] = Y ? ((const GAS f32x4*)gpost)[2 * (64 * j + ln)] : (f32x4){0.f, 0.f, 0.f, 0.f}; gq[2 * j + 1] = Y ? ((const GAS f32x4*)gpost)[2 * (64 * j + ln) + 1] : (f32x4){0.f, 0.f, 0.f, 0.f}; }
    for (int m = gw; m < M; m += 2 * NGW) {
        const int m1 = m + NGW;
        f32x4 x0[8], x1[8];
        if (xin32) { const GAS f32x4* xr0 = (const GAS f32x4*)(xin32 + (size_t)m * D) + 2 * ln; const GAS f32x4* xr1 = (const GAS f32x4*)(xin32 + (size_t)m1 * D) + 2 * ln;
#pragma unroll
            for (int j = 0; j < 4; ++j) { x0[2 * j] = xr0[128 * j]; x0[2 * j + 1] = xr0[128 * j + 1]; x1[2 * j] = xr1[128 * j]; x1[2 * j + 1] = xr1[128 * j + 1]; } }
        else { const GAS v4u* h0 = (const GAS v4u*)(xih + (size_t)m * D) + ln; const GAS v4u* h1 = (const GAS v4u*)(xih + (size_t)m1 * D) + ln;
            const GAS v2u* l0 = (const GAS v2u*)(xil + (size_t)m * D) + ln; const GAS v2u* l1 = (const GAS v2u*)(xil + (size_t)m1 * D) + ln;
            v4u a0[4], a1[4]; v2u b0[4], b1[4];
#pragma unroll
            for (int j = 0; j < 4; ++j) { a0[j] = __builtin_nontemporal_load(h0 + 64 * j); a1[j] = __builtin_nontemporal_load(h1 + 64 * j); b0[j] = __builtin_nontemporal_load(l0 + 64 * j); b1[j] = __builtin_nontemporal_load(l1 + 64 * j); }
#pragma unroll
            for (int j = 0; j < 4; ++j) { x0[2 * j] = x_unpack4(a0[j].x, a0[j].y, b0[j].x); x0[2 * j + 1] = x_unpack4(a0[j].z, a0[j].w, b0[j].y); x1[2 * j] = x_unpack4(a1[j].x, a1[j].y, b1[j].x); x1[2 * j + 1] = x_unpack4(a1[j].z, a1[j].w, b1[j].y); } }
        if (Y) {
            const GAS v4u* yr0 = (const GAS v4u*)(Y + (size_t)m * D) + ln; const GAS v4u* yr1 = (const GAS v4u*)(Y + (size_t)m1 * D) + ln;
            v4u y0[4], y1[4]; float s0 = 0.f, s1 = 0.f;
#pragma unroll
            for (int j = 0; j < 4; ++j) { y0[j] = __builtin_nontemporal_load(yr0 + 64 * j); y1[j] = __builtin_nontemporal_load(yr1 + 64 * j); }
#pragma unroll
            for (int j = 0; j < 4; ++j) { const f32x4 a = bf4(y0[j].x, y0[j].y), b = bf4(y0[j].z, y0[j].w), c = bf4(y1[j].x, y1[j].y), d = bf4(y1[j].z, y1[j].w);
                s0 += ((a.x * a.x + a.y * a.y) + (a.z * a.z + a.w * a.w)) + ((b.x * b.x + b.y * b.y) + (b.z * b.z + b.w * b.w));
                s1 += ((c.x * c.x + c.y * c.y) + (c.z * c.z + c.w * c.w)) + ((d.x * d.x + d.y * d.y) + (d.z * d.z + d.w * d.w)); }
#pragma unroll
            for (int o = 1; o < 64; o <<= 1) { s0 += __shfl_xor(s0, o); s1 += __shfl_xor(s1, o); }
            const float r0 = scale * rsqrtf(s0 * (1.f / D) + EPS), r1 = scale * rsqrtf(s1 * (1.f / D) + EPS);
#pragma unroll
            for (int j = 0; j < 4; ++j) { x0[2 * j] = x0[2 * j] + bf4(y0[j].x, y0[j].y) * gq[2 * j] * r0; x0[2 * j + 1] = x0[2 * j + 1] + bf4(y0[j].z, y0[j].w) * gq[2 * j + 1] * r0;
                x1[2 * j] = x1[2 * j] + bf4(y1[j].x, y1[j].y) * gq[2 * j] * r1; x1[2 * j + 1] = x1[2 * j + 1] + bf4(y1[j].z, y1[j].w) * gq[2 * j + 1] * r1; }
            if (xo32) { GAS f32x4* xo0 = (GAS f32x4*)(xo32 + (size_t)m * D) + 2 * ln; GAS f32x4* xo1 = (GAS f32x4*)(xo32 + (size_t)m1 * D) + 2 * ln;
#pragma unroll
                for (int j = 0; j < 4; ++j) { xo0[128 * j] = x0[2 * j]; xo0[128 * j + 1] = x0[2 * j + 1]; xo1[128 * j] = x1[2 * j]; xo1[128 * j + 1] = x1[2 * j + 1]; } }
            else { GAS v4u* h0 = (GAS v4u*)(xoh + (size_t)m * D) + ln; GAS v4u* h1 = (GAS v4u*)(xoh + (size_t)m1 * D) + ln;
                GAS v2u* l0 = (GAS v2u*)(xol + (size_t)m * D) + ln; GAS v2u* l1 = (GAS v2u*)(xol + (size_t)m1 * D) + ln;
#pragma unroll
                for (int j = 0; j < 4; ++j) { v4u a; v2u b; x_pack8(x0[2 * j], x0[2 * j + 1], a, b); __builtin_nontemporal_store(a, h0 + 64 * j); __builtin_nontemporal_store(b, l0 + 64 * j); x_pack8(x1[2 * j], x1[2 * j + 1], a, b); __builtin_nontemporal_store(a, h1 + 64 * j); __builtin_nontemporal_store(b, l1 + 64 * j); } }
        }
        if (H || H8) {
            float s0 = 0.f, s1 = 0.f;
#pragma unroll
            for (int j = 0; j < 8; ++j) { s0 += (x0[j].x * x0[j].x + x0[j].y * x0[j].y) + (x0[j].z * x0[j].z + x0[j].w * x0[j].w); s1 += (x1[j].x * x1[j].x + x1[j].y * x1[j].y) + (x1[j].z * x1[j].z + x1[j].w * x1[j].w); }
#pragma unroll
            for (int o = 1; o < 64; o <<= 1) { s0 += __shfl_xor(s0, o); s1 += __shfl_xor(s1, o); }
            const float r0 = rsqrtf(s0 * (1.f / D) + EPS), r1 = rsqrtf(s1 * (1.f / D) + EPS);
            GAS v4u* ho0 = (GAS v4u*)(H + (size_t)m * HP) + ln; GAS v4u* ho1 = (GAS v4u*)(H + (size_t)m1 * HP) + ln;
            float q0 = s8, q1 = s8;
            if (RS) { float m0 = 0.f, mm1 = 0.f;
#pragma unroll
                for (int j = 0; j < 4; ++j) { const f32x4 ga = ((const GAS f32x4*)gpre)[2 * (64 * j + ln)], gb = ((const GAS f32x4*)gpre)[2 * (64 * j + ln) + 1];
                    const f32x4 a = x0[2 * j] * ga, b = x0[2 * j + 1] * gb, c = x1[2 * j] * ga, d = x1[2 * j + 1] * gb;
                    m0 = fmaxf(m0, fmaxf(fmaxf(fmaxf(fabsf(a.x), fabsf(a.y)), fmaxf(fabsf(a.z), fabsf(a.w))), fmaxf(fmaxf(fabsf(b.x), fabsf(b.y)), fmaxf(fabsf(b.z), fabsf(b.w)))));
                    mm1 = fmaxf(mm1, fmaxf(fmaxf(fmaxf(fabsf(c.x), fabsf(c.y)), fmaxf(fabsf(c.z), fabsf(c.w))), fmaxf(fmaxf(fabsf(d.x), fabsf(d.y)), fmaxf(fabsf(d.z), fabsf(d.w))))); }
#pragma unroll
                for (int o = 1; o < 64; o <<= 1) { m0 = fmaxf(m0, __shfl_xor(m0, o)); mm1 = fmaxf(mm1, __shfl_xor(mm1, o)); }
                const float h0 = fmaxf(m0 * r0, 1e-30f), h1 = fmaxf(mm1 * r1, 1e-30f); q0 = 127.0f / h0; q1 = 127.0f / h1;
                if (ln == 0) { RS[m] = h0 * (1.0f / 127.0f); RS[m1] = h1 * (1.0f / 127.0f); } }
#pragma unroll
            for (int j = 0; j < 4; ++j) { const f32x4 ga = ((const GAS f32x4*)gpre)[2 * (64 * j + ln)], gb = ((const GAS f32x4*)gpre)[2 * (64 * j + ln) + 1];
                const f32x4 a = x0[2 * j] * ga * r0, b = x0[2 * j + 1] * gb * r0, c = x1[2 * j] * ga * r1, d = x1[2 * j + 1] * gb * r1;
                if (H) { ho0[64 * j] = (v4u){pk2(a.x, a.y), pk2(a.z, a.w), pk2(b.x, b.y), pk2(b.z, b.w)}; ho1[64 * j] = (v4u){pk2(c.x, c.y), pk2(c.z, c.w), pk2(d.x, d.y), pk2(d.z, d.w)}; }
                if (H8) { const f32x4 a8 = a * q0, b8 = b * q0, c8 = c * q1, d8 = d * q1;
                    if (RS) { ((GAS v2u*)(H8 + (size_t)m * D) + ln)[64 * j] = (v2u){pk4_i8(clamp127(a8.x), clamp127(a8.y), clamp127(a8.z), clamp127(a8.w)), pk4_i8(clamp127(b8.x), clamp127(b8.y), clamp127(b8.z), clamp127(b8.w))};
                        ((GAS v2u*)(H8 + (size_t)m1 * D) + ln)[64 * j] = (v2u){pk4_i8(clamp127(c8.x), clamp127(c8.y), clamp127(c8.z), clamp127(c8.w)), pk4_i8(clamp127(d8.x), clamp127(d8.y), clamp127(d8.z), clamp127(d8.w))}; }
                    else { ((GAS v2u*)(H8 + (size_t)m * D) + ln)[64 * j] = (v2u){pk4_fp8(a8.x, a8.y, a8.z, a8.w), pk4_fp8(b8.x, b8.y, b8.z, b8.w)}; ((GAS v2u*)(H8 + (size_t)m1 * D) + ln)[64 * j] = (v2u){pk4_fp8(c8.x, c8.y, c8.z, c8.w), pk4_fp8(d8.x, d8.y, d8.z, d8.w)}; } } }
        }
    }
}

__device__ __forceinline__ void conv_item(const bf16* P, const float* cw, const float* cb, bf16* XC, int c8, int m0) {
    const int t0 = m0 & (SEQ - 1);
    float w[4][8], bb[8];
#pragma unroll
    for (int k = 0; k < 4; ++k) { const f32x4 a = *(const GAS f32x4*)(cw + k * 1024 + c8), b = *(const GAS f32x4*)(cw + k * 1024 + c8 + 4); w[k][0] = a.x; w[k][1] = a.y; w[k][2] = a.z; w[k][3] = a.w; w[k][4] = b.x; w[k][5] = b.y; w[k][6] = b.z; w[k][7] = b.w; }
    { const f32x4 a = *(const GAS f32x4*)(cb + c8), b = *(const GAS f32x4*)(cb + c8 + 4); bb[0] = a.x; bb[1] = a.y; bb[2] = a.z; bb[3] = a.w; bb[4] = b.x; bb[5] = b.y; bb[6] = b.z; bb[7] = b.w; }
    v4u r[19];
#pragma unroll
    for (int i = 0; i < 19; ++i) r[i] = (t0 + i - 3 >= 0) ? *(const GAS v4u*)(P + (size_t)(m0 + i - 3) * PW + P_AX + c8) : (v4u){0u, 0u, 0u, 0u};
#pragma unroll
    for (int t = 0; t < 16; ++t) { float acc[8];
#pragma unroll
        for (int e = 0; e < 8; ++e) acc[e] = bb[e];
#pragma unroll
        for (int k = 0; k < 4; ++k) { const v4u q = r[t + k];
            acc[0] += w[k][0] * blo(q.x); acc[1] += w[k][1] * bhi(q.x); acc[2] += w[k][2] * blo(q.y); acc[3] += w[k][3] * bhi(q.y); acc[4] += w[k][4] * blo(q.z); acc[5] += w[k][5] * bhi(q.z); acc[6] += w[k][6] * blo(q.w); acc[7] += w[k][7] * bhi(q.w); }
        *(GAS v4u*)(XC + (size_t)(m0 + t) * 1024 + c8) = (v4u){pk2(acc[0], acc[1]), pk2(acc[2], acc[3]), pk2(acc[4], acc[5]), pk2(acc[6], acc[7])}; }
}

constexpr int LRU_LDS = 0;
template <bool FINAL> __device__ __forceinline__ void lru_chunk_phase(const Frame& F, const unsigned char* GT, const bf16* XC, const bf16* P, const float* ba, const float* bx, const float* lam,
                                                                    float* CA, float* CH, const float* HIN, bf16* YA, int u0, int u1) {
    LAS float* XA = (LAS float*)(F.lds + LRU_LDS); LAS float* XH = XA + 2048;
    const int c4l = F.lane, part = F.wave;
    {
#pragma unroll 1
        for (int uu = u0; uu < u1; ++uu) { const int c = uu >> 2, r = uu & 3;
            const int ch = 256 * r + 4 * c4l, gc = 256 * (ch >> 7) + (ch & 127); const size_t m0 = (size_t)c * 64 + 8 * part;
            const f32x4 lm = *(const GAS f32x4*)(lam + ch);
            float sp8[4];
#pragma unroll
            for (int e = 0; e < 4; ++e) sp8[e] = (-8.0f / 255.0f) * (flog(1.0f + fexp(-fabsf(lm[e]))) + fmaxf(-lm[e], 0.f));
            float av[8][4], uv[8][4]; float A[4] = {1.f, 1.f, 1.f, 1.f}, Hs[4] = {0.f, 0.f, 0.f, 0.f};
            v2u gwv[8];
#pragma unroll
            for (int t = 0; t < 8; ++t) {
                const unsigned rw = *(const GAS unsigned*)(GT + (m0 + t) * 2048 + gc), iw = *(const GAS unsigned*)(GT + (m0 + t) * 2048 + 128 + gc); const v2u xw = *(const GAS v2u*)(XC + (m0 + t) * 1024 + ch);
                gwv[t] = FINAL ? *(const GAS v2u*)(P + (m0 + t) * PW + P_AG + ch) : (v2u){0u, 0u};
                const float rp[4] = {(float)(rw & 0xFFu), (float)((rw >> 8) & 0xFFu), (float)((rw >> 16) & 0xFFu), (float)(rw >> 24)}, ip[4] = {(float)(iw & 0xFFu), (float)((iw >> 8) & 0xFFu), (float)((iw >> 16) & 0xFFu), (float)(iw >> 24)}, xc[4] = {blo(xw.x), bhi(xw.x), blo(xw.y), bhi(xw.y)};
#pragma unroll
                for (int e = 0; e < 4; ++e) { const float la = rp[e] * sp8[e], a = fexp(la);
                    const float u = __builtin_amdgcn_sqrtf(fmaxf(neg_expm1(2.0f * la, a * a), 0.f)) * (ip[e] * xc[e] * (1.0f / 255.0f));
                    av[t][e] = a; uv[t][e] = u; A[e] *= a; Hs[e] = a * Hs[e] + u; }
            }
            *(LAS f32x4*)(XA + part * 256 + 4 * c4l) = (f32x4){A[0], A[1], A[2], A[3]}; *(LAS f32x4*)(XH + part * 256 + 4 * c4l) = (f32x4){Hs[0], Hs[1], Hs[2], Hs[3]};
            __syncthreads();
            if (!FINAL) {
                if (part == 0) { f32x4 At = (f32x4){1.f, 1.f, 1.f, 1.f}, Ht = (f32x4){0.f, 0.f, 0.f, 0.f};
#pragma unroll
                    for (int qq = 0; qq < 8; ++qq) { const f32x4 a = *(const LAS f32x4*)(XA + qq * 256 + 4 * c4l), hh = *(const LAS f32x4*)(XH + qq * 256 + 4 * c4l); Ht = a * Ht + hh; At = At * a; }
                    *(GAS f32x4*)(CA + (size_t)c * 1024 + ch) = At; *(GAS f32x4*)(CH + (size_t)c * 1024 + ch) = Ht; }
            } else {
                f32x4 h = *(const GAS f32x4*)(HIN + (size_t)c * 1024 + ch);
#pragma unroll
                for (int qq = 0; qq < 7; ++qq) if (qq < part) { const f32x4 a = *(const LAS f32x4*)(XA + qq * 256 + 4 * c4l), hh = *(const LAS f32x4*)(XH + qq * 256 + 4 * c4l); h = a * h + hh; }
#pragma unroll
                for (int t = 0; t < 8; ++t) { const v2u gw = gwv[t]; const float g[4] = {blo(gw.x), bhi(gw.x), blo(gw.y), bhi(gw.y)}; float y[4];
#pragma unroll
                    for (int e = 0; e < 4; ++e) { h[e] = av[t][e] * h[e] + uv[t][e]; y[e] = gelu_tanh(g[e]) * h[e]; }
                    *(GAS v2u*)(YA + (m0 + t) * 1024 + ch) = (v2u){pk2(y[0], y[1]), pk2(y[2], y[3])}; }
            }
            __syncthreads();
        }
    }
}
__device__ __forceinline__ void lru_carry_phase(const Frame& F, const float* CA, const float* CH, float* HIN) {
    if (F.bx < 32) {
        LAS float* XA = (LAS float*)(F.lds + LRU_LDS); LAS float* XH = XA + 512;
        const int b = F.bx >> 4, ch = (F.bx & 15) * 64 + F.lane, part = F.wave;
        float a[16], hh[16]; float At = 1.f, Ht = 0.f;
#pragma unroll
        for (int k = 0; k < 16; ++k) { const size_t i = (size_t)(b * 128 + part * 16 + k) * 1024 + ch; a[k] = CA[i]; hh[k] = CH[i]; }
#pragma unroll
        for (int k = 0; k < 16; ++k) { Ht = a[k] * Ht + hh[k]; At *= a[k]; }
        XA[part * 64 + F.lane] = At; XH[part * 64 + F.lane] = Ht;
        __syncthreads();
        float h = 0.f;
#pragma unroll
        for (int pp = 0; pp < 7; ++pp) if (pp < part) h = XA[pp * 64 + F.lane] * h + XH[pp * 64 + F.lane];
#pragma unroll
        for (int k = 0; k < 16; ++k) { const size_t i = (size_t)(b * 128 + part * 16 + k) * 1024 + ch; HIN[i] = h; h = a[k] * h + hh[k]; }
        __syncthreads();
    }
}

typedef short bf16x8 __attribute__((ext_vector_type(8)));
__device__ __forceinline__ void lrgg_phase(const Frame& F, const bf16* H, const bf16* WlrT, const float* w2, const float* b2, float* GG) {
    LAS float* PART = (LAS float*)(F.lds); LAS float* LR = (LAS float*)(F.lds + 32768);
    const int w = F.wave, lane = F.lane, l15 = lane & 15, g4 = lane >> 4;
    for (int tb = F.vcu; tb < M / 64; tb += F.G) {
        bf16x8 bw[8];
#pragma unroll
        for (int ks = 0; ks < 8; ++ks) bw[ks] = *(const GAS bf16x8*)(WlrT + (size_t)l15 * 2048 + 256 * w + 32 * ks + 8 * g4);
#pragma unroll
        for (int mt = 0; mt < 4; ++mt) { f32x4 acc = (f32x4){0.f, 0.f, 0.f, 0.f}; const bf16* hr = H + (size_t)(64 * tb + 16 * mt + l15) * HP + 256 * w + 8 * g4;
            bf16x8 af[8];
#pragma unroll
            for (int ks = 0; ks < 8; ++ks) af[ks] = *(const GAS bf16x8*)(hr + 32 * ks);
#pragma unroll
            for (int ks = 0; ks < 8; ++ks) acc = __builtin_amdgcn_mfma_f32_16x16x32_bf16(af[ks], bw[ks], acc, 0, 0, 0);
            *(LAS f32x4*)(PART + ((w * 4 + mt) * 64 + lane) * 4) = acc; }
        __syncthreads();
#pragma unroll
        for (int o = F.tid; o < 1024; o += 512) { const int t = o >> 4, n = o & 15, mt = t >> 4, tl = t & 15, ln = n + 16 * (tl >> 2), r = tl & 3; float sum = 0.f;
#pragma unroll
            for (int ww = 0; ww < 8; ++ww) sum += PART[((ww * 4 + mt) * 64 + ln) * 4 + r];
            LR[t * 16 + n] = sum; }
        __syncthreads();
        { const int d = F.tid; float wc[16];
#pragma unroll
          for (int r = 0; r < 16; ++r) wc[r] = w2[r * 512 + d];
          const float bb = b2[d];
#pragma unroll 4
          for (int t = 0; t < 64; ++t) { const f32x4 a0 = *(const LAS f32x4*)(LR + t * 16), a1 = *(const LAS f32x4*)(LR + t * 16 + 4), a2 = *(const LAS f32x4*)(LR + t * 16 + 8), a3 = *(const LAS f32x4*)(LR + t * 16 + 12);
              float x = bb + a0.x * wc[0] + a0.y * wc[1] + a0.z * wc[2] + a0.w * wc[3] + a1.x * wc[4] + a1.y * wc[5] + a1.z * wc[6] + a1.w * wc[7] + a2.x * wc[8] + a2.y * wc[9] + a2.z * wc[10] + a2.w * wc[11] + a3.x * wc[12] + a3.y * wc[13] + a3.z * wc[14] + a3.w * wc[15];
              GG[(size_t)(64 * tb + t) * 512 + d] = log_sigm(x) * 0.0625f; } }
        __syncthreads();
    }
}

constexpr int LA_QT = 0, LA_QP = 17408, LA_KP = 34816, LA_KHT = 78336, LA_VT = 96768, LA_PS = 133632, LA_DEC = 142848, LA_T8 = 143360, LA_NRM = 147456, LA_END = 149504;
constexpr int QS = 272, TS = 144, OBS = 528;
constexpr size_t SLOC_HGRN_OFF = (size_t)128 * 128 * 256;
__device__ __forceinline__ bf16x8 mk8(v2u lo, v2u hi) { v4u t; t.x = lo.x; t.y = lo.y; t.z = hi.x; t.w = hi.y; return __builtin_bit_cast(bf16x8, t); }
template <int TYPE, bool FULL>
__device__ __forceinline__ void la_segment(const Frame& F, int item, const bf16* P, const float* GG, const float* LBl, const float* gn, float* SLOC, float* LDT, const float* SIN, bf16* Y) {
    constexpr int DV = TYPE == 0 ? 256 : 128, NVT = DV / 128, NSEG = TYPE == 0 ? 16 : 8, NCH = 128 / NSEG;
    const int lane = F.lane, w = F.wave, g4 = lane >> 4, l15 = lane & 15, p = lane;
    int bh, seg, b, h;
    if (TYPE == 0) { bh = item >> 4; seg = item & 15; b = bh >> 2; h = bh & 3; } else { bh = item >> 3; seg = item & 7; b = bh >> 3; h = bh & 7; }
    const int qoff = (TYPE == 0 ? P_BQ : P_CQ) + h * 128, koff = (TYPE == 0 ? P_BK : P_CF) + h * 128, voff = TYPE == 0 ? P_BV + h * 256 : P_CI + h * 128, goff = TYPE == 0 ? P_BG + h * 256 : P_CG + h * 128;
    LAS unsigned char* L = F.lds;
    float* slb = SLOC + (TYPE == 0 ? (size_t)0 : SLOC_HGRN_OFF); float* ldb = LDT + (TYPE == 0 ? 0 : 128 * 128);
    f32x4 S[NVT][8];
#pragma unroll
    for (int vt = 0; vt < NVT; ++vt)
#pragma unroll
        for (int dt = 0; dt < 8; ++dt) S[vt][dt] = (f32x4){0.f, 0.f, 0.f, 0.f};
    float ldsa = 0.f, ldsb = 0.f;
    if (FULL) {
        for (int i = F.tid; i < (64 * TS) / 4; i += 512) ((LAS unsigned*)(L + LA_PS))[i] = 0u;
        if (seg > 0) { const float* si = SIN + (TYPE == 0 ? (size_t)0 : SLOC_HGRN_OFF) + (size_t)item * (128 * DV);
#pragma unroll
            for (int vt = 0; vt < NVT; ++vt)
#pragma unroll
                for (int dt = 0; dt < 8; ++dt) S[vt][dt] = *(const GAS f32x4*)(si + ((size_t)(((w * NVT + vt) * 8 + dt) * 64 + lane)) * 4); }
        __syncthreads();
    }
    unsigned qr[8], kr[8]; f32x2 gr[8]; v2u vr[8];
#define LA_BAR() do { asm volatile("s_waitcnt lgkmcnt(0)" ::: "memory"); __builtin_amdgcn_s_barrier(); asm volatile("" ::: "memory"); } while (0)
#define LA_LOAD_RAW(chn) do { const bf16* Pr = P + (size_t)(b * SEQ + (seg * NCH + (chn)) * 64 + 8 * w) * PW; const float* Gr = GG + (size_t)(b * SEQ + (seg * NCH + (chn)) * 64 + 8 * w) * 512 + h * 128 + 2 * p; \
        _Pragma("unroll") for (int j = 0; j < 8; ++j) { const bf16* Pj = Pr + (size_t)j * PW; \
            qr[j] = FULL ? *(const GAS unsigned*)(Pj + qoff + 2 * p) : 0u; kr[j] = *(const GAS unsigned*)(Pj + koff + 2 * p); \
            if (TYPE == 0) gr[j] = *(const GAS f32x2*)(Gr + (size_t)j * 512); else gr[j] = (f32x2){0.f, 0.f}; \
            if (DV == 256) vr[j] = *(const GAS v2u*)(Pj + voff + 4 * p); else { vr[j].x = *(const GAS unsigned*)(Pj + voff + 2 * p); vr[j].y = 0u; } } } while (0)
    LA_LOAD_RAW(0);
    f32x4 gnv[NVT];
#pragma unroll
    for (int vt = 0; vt < NVT; ++vt) gnv[vt] = FULL ? *(const GAS f32x4*)(gn + (w * NVT + vt) * 16 + 4 * g4) : (f32x4){0.f, 0.f, 0.f, 0.f};
#pragma unroll 1
    for (int ch = 0; ch < NCH; ++ch) {
        const int m0 = b * SEQ + (seg * NCH + ch) * 64, sb = w, t0 = 8 * sb, I = sb >> 1;
        float ca[8], cb[8], ka[8], kb[8], qa[8], qb[8]; float ra = 0.f, rb = 0.f;
#pragma unroll
        for (int j = 0; j < 8; ++j) { float ga, gb;
            if (TYPE == 0) { ga = gr[j].x; gb = gr[j].y; ka[j] = blo(kr[j]); kb[j] = bhi(kr[j]); qa[j] = blo(qr[j]); qb[j] = bhi(qr[j]); }
            else { ga = blo(kr[j]); gb = bhi(kr[j]); ka[j] = 1.f - fexp(ga); kb[j] = 1.f - fexp(gb); qa[j] = blo(qr[j]); qb[j] = bhi(qr[j]); }
            ra += ga; rb += gb; ca[j] = ra; cb[j] = rb; }
        *(LAS f32x2*)(L + LA_T8 + (sb * 128 + 2 * p) * 4) = (f32x2){ra, rb};
        LA_BAR();
        float brefa[5], brefb[5]; brefa[0] = 0.f; brefb[0] = 0.f; float cba = 0.f, cbb = 0.f;
#pragma unroll
        for (int J = 0; J < 4; ++J) { const f32x2 u0 = *(const LAS f32x2*)(L + LA_T8 + ((2 * J) * 128 + 2 * p) * 4), u1 = *(const LAS f32x2*)(L + LA_T8 + ((2 * J + 1) * 128 + 2 * p) * 4);
            brefa[J + 1] = brefa[J] + (u0.x + u1.x); brefb[J + 1] = brefb[J] + (u0.y + u1.y);
            if (sb == 2 * J + 1) { cba = u0.x; cbb = u0.y; } }
        const float bIa = I == 0 ? brefa[0] : (I == 1 ? brefa[1] : (I == 2 ? brefa[2] : brefa[3])), bIb = I == 0 ? brefb[0] : (I == 1 ? brefb[1] : (I == 2 ? brefb[2] : brefb[3]));
        const float bla = brefa[4], blb = brefb[4];
        ldsa += bla; ldsb += blb;
        const float eha = fexp(bla - bIa), ehb = fexp(blb - bIb);
        const float eqa = fexp(bIa), eqb = fexp(bIb);
        unsigned kh_a[4], kh_b[4], vlo[4], vhi[4], v2lo[4], v2hi[4];
        float kfa[4], kfb[4];
#pragma unroll
        for (int Ip = 0; Ip < 4; ++Ip) { kfa[Ip] = fexp(fminf(brefa[Ip] - bIa, 0.f)); kfb[Ip] = fexp(fminf(brefb[Ip] - bIb, 0.f)); }
#pragma unroll
        for (int j = 0; j < 8; ++j) { const int t = t0 + j;
            const float cca = fmaxf(cba + ca[j], -60.f), ccb = fmaxf(cbb + cb[j], -60.f); const float e1a = fexp(cca), e1b = fexp(ccb), e2a = fexp(-cca), e2b = fexp(-ccb);
            const float kka = ka[j] * e2a, kkb = kb[j] * e2b;
            const float kha = kka * eha, khb = kkb * ehb;
            if (j & 1) { kh_a[j >> 1] |= f2bf(kha) << 16; kh_b[j >> 1] |= f2bf(khb) << 16; } else { kh_a[j >> 1] = f2bf(kha); kh_b[j >> 1] = f2bf(khb); }
            if (FULL) { const float qpa = qa[j] * e1a, qpb = qb[j] * e1b;
                *(LAS unsigned*)(L + LA_QP + t * QS + 4 * p) = pk2(qpa, qpb); *(LAS unsigned*)(L + LA_QT + t * QS + 4 * p) = pk2(qpa * eqa, qpb * eqb);
#pragma unroll
                for (int Ip = 0; Ip < 4; ++Ip) if (Ip >= I) { const int base = Ip == 0 ? 0 : (Ip == 1 ? 16 : (Ip == 2 ? 48 : 96));
                    *(LAS unsigned*)(L + LA_KP + (base + t) * QS + 4 * p) = pk2(kka * kfa[Ip], kkb * kfb[Ip]); } }
            const unsigned x = vr[j].x, y = vr[j].y;
            if (j & 1) { vlo[j >> 1] |= x << 16; vhi[j >> 1] |= x & 0xffff0000u; v2lo[j >> 1] |= y << 16; v2hi[j >> 1] |= y & 0xffff0000u; }
            else { vlo[j >> 1] = x & 0xffffu; vhi[j >> 1] = x >> 16; v2lo[j >> 1] = y & 0xffffu; v2hi[j >> 1] = y >> 16; } }
        *(LAS v4u*)(L + LA_KHT + (2 * p) * TS + 2 * t0) = (v4u){kh_a[0], kh_a[1], kh_a[2], kh_a[3]}; *(LAS v4u*)(L + LA_KHT + (2 * p + 1) * TS + 2 * t0) = (v4u){kh_b[0], kh_b[1], kh_b[2], kh_b[3]};
        if (DV == 256) { *(LAS v4u*)(L + LA_VT + (4 * p) * TS + 2 * t0) = (v4u){vlo[0], vlo[1], vlo[2], vlo[3]}; *(LAS v4u*)(L + LA_VT + (4 * p + 1) * TS + 2 * t0) = (v4u){vhi[0], vhi[1], vhi[2], vhi[3]};
                         *(LAS v4u*)(L + LA_VT + (4 * p + 2) * TS + 2 * t0) = (v4u){v2lo[0], v2lo[1], v2lo[2], v2lo[3]}; *(LAS v4u*)(L + LA_VT + (4 * p + 3) * TS + 2 * t0) = (v4u){v2hi[0], v2hi[1], v2hi[2], v2hi[3]}; }
        else { *(LAS v4u*)(L + LA_VT + (2 * p) * TS + 2 * t0) = (v4u){vlo[0], vlo[1], vlo[2], vlo[3]}; *(LAS v4u*)(L + LA_VT + (2 * p + 1) * TS + 2 * t0) = (v4u){vhi[0], vhi[1], vhi[2], vhi[3]}; }
        if (sb == 0) *(LAS f32x2*)(L + LA_DEC + 8 * p) = (f32x2){fexp(bla), fexp(blb)};
        if (ch + 1 < NCH) LA_LOAD_RAW(ch + 1);
        LA_BAR();
        v2u gwv[NVT][4];
        f32x4 oacc[TYPE == 0 ? 1 : NVT][4];
        if (FULL) {
            for (int blk = w; blk < 10; blk += 8) { const int I2 = blk >= 6 ? 3 : (blk >= 3 ? 2 : (blk >= 1 ? 1 : 0)), J2 = blk - (I2 * (I2 + 1)) / 2; const int base = I2 == 0 ? 0 : (I2 == 1 ? 16 : (I2 == 2 ? 48 : 96));
                const LAS unsigned char* kp = L + LA_KP + (base + 16 * J2 + l15) * QS + 16 * g4; const LAS unsigned char* qp = L + LA_QP + (16 * I2 + l15) * QS + 16 * g4;
                f32x4 acc = (f32x4){0.f, 0.f, 0.f, 0.f};
#pragma unroll
                for (int ks = 0; ks < 4; ++ks) acc = __builtin_amdgcn_mfma_f32_16x16x32_bf16(*(const LAS bf16x8*)(kp + 64 * ks), *(const LAS bf16x8*)(qp + 64 * ks), acc, 0, 0, 0);
                if (I2 == J2) {
#pragma unroll
                    for (int r = 0; r < 4; ++r) if (4 * g4 + r > l15) acc[r] = 0.f; }
                *(LAS v2u*)(L + LA_PS + (16 * I2 + l15) * TS + (16 * J2 + 4 * g4) * 2) = (v2u){pk2(acc[0], acc[1]), pk2(acc[2], acc[3])}; }
            LA_BAR();
            float ssq[4] = {0.f, 0.f, 0.f, 0.f};
#pragma unroll
            for (int vt = 0; vt < NVT; ++vt) {
                bf16x8 sf[4];
#pragma unroll
                for (int ks = 0; ks < 4; ++ks) { const f32x4 a = S[vt][2 * ks], c = S[vt][2 * ks + 1]; sf[ks] = mk8((v2u){pk2(a.x, a.y), pk2(a.z, a.w)}, (v2u){pk2(c.x, c.y), pk2(c.z, c.w)}); }
#pragma unroll
                for (int I2 = 0; I2 < 4; ++I2) {
                    f32x4 o = (f32x4){0.f, 0.f, 0.f, 0.f};
                    const LAS unsigned char* qt = L + LA_QT + (16 * I2 + l15) * QS + 8 * g4;
#pragma unroll
                    for (int ks = 0; ks < 4; ++ks) o = __builtin_amdgcn_mfma_f32_16x16x32_bf16(sf[ks], mk8(*(const LAS v2u*)(qt + 64 * ks), *(const LAS v2u*)(qt + 64 * ks + 32)), o, 0, 0, 0);
#pragma unroll
                    for (int ks = 0; ks < 2; ++ks) if (ks == 0 || I2 >= 2)
                        o = __builtin_amdgcn_mfma_f32_16x16x32_bf16(*(const LAS bf16x8*)(L + LA_VT + ((w * NVT + vt) * 16 + l15) * TS + (32 * ks + 8 * g4) * 2), *(const LAS bf16x8*)(L + LA_PS + (16 * I2 + l15) * TS + (32 * ks + 8 * g4) * 2), o, 0, 0, 0);
                    ssq[I2] += (o.x * o.x + o.y * o.y) + (o.z * o.z + o.w * o.w);
                    if (TYPE == 0) *(LAS v2u*)(L + LA_KP + (16 * I2 + l15) * OBS + ((w * NVT + vt) * 16 + 4 * g4) * 2) = (v2u){pk2(o.x, o.y), pk2(o.z, o.w)};
                    else oacc[vt][I2] = o;
                }
            }
#pragma unroll
            for (int I2 = 0; I2 < 4; ++I2) { float ss = ssq[I2]; ss += __shfl_xor(ss, 16); ss += __shfl_xor(ss, 32);
                if (g4 == 0) *(LAS float*)(L + LA_NRM + (w * 64 + 16 * I2 + l15) * 4) = ss; }
#pragma unroll
            for (int I2 = 0; I2 < 4; ++I2)
#pragma unroll
                for (int vt = 0; vt < NVT; ++vt) gwv[vt][I2] = *(const GAS v2u*)(P + (size_t)(m0 + 16 * I2 + l15) * PW + goff + (w * NVT + vt) * 16 + 4 * g4);
        }
        { bf16x8 bv[NVT][2];
#pragma unroll
          for (int vt = 0; vt < NVT; ++vt)
#pragma unroll
              for (int ks = 0; ks < 2; ++ks) bv[vt][ks] = *(const LAS bf16x8*)(L + LA_VT + ((w * NVT + vt) * 16 + l15) * TS + (32 * ks + 8 * g4) * 2);
#pragma unroll
          for (int dt = 0; dt < 8; ++dt) { const f32x4 dec = *(const LAS f32x4*)(L + LA_DEC + (dt * 16 + 4 * g4) * 4);
              const bf16x8 a0 = *(const LAS bf16x8*)(L + LA_KHT + (dt * 16 + l15) * TS + (8 * g4) * 2), a1 = *(const LAS bf16x8*)(L + LA_KHT + (dt * 16 + l15) * TS + (32 + 8 * g4) * 2);
#pragma unroll
              for (int vt = 0; vt < NVT; ++vt) { f32x4 sv = S[vt][dt] * dec; sv = __builtin_amdgcn_mfma_f32_16x16x32_bf16(a0, bv[vt][0], sv, 0, 0, 0); S[vt][dt] = __builtin_amdgcn_mfma_f32_16x16x32_bf16(a1, bv[vt][1], sv, 0, 0, 0); } } }
        if (FULL) {
            LA_BAR();
#pragma unroll
            for (int I2 = 0; I2 < 4; ++I2) { float tot = 0.f;
#pragma unroll
                for (int ww = 0; ww < 8; ++ww) tot += *(const LAS float*)(L + LA_NRM + (ww * 64 + 16 * I2 + l15) * 4);
                const float rstd = rsqrtf(tot * (1.f / DV) + EPS); const size_t m = (size_t)(m0 + 16 * I2 + l15);
#pragma unroll
                for (int vt = 0; vt < NVT; ++vt) { const int col = (w * NVT + vt) * 16 + 4 * g4; const v2u gw = gwv[vt][I2]; const f32x4 gg = gnv[vt]; f32x4 o; if (TYPE == 0) { const v2u ob = *(const LAS v2u*)(L + LA_KP + (16 * I2 + l15) * OBS + col * 2); o = (f32x4){blo(ob.x), bhi(ob.x), blo(ob.y), bhi(ob.y)}; } else o = oacc[vt][I2];
                    const float g0 = blo(gw.x), g1 = bhi(gw.x), g2 = blo(gw.y), g3 = bhi(gw.y);
                    float a0, a1, a2, a3; if (TYPE == 0) { a0 = g0 * sigm(g0); a1 = g1 * sigm(g1); a2 = g2 * sigm(g2); a3 = g3 * sigm(g3); } else { a0 = sigm(g0); a1 = sigm(g1); a2 = sigm(g2); a3 = sigm(g3); }
                    *(GAS v2u*)(Y + m * 1024 + h * DV + col) = (v2u){pk2(o.x * rstd * gg.x * a0, o.y * rstd * gg.y * a1), pk2(o.z * rstd * gg.z * a2, o.w * rstd * gg.w * a3)}; } }
        }
    }
    if (!FULL) {
        float* sl = slb + (size_t)item * (128 * DV);
#pragma unroll
        for (int vt = 0; vt < NVT; ++vt)
#pragma unroll
            for (int dt = 0; dt < 8; ++dt) *(GAS f32x4*)(sl + ((size_t)(((w * NVT + vt) * 8 + dt) * 64 + lane)) * 4) = S[vt][dt];
        if (w == 0) { ldb[(size_t)item * 128 + 2 * p] = ldsa; ldb[(size_t)item * 128 + 2 * p + 1] = ldsb; }
    }
    __syncthreads();
}

template <int TYPE> __device__ __forceinline__ void la_prefix(const Frame& F, int gtid, const float* SLOC, const float* LDT, float* SIN) {
    constexpr int DV = TYPE == 0 ? 256 : 128, NSEG = TYPE == 0 ? 16 : 8, NV4 = 128 * DV / 4;
    const int seq = gtid / NV4, e4 = gtid % NV4, dt = (e4 >> 6) & 7, ln = e4 & 63, d0 = dt * 16 + 4 * (ln >> 4);
    const float* slb = SLOC + (TYPE == 0 ? (size_t)0 : SLOC_HGRN_OFF) + (size_t)seq * NSEG * (128 * DV) + (size_t)e4 * 4;
    float* sib = SIN + (TYPE == 0 ? (size_t)0 : SLOC_HGRN_OFF) + (size_t)seq * NSEG * (128 * DV) + (size_t)e4 * 4;
    const float* ldb = LDT + (TYPE == 0 ? 0 : 128 * 128) + (size_t)seq * NSEG * 128 + d0;
    f32x4 sv[NSEG - 1], lv[NSEG - 1];
#pragma unroll
    for (int sg = 0; sg < NSEG - 1; ++sg) { sv[sg] = *(const GAS f32x4*)(slb + (size_t)sg * (128 * DV)); lv[sg] = *(const GAS f32x4*)(ldb + (size_t)sg * 128); }
    f32x4 S = (f32x4){0.f, 0.f, 0.f, 0.f};
#pragma unroll
    for (int sg = 0; sg < NSEG - 1; ++sg) { const f32x4 e = (f32x4){fexp(lv[sg].x), fexp(lv[sg].y), fexp(lv[sg].z), fexp(lv[sg].w)}; S = S * e + sv[sg]; *(GAS f32x4*)(sib + (size_t)(sg + 1) * (128 * DV)) = S; }
}

typedef const __attribute__((address_space(4))) Args* KArgs;
__device__ __forceinline__ KArgs kargs() { unsigned long long p = (unsigned long long)__builtin_amdgcn_kernarg_segment_ptr(); asm volatile("" : "+s"(p)); return (KArgs)p; }
__device__ __forceinline__ Frame mkframe(LAS unsigned char* lds, gu32* ctl) {
    Frame F; int tid = threadIdx.x; asm volatile("" : "+v"(tid)); int bx = blockIdx.x, G = gridDim.x; asm volatile("" : "+s"(bx), "+s"(G));
    F.lds = lds; F.MISC = (volatile LAS unsigned*)(lds + MISC_OFF); F.ctl = ctl;
    F.tid = tid; F.lane = tid & 63; F.wave = __builtin_amdgcn_readfirstlane(tid >> 6); F.G = G; F.bx = bx;
    F.vcu = (G % 8 == 0) ? (bx % 8) * (G / 8) + bx / 8 : bx;
    return F;
}
__global__ void __launch_bounds__(NWAVES * 64, 2) fwd_kernel(Args args_unused) {
    extern __shared__ __attribute__((aligned(16))) unsigned char lds_raw[];
    LAS unsigned char* lds = (LAS unsigned char*)lds_raw;
    XcdBarrier bar;
    int lo, hi;
    {
        KArgs A = kargs();
        gu32* ctl = (gu32*)(A->ws + WS_CTL);
        for (int u = threadIdx.x; u < (LDS_BYTES - LDSCTL_OFF) / 4; u += NWAVES * 64) ((LAS unsigned*)(lds + LDSCTL_OFF))[u] = 0u;
        __syncthreads();
        bar = xcd_barrier_post((unsigned*)(ctl + CW_BAR), (volatile LAS unsigned*)(lds + MISC_OFF) + 8);
        lo = A->ph_lo; hi = A->ph_hi;
    }
#define GRID_BAR() xcd_barrier(bar)
#define PH_SETUP KArgs A = kargs(); unsigned char* ws = A->ws; Frame F = mkframe(lds, (gu32*)(ws + WS_CTL)); (void)F;
#define WSP(T, off) ((T*)(ws + (off)))

    for (int rep = 0; rep < REP_P0; ++rep)
    if (lo <= 0 && 0 < hi) {
        PH_SETUP
        LAS float* scr = (LAS float*)(F.lds + RING_OFF + F.wave * 16384);
        const int gw = F.vcu * NWAVES + F.wave, NGW = F.G * NWAVES;
        int wslot = -1; float wmax = 0.f, s0c = 0.f;
#define WMAX_FLUSH() do { if (wslot >= 0) { for (int o = 1; o < 64; o <<= 1) wmax = fmaxf(wmax, __shfl_xor(wmax, o)); if (F.lane == 0) __hip_atomic_fetch_max((unsigned*)(ws + WS_CTL) + CW_WMAX + wslot, __float_as_uint(wmax), RLX_AGENT); } } while (0)
#define SLOT_ENTER(sl, SAMPLE) do { if (wslot != (sl)) { WMAX_FLUSH(); wslot = (sl); wmax = 0.f; float sm = (SAMPLE); for (int o = 1; o < 64; o <<= 1) sm = fmaxf(sm, __shfl_xor(sm, o)); s0c = fp8_scale(FP8_HEAD * sm); \
            if (F.lane == 0) __hip_atomic_fetch_max((unsigned*)(ws + WS_CTL) + CW_SMAX + wslot, __float_as_uint(sm), RLX_AGENT); } } while (0)
#define SLOT_ENTER_I8(sl, SAMPLE) do { if (wslot != (sl)) { WMAX_FLUSH(); wslot = (sl); wmax = 0.f; float ss = (SAMPLE); for (int o = 1; o < 64; o <<= 1) ss += __shfl_xor(ss, o); s0c = 127.0f / fmaxf(5.5f * sqrtf(ss * (1.0f / 2048.0f)), 1e-30f); \
            if (F.lane == 0) __hip_atomic_fetch_max((unsigned*)(ws + WS_CTL) + CW_SMAX + wslot, __float_as_uint(s0c), RLX_AGENT); } } while (0)
        for (int it = gw; it < NL * I_LAYER; it += NGW) {
            const int l = it / I_LAYER; int r = it % I_LAYER;
            unsigned char* wl = ws + WS_W + (size_t)l * WL_STRIDE;
            const size_t oGU = (size_t)l * D * FF, oD = (size_t)l * FF * D;
            if (r < 2 * I_GATE) { const bool up = r >= I_GATE; const int ri = up ? r - I_GATE : r;
                if (2 * l >= FP8_S0 && I8_F1) { SLOT_ENTER_I8(SL_GU(2 * l), p0_sumsq_item(A->in[2] + oGU, D, FF, 0, F.lane));
                    (void)(up ? p0_item8<2>(A->in[3] + oGU, D, FF, wl + WL_GU1, scr, ri, F.lane, s0c, true) : p0_item8<1>(A->in[2] + oGU, D, FF, wl + WL_GU1, scr, ri, F.lane, s0c, true)); }
                else if (2 * l >= FP8_S0) { SLOT_ENTER(SL_GU(2 * l), p0_absmax_item(A->in[2] + oGU, D, FF, 0, F.lane, 0));
                    wmax = fmaxf(wmax, up ? p0_item8<2>(A->in[3] + oGU, D, FF, wl + WL_GU1, scr, ri, F.lane, s0c) : p0_item8<1>(A->in[2] + oGU, D, FF, wl + WL_GU1, scr, ri, F.lane, s0c)); }
                else if (up) p0_item<2>(A->in[3] + oGU, D, FF, (bf16*)(wl + WL_GU1), scr, ri, F.lane); else p0_item<1>(A->in[2] + oGU, D, FF, (bf16*)(wl + WL_GU1), scr, ri, F.lane);
                continue; } r -= 2 * I_GATE;
            if (r < I_DOWN) { if (2 * l >= FP8_F2_S0) { SLOT_ENTER(SL_DN(2 * l), p0_absmax_item(A->in[4] + oD, FF, D, 0, F.lane, 0)); wmax = fmaxf(wmax, p0_item8<0>(A->in[4] + oD, FF, D, wl + WL_D1, scr, r, F.lane, s0c)); }
                else p0_item<0>(A->in[4] + oD, FF, D, (bf16*)(wl + WL_D1), scr, r, F.lane);
                continue; } r -= I_DOWN;
            if (r < 2 * I_GATE) { const bool up = r >= I_GATE; const int ri = up ? r - I_GATE : r;
                if (2 * l + 1 >= FP8_S0 && I8_F1) { SLOT_ENTER_I8(SL_GU(2 * l + 1), p0_sumsq_item(A->in[26] + oGU, D, FF, 0, F.lane));
                    (void)(up ? p0_item8<2>(A->in[27] + oGU, D, FF, wl + WL_GU2, scr, ri, F.lane, s0c, true) : p0_item8<1>(A->in[26] + oGU, D, FF, wl + WL_GU2, scr, ri, F.lane, s0c, true)); }
                else if (2 * l + 1 >= FP8_S0) { SLOT_ENTER(SL_GU(2 * l + 1), p0_absmax_item(A->in[26] + oGU, D, FF, 0, F.lane, 0));
                    wmax = fmaxf(wmax, up ? p0_item8<2>(A->in[27] + oGU, D, FF, wl + WL_GU2, scr, ri, F.lane, s0c) : p0_item8<1>(A->in[26] + oGU, D, FF, wl + WL_GU2, scr, ri, F.lane, s0c)); }
                else if (up) p0_item<2>(A->in[27] + oGU, D, FF, (bf16*)(wl + WL_GU2), scr, ri, F.lane); else p0_item<1>(A->in[26] + oGU, D, FF, (bf16*)(wl + WL_GU2), scr, ri, F.lane);
                continue; } r -= 2 * I_GATE;
            if (r < I_DOWN) { if (2 * l + 1 >= FP8_F2_S0) { SLOT_ENTER(SL_DN(2 * l + 1), p0_absmax_item(A->in[28] + oD, FF, D, 0, F.lane, 0)); wmax = fmaxf(wmax, p0_item8<0>(A->in[28] + oD, FF, D, wl + WL_D2, scr, r, F.lane, s0c)); }
                else p0_item<0>(A->in[28] + oD, FF, D, (bf16*)(wl + WL_D2), scr, r, F.lane);
                continue; } r -= I_DOWN;
            if (r < I_IN) { const float* wi = A->in[7] + (size_t)l * D * IN_W;
                if (l < G8_L0) { p0_item<5>(wi, D, IN_W, (bf16*)(wl + WL_IN), scr, r, F.lane); continue; }
                if (r % NBLK_IN <= MG_NB0) p0_item<3>(wi, D, IN_W, (bf16*)(wl + WL_IN), scr, r, F.lane);
                if (r % NBLK_IN >= MG_NB0) { SLOT_ENTER(l, p0_absmax_item(wi, D, IN_W, MG_NB0 + 1, F.lane, MG_N0)); wmax = fmaxf(wmax, p0_item8<4>(wi, D, IN_W, wl + WL_IN + WL_IN8, scr, r, F.lane, s0c)); }
                continue; } r -= I_IN;
            if (r < 3 * I_BR) { const int br = r / I_BR; p0_item<0>(A->in[20 + br] + (size_t)l * 1024 * D, 1024, D, (bf16*)(wl + WL_BR) + (size_t)br * D * 1024, scr, r % I_BR, F.lane); continue; } r -= 3 * I_BR;
            p0_item<0>(A->in[23] + (size_t)l * D * D, D, D, (bf16*)(wl + WL_OUT), scr, r, F.lane);
        }
        WMAX_FLUSH();
#undef WMAX_FLUSH
#undef SLOT_ENTER
#undef SLOT_ENTER_I8
        const int gt = F.vcu * 512 + F.tid, NT = F.G * 512;
        for (int i = gt; i < NL * 2048 * 32; i += NT) { const int l = i / (2048 * 32), r = i % (2048 * 32), n = r >> 5, k8 = (r & 31) * 8;
            const int h = n >> 8, g = (n >> 7) & 1, j = n & 127, hp = 2 * (h >> 1) + (k8 >> 7), i0 = k8 & 127;
            v4u o = (v4u){0u, 0u, 0u, 0u};
            if (hp == h) { const float* w = (g ? A->in[12] : A->in[10]) + (size_t)l * 8 * 128 * 128 + (size_t)h * 128 * 128 + (size_t)i0 * 128 + j;
                o.x = pk2(w[0], w[128]); o.y = pk2(w[256], w[384]); o.z = pk2(w[512], w[640]); o.w = pk2(w[768], w[896]); }
            *(GAS v4u*)((bf16*)(ws + WS_W + (size_t)l * WL_STRIDE + WL_GT) + (size_t)n * 256 + k8) = o; }
        if (gt < 1024) { float* LB = WSP(float, WS_LB); const float* lg = A->in[18]; float v0 = lg[gt], v1 = lg[1024 + gt], v2 = lg[2048 + gt], v3 = lg[3072 + gt];
            const float mx = fmaxf(fmaxf(v0, v1), fmaxf(v2, v3)); v0 = expf(v0 - mx); v1 = expf(v1 - mx); v2 = expf(v2 - mx); v3 = expf(v3 - mx);
            const float inv = 1.f / (v0 + v1 + v2 + v3);
            LB[gt] = 0.f; LB[1024 + gt] = v1 * inv; LB[2048 + gt] = (v1 + v2) * inv; LB[3072 + gt] = (v1 + v2 + v3) * inv; }
        rowpass(F, A->in[0], nullptr, nullptr, nullptr, nullptr, nullptr, nullptr, nullptr, 0.f, A->in[1], WSP(bf16, WS_H));
        GRID_BAR();
    }
    if (lo <= 0 && 0 < hi) {
        PH_SETUP
        LAS float* scr = (LAS float*)(F.lds + RING_OFF + F.wave * 16384);
        const int gw = F.vcu * NWAVES + F.wave, NGW = F.G * NWAVES;
        bool redo = false;
        for (int l = G8_L0; l < NL; ++l) { if (wscale_ok(ws, l)) continue; redo = true; const float sW = wscale(ws, l);
            for (int it = gw; it < I_MG; it += NGW) { const int kb = it / (NBLK_IN - MG_NB0), nb = MG_NB0 + it % (NBLK_IN - MG_NB0);
                (void)p0_item8<4>(A->in[7] + (size_t)l * D * IN_W, D, IN_W, ws + WS_W + (size_t)l * WL_STRIDE + WL_IN + WL_IN8, scr, kb * NBLK_IN + nb, F.lane, sW); } }
        for (int hs = FP8_S0; hs < 2 * NL; ++hs) { if (I8_F1 || wscale_ok(ws, SL_GU(hs))) continue; redo = true; const float sW = wscale(ws, SL_GU(hs)); const int l = hs >> 1, f = hs & 1;
            unsigned char* w8 = ws + WS_W + (size_t)l * WL_STRIDE + (f ? WL_GU2 : WL_GU1);
            for (int it = gw; it < 2 * I_GATE; it += NGW) {
                if (it < I_GATE) (void)p0_item8<1>((f ? A->in[26] : A->in[2]) + (size_t)l * D * FF, D, FF, w8, scr, it, F.lane, sW);
                else (void)p0_item8<2>((f ? A->in[27] : A->in[3]) + (size_t)l * D * FF, D, FF, w8, scr, it - I_GATE, F.lane, sW); } }
        for (int hs = FP8_F2_S0; hs < 2 * NL; ++hs) { if (wscale_ok(ws, SL_DN(hs))) continue; redo = true; const float sW = wscale(ws, SL_DN(hs)); const int l = hs >> 1, f = hs & 1;
            for (int it = gw; it < I_DOWN; it += NGW) (void)p0_item8<0>((f ? A->in[28] : A->in[4]) + (size_t)l * FF * D, FF, D, ws + WS_W + (size_t)l * WL_STRIDE + (f ? WL_D2 : WL_D1), scr, it, F.lane, sW); }
        if (redo && hi > 1) GRID_BAR();
    }

    int ph = 1;
#define PH_BEGIN if (lo <= ph && ph < hi) { PH_SETUP unsigned char* wl = ws + WS_W + (size_t)l * WL_STRIDE; (void)wl;
#define PH_END(last) if (!(last) && ph + 1 < hi) GRID_BAR(); } ++ph;
#pragma unroll 1
    for (int s = 0; s < 2 * NL; ++s) {
        const int l = s >> 1, f = s & 1;
        for (int rep = 0; rep < REP_F1; ++rep) { if (rep) --ph;
        PH_BEGIN
            if (s >= FP8_S0) {
                pg8::Gemm g{WSP(bf16, WS_H8), (const bf16*)(wl + (f ? WL_GU2 : WL_GU1)), M, 2 * FF, D / 2, D / 2}; pg8::StaticOrder S; S.init(M, 2 * FF, F.G, F.bx);
                const float sc = I8_F1 ? 1.0f / __uint_as_float(((const gu32*)(ws + WS_CTL))[CW_SMAX + SL_GU(s)]) : 1.0f / (h8_scale((f ? A->in[25] : A->in[1]) + (size_t)l * D, F.lane) * wscale(ws, SL_GU(s)));
                const bool track = (s + 1 >= FP8_F2_S0 && s + 1 < 2 * NL), out8 = (s >= FP8_F2_S0);
                LAS unsigned* mxw = (LAS unsigned*)(F.lds + MISC_OFF + 1024);
                if (F.tid == 0) *mxw = 0u;
                const float s8 = out8 ? fp8_scale(4.0f * __uint_as_float(((const gu32*)(ws + WS_CTL))[CW_WMAX + SL_ACT(s)])) : 0.f;
                pg8::EpiSwiGLU8 E{WSP(bf16, WS_P), FF, sc, out8 ? WSP(unsigned char, WS_P) : nullptr, s8, track ? mxw : nullptr, I8_F1 ? WSP(float, WS_RS) : nullptr};
                pg8::gemm_phase<pg8::EpiSwiGLU8, pg8::StaticOrder, GEMM_ALIGN, GEMM_SP2, 0, I8_F1 ? 2 : 1>(F.lds + RING_OFF, g, S, E);
                if (track && F.tid == 0) __hip_atomic_fetch_max((unsigned*)(ws + WS_CTL) + CW_WMAX + SL_ACT(s + 1), *mxw, RLX_AGENT);
            } else {
            pg8::Gemm g{WSP(bf16, WS_H), (const bf16*)(wl + (f ? WL_GU2 : WL_GU1)), M, 2 * FF, D, HP}; pg8::StaticOrder S; S.init(M, 2 * FF, F.G, F.bx);
            const bool track = (s + 1 >= FP8_F2_S0 && s + 1 < 2 * NL);
            LAS unsigned* mxw = (LAS unsigned*)(F.lds + MISC_OFF + 1024);
            if (F.tid == 0) *mxw = 0u;
            pg8::EpiSwiGLU E{WSP(bf16, WS_P), FF, track ? mxw : nullptr};
            pg8::gemm_phase<pg8::EpiSwiGLU, pg8::StaticOrder, GEMM_ALIGN, GEMM_SP2, HP == D ? 0 : HP>(F.lds + RING_OFF, g, S, E);
            if (track && F.tid == 0) __hip_atomic_fetch_max((unsigned*)(ws + WS_CTL) + CW_WMAX + SL_ACT(s + 1), *mxw, RLX_AGENT);
            }
        PH_END(false) }
        for (int rep = 0; rep < REP_F2; ++rep) { if (rep) --ph;
        PH_BEGIN
            if (s >= FP8_F2_S0) {
                pg8::Gemm g{WSP(bf16, WS_P), (const bf16*)(wl + (f ? WL_D2 : WL_D1)), M, D, FF / 2, FF / 2}; pg8::StaticOrder S; S.init(M, D, F.G, F.bx);
                const float sc = 1.0f / (fp8_scale(4.0f * __uint_as_float(((const gu32*)(ws + WS_CTL))[CW_WMAX + SL_ACT(s)])) * wscale(ws, SL_DN(s)));
                pg8::EpiRaw8 E{WSP(bf16, WS_Y), D, sc};
                pg8::gemm_phase<pg8::EpiRaw8, pg8::StaticOrder, GEMM_ALIGN, GEMM_SP2, 0, true>(F.lds + RING_OFF, g, S, E);
            } else {
            pg8::Gemm g{WSP(bf16, WS_P), (const bf16*)(wl + (f ? WL_D2 : WL_D1)), M, D, FF, FF}; pg8::StaticOrder S; S.init(M, D, F.G, F.bx);
            pg8::EpiRawBf16 E{WSP(bf16, WS_Y), D};
            pg8::gemm_phase<pg8::EpiRawBf16, pg8::StaticOrder, GEMM_ALIGN, GEMM_SP2>(F.lds + RING_OFF, g, S, E);
            }
        PH_END(false) }
        for (int rep = 0; rep < REP_RP; ++rep) { if (rep) --ph;
        PH_BEGIN
            const float* gpost = A->in[f ? 29 : 5] + (size_t)l * D;
            const float* gpre = f ? (l + 1 < NL ? A->in[1] + (size_t)(l + 1) * D : nullptr) : A->in[6] + (size_t)l * D;
            const bool lastp = (s == 2 * NL - 1);
            rowpass(F, (s == 0) ? A->in[0] : nullptr, WSP(unsigned short, WS_XH), WSP(unsigned char, WS_XL), WSP(bf16, WS_Y), lastp ? A->out : nullptr, WSP(unsigned short, WS_XH), WSP(unsigned char, WS_XL), gpost, 0.5f, gpre, (gpre && !(f == 1 && s + 1 >= FP8_S0)) ? WSP(bf16, WS_H) : nullptr, ((f == 0 && l >= G8_L0) || (f == 1 && gpre && s + 1 >= FP8_S0)) ? WSP(unsigned char, WS_H8) : nullptr, (I8_F1 && f == 1 && gpre && s + 1 >= FP8_S0) ? WSP(float, WS_RS) : nullptr);
        PH_END(s == 2 * NL - 1 && rep == REP_RP - 1) }
        if (f == 0) {
            for (int rep = 0; rep < REP_M1; ++rep) { if (rep) --ph;
        PH_BEGIN
                if (l < G8_L0) {
                  pg8::Gemm g{WSP(bf16, WS_H), (const bf16*)(wl + WL_IN), M, NIN, D, HP}; pg8::StaticOrder S; S.init(M, NIN, F.G, F.bx);
                  pg8::EpiWinFull E{WSP(bf16, WS_P), PW, WSP(unsigned char, WS_MGQ), WSP(float, WS_LB) + l * 1024};
                  pg8::gemm_phase<pg8::EpiWinFull, pg8::StaticOrder, GEMM_ALIGN, GEMM_SP2, HP == D ? 0 : HP>(F.lds + RING_OFF, g, S, E);
                } else {
                { pg8::Gemm g{WSP(bf16, WS_H), (const bf16*)(wl + WL_IN), M, PW, D, HP}; pg8::StaticOrder S; S.init(M, PW, F.G, F.bx);
                  pg8::EpiWin E{WSP(bf16, WS_P), PW, WSP(float, WS_LB) + l * 1024};
                  pg8::gemm_phase<pg8::EpiWin, pg8::StaticOrder, GEMM_ALIGN, GEMM_SP2, HP == D ? 0 : HP>(F.lds + RING_OFF, g, S, E); }
                { Frame F2 = mkframe(lds, (gu32*)(ws + WS_CTL));
                  pg8::Gemm g{WSP(bf16, WS_H8), (const bf16*)(wl + WL_IN + WL_IN8), M, 6144, D / 2, D / 2}; pg8::StaticOrder S; S.init(M, 6144, F2.G, F2.bx);
                  const float sc = 1.0f / (h8_scale(A->in[6] + (size_t)l * D, F2.lane) * wscale(ws, l));
                  pg8::EpiWinGate E{WSP(unsigned char, WS_MGQ), sc};
                  pg8::gemm_phase<pg8::EpiWinGate, pg8::StaticOrder, GEMM_ALIGN, GEMM_SP2, 0, true>(F2.lds + RING_OFF, g, S, E); }
                }
            PH_END(false) }
            for (int rep = 0; rep < REP_M3; ++rep) { if (rep) --ph;
            PH_BEGIN
                { Frame F2 = mkframe(lds, (gu32*)(ws + WS_CTL));
                  lrgg_phase(F2, WSP(bf16, WS_H), (const bf16*)(wl + WL_IN) + (size_t)NIN * D, A->in[15] + (size_t)l * 16 * 512, A->in[16] + l * 512, WSP(float, WS_GG));
                  pg8::GateOrder S2; S2.init(M, 2048, F2.G, F2.bx); pg8::Unit u;
#pragma unroll 1
                  for (int i = 0; S2.next(i, u); ++i) conv_item(WSP(bf16, WS_P), A->in[8] + (size_t)l * 4 * 1024, A->in[9] + (size_t)l * 1024, WSP(bf16, WS_XC), 256 * (u.pn >> 1) + 8 * (F2.tid & 31), 256 * u.pm + 16 * (F2.tid >> 5));
                  VM_WAIT(); __syncthreads(); }
                int kgate = 256; asm volatile("" : "+s"(kgate));
                pg8::Gemm g{WSP(bf16, WS_XC), (const bf16*)(wl + WL_GT), M, 2048, kgate, 1024}; pg8::GateOrder S; S.init(M, 2048, F.G, F.bx);
                pg8::EpiGate8 E{WSP(unsigned char, WS_GT), A->in[11] + l * 1024, A->in[13] + l * 1024};
                pg8::gemm_phase<pg8::EpiGate8, pg8::GateOrder, GEMM_ALIGN, GEMM_SP2, 1024>(F.lds + RING_OFF, g, S, E);
            PH_END(false) }
            for (int rep = 0; rep < REP_M4; ++rep) { if (rep) --ph;
            PH_BEGIN
                lru_chunk_phase<false>(F, WSP(unsigned char, WS_GT), WSP(bf16, WS_XC), WSP(bf16, WS_P), A->in[11] + l * 1024, A->in[13] + l * 1024, A->in[14] + l * 1024, WSP(float, WS_CA), WSP(float, WS_CH), WSP(float, WS_HIN), WSP(bf16, WS_YA), F.bx < 128 ? LRUA_G * F.bx : 128 * LRUA_G + (8 - LRUA_G) * (F.bx - 128), F.bx < 128 ? LRUA_G * F.bx + LRUA_G : 128 * LRUA_G + (8 - LRUA_G) * (F.bx - 127));
                if (F.bx < 128) la_segment<0, false>(F, F.bx, WSP(bf16, WS_P), WSP(float, WS_GG), WSP(float, WS_LB) + l * 1024, A->in[17] + l * 256, WSP(float, WS_SLOC), WSP(float, WS_LDT), WSP(float, WS_SIN), WSP(bf16, WS_YB));
                else la_segment<1, false>(F, F.bx - 128, WSP(bf16, WS_P), WSP(float, WS_GG), WSP(float, WS_LB) + l * 1024, A->in[19] + l * 128, WSP(float, WS_SLOC), WSP(float, WS_LDT), WSP(float, WS_SIN), WSP(bf16, WS_YC));
            PH_END(false) }
            for (int rep = 0; rep < REP_M5; ++rep) { if (rep) --ph;
            PH_BEGIN
                lru_carry_phase(F, WSP(float, WS_CA), WSP(float, WS_CH), WSP(float, WS_HIN));
                if (F.bx < 128) la_prefix<0>(F, F.bx * 512 + F.tid, WSP(float, WS_SLOC), WSP(float, WS_LDT), WSP(float, WS_SIN));
                else la_prefix<1>(F, (F.bx - 128) * 512 + F.tid, WSP(float, WS_SLOC), WSP(float, WS_LDT), WSP(float, WS_SIN));
            PH_END(false) }
            for (int rep = 0; rep < REP_M6; ++rep) { if (rep) --ph;
            PH_BEGIN
                if (rep == 0) lru_chunk_phase<true>(F, WSP(unsigned char, WS_GT), WSP(bf16, WS_XC), WSP(bf16, WS_P), A->in[11] + l * 1024, A->in[13] + l * 1024, A->in[14] + l * 1024, WSP(float, WS_CA), WSP(float, WS_CH), WSP(float, WS_HIN), WSP(bf16, WS_YA), F.bx < 128 ? LRUC_G * F.bx : 128 * LRUC_G + (8 - LRUC_G) * (F.bx - 128), F.bx < 128 ? LRUC_G * F.bx + LRUC_G : 128 * LRUC_G + (8 - LRUC_G) * (F.bx - 127));
                if (F.bx < 128) { if (rep == 0 || PROBE_SECOND != 2) la_segment<0, true>(F, F.bx, WSP(bf16, WS_P), WSP(float, WS_GG), WSP(float, WS_LB) + l * 1024, A->in[17] + l * 256, WSP(float, WS_SLOC), WSP(float, WS_LDT), WSP(float, WS_SIN), WSP(bf16, WS_YB)); }
                else if (rep == 0 || PROBE_SECOND != 1) la_segment<1, true>(F, F.bx - 128, WSP(bf16, WS_P), WSP(float, WS_GG), WSP(float, WS_LB) + l * 1024, A->in[19] + l * 128, WSP(float, WS_SLOC), WSP(float, WS_LDT), WSP(float, WS_SIN), WSP(bf16, WS_YC));
            PH_END(false) }
            for (int rep = 0; rep < REP_M7; ++rep) { if (rep) --ph;
        PH_BEGIN
                pg8::Gemm g{WSP(bf16, WS_YA), (const bf16*)(wl + WL_BR), M, D, 1024, 1024}; pg8::BranchOrder S; S.init(M, D, F.G, F.bx);
                S.astride = (size_t)M * 1024 * 2; S.bstride = (size_t)D * 1024 * 2;
                pg8::EpiBranchFused E{WSP(unsigned char, WS_MGQ), WSP(bf16, WS_MG), D};
                pg8::gemm_phase<pg8::EpiBranchFused, pg8::BranchOrder, GEMM_ALIGN, GEMM_SP2>(F.lds + RING_OFF, g, S, E);
            PH_END(false) }
            for (int rep = 0; rep < REP_M8; ++rep) { if (rep) --ph;
        PH_BEGIN
                pg8::Gemm g{WSP(bf16, WS_MG), (const bf16*)(wl + WL_OUT), M, D, D, D}; pg8::StaticOrder S; S.init(M, D, F.G, F.bx);
                pg8::EpiRawBf16 E{WSP(bf16, WS_Y), D};
                pg8::gemm_phase<pg8::EpiRawBf16, pg8::StaticOrder, GEMM_ALIGN, GEMM_SP2>(F.lds + RING_OFF, g, S, E);
            PH_END(false) }
            for (int rep = 0; rep < REP_RP; ++rep) { if (rep) --ph;
            PH_BEGIN
                rowpass(F, nullptr, WSP(unsigned short, WS_XH), WSP(unsigned char, WS_XL), WSP(bf16, WS_Y), nullptr, WSP(unsigned short, WS_XH), WSP(unsigned char, WS_XL), A->in[24] + (size_t)l * D, 1.0f, A->in[25] + (size_t)l * D, 2 * l + 1 >= FP8_S0 ? nullptr : WSP(bf16, WS_H), 2 * l + 1 >= FP8_S0 ? WSP(unsigned char, WS_H8) : nullptr, (I8_F1 && 2 * l + 1 >= FP8_S0) ? WSP(float, WS_RS) : nullptr);
            PH_END(false) }
        }
    }
}

static int gridDimOk() { return 1; }
extern "C" void kernel_launch(void* const* d_in, const int* in_sizes, int n_in, void* d_out, int out_size, void* d_ws, size_t ws_size, hipStream_t stream) {
    static int grid = 0;
    if (grid == 0) {
        if (n_in != 30 || in_sizes[0] != M * D || out_size != M * D || ws_size < WS_END || gridDimOk() == 0) { fprintf(stderr, "kernel_launch: unexpected shapes (n_in %d, in0 %d, out %d, ws %zu < %zu)\n", n_in, n_in > 0 ? in_sizes[0] : -1, out_size, ws_size, (size_t)WS_END); grid = -1; return; }
        int dev = 0, cus = 0, per_cu = 0;
        if (hipGetDevice(&dev) != hipSuccess || hipDeviceGetAttribute(&cus, hipDeviceAttributeMultiprocessorCount, dev) != hipSuccess) { grid = -1; return; }
        if (hipFuncSetAttribute((const void*)fwd_kernel, hipFuncAttributeMaxDynamicSharedMemorySize, LDS_BYTES) != hipSuccess) { fprintf(stderr, "kernel_launch: hipFuncSetAttribute failed\n"); grid = -1; return; }
        if (hipOccupancyMaxActiveBlocksPerMultiprocessor(&per_cu, (const void*)fwd_kernel, NWAVES * 64, LDS_BYTES) != hipSuccess || per_cu < 1) fprintf(stderr, "kernel_launch: occupancy query says %d\n", per_cu);
        (void)hipGetLastError();
        grid = cus;
    }
    if (grid < 0) return;
    if (hipMemsetAsync((char*)d_ws + WS_CTL, 0, CTL_ZERO_BYTES, stream) != hipSuccess) return;
    Args a{};
    for (int i = 0; i < 30; ++i) a.in[i] = (const float*)d_in[i];
    a.out = (float*)d_out; a.ws = (unsigned char*)d_ws; a.ph_lo = 0; a.ph_hi = 1 << 20;
    hipLaunchKernelGGL(fwd_kernel, dim3(grid), dim3(NWAVES * 64), LDS_BYTES, stream, a);
}
```
